# Optimizing an MI355X kernel written in HIP

```python
import math
import jax, jax.numpy as jnp
from jax import lax
import numpy as np

D_MODEL = 1024
BATCH = 16
SEQ = 2048
DEPTH = 4

MEM_LEN = 256
EPS = 1e-6
ROPE_THETA = 10000.0
A_HEADS = D_MODEL // 128
A_HEAD_DIM = 64
A_WIDTH = A_HEADS * A_HEAD_DIM
MOBA_BLOCK = 256
MOBA_TOPK = 3
MOBA_QCHUNK = 32
B_HEADS = D_MODEL // 128
B_NOPE = 64
B_ROPE = 32
B_VDIM = 64
B_Q_LORA = 3 * D_MODEL // 8
B_KV_LORA = D_MODEL // 4
B_WIDTH = B_HEADS * B_VDIM
ATTN_QBLOCK = 128
X_HEADS = 4
X_HEAD_DIM = 128
X_WIDTH = X_HEADS * X_HEAD_DIM
D_FF = ((8 * D_MODEL // 3 + 255) // 256) * 256
IN_WIDTH = 3 * A_WIDTH + B_Q_LORA + B_KV_LORA + B_ROPE + 2 * D_MODEL

kernel_name = "hybrid_moba_mla_gated_trunk"

F32 = jnp.float32


def rmsnorm(t, g):
    tf = t.astype(F32)
    y = tf * lax.rsqrt(jnp.mean(tf * tf, axis=-1, keepdims=True) + EPS)
    return (y * g.astype(F32)).astype(t.dtype)


def rope(t, pos):
    dim = t.shape[-1]
    half = dim // 2
    inv = jnp.exp(-math.log(ROPE_THETA) * (2.0 / dim) * jnp.arange(half, dtype=F32))
    ang = pos.astype(F32)[:, None, :, None] * inv
    cos, sin = jnp.cos(ang), jnp.sin(ang)
    tf = t.astype(F32)
    t1, t2 = tf[..., :half], tf[..., half:]
    return jnp.concatenate([t1 * cos - t2 * sin, t2 * cos + t1 * sin], axis=-1).astype(t.dtype)


def _heads(t, n):
    b, s, _ = t.shape
    return t.reshape(b, s, n, -1).transpose(0, 2, 1, 3)


def _merge(o):
    b, h, s, d = o.shape
    return o.transpose(0, 2, 1, 3).reshape(b, s, h * d)


def moba_attention(q, k, v):
    b, h, s, d = q.shape
    nb = -(-s // MOBA_BLOCK)
    pad = nb * MOBA_BLOCK - s
    kp = jnp.pad(k, ((0, 0), (0, 0), (0, pad), (0, 0)))
    vp = jnp.pad(v, ((0, 0), (0, 0), (0, pad), (0, 0)))
    kb = kp.reshape(b, h, nb, MOBA_BLOCK, d)
    vb = vp.reshape(b, h, nb, MOBA_BLOCK, d)
    kbar = jnp.mean(kb.astype(F32), axis=3)
    n_sel = min(MOBA_TOPK, nb)
    scale = d ** -0.5
    bi = jnp.arange(b)[:, None, None, None]
    hi = jnp.arange(h)[None, :, None, None]
    blk_ids = jnp.arange(nb)
    slot_ids = jnp.arange(n_sel)
    own_offsets = jnp.arange(MOBA_BLOCK)

    def chunk(c):
        start = c * MOBA_QCHUNK
        qc = lax.dynamic_slice_in_dim(q, start, MOBA_QCHUNK, axis=2)
        tq = start + jnp.arange(MOBA_QCHUNK)
        cur = start // MOBA_BLOCK
        gate = jnp.einsum('bhcd,bhnd->bhcn', qc.astype(F32), kbar)
        gate = jnp.where(blk_ids < cur, gate, -jnp.inf)
        _, sel = lax.top_k(gate, n_sel)
        ks = kb[bi, hi, sel]
        vs = vb[bi, hi, sel]
        s_sel = jnp.einsum('bhcd,bhcnkd->bhcnk', qc, ks, preferred_element_type=F32) * scale
        s_sel = jnp.where((slot_ids < cur)[:, None], s_sel, -jnp.inf)
        s_sel = s_sel.reshape(b, h, MOBA_QCHUNK, n_sel * MOBA_BLOCK)
        k_own = lax.dynamic_slice_in_dim(kp, cur * MOBA_BLOCK, MOBA_BLOCK, axis=2)
        v_own = lax.dynamic_slice_in_dim(vp, cur * MOBA_BLOCK, MOBA_BLOCK, axis=2)
        kpos = cur * MOBA_BLOCK + own_offsets
        s_own = jnp.einsum('bhcd,bhkd->bhck', qc, k_own, preferred_element_type=F32) * scale
        s_own = jnp.where(kpos[None, :] <= tq[:, None], s_own, -jnp.inf)
        p = jax.nn.softmax(jnp.concatenate([s_sel, s_own], axis=-1), axis=-1)
        p_sel = p[..., :n_sel * MOBA_BLOCK].reshape(b, h, MOBA_QCHUNK, n_sel, MOBA_BLOCK).astype(v.dtype)
        p_own = p[..., n_sel * MOBA_BLOCK:].astype(v.dtype)
        return (jnp.einsum('bhcnk,bhcnkd->bhcd', p_sel, vs)
                + jnp.einsum('bhck,bhkd->bhcd', p_own, v_own))

    out = lax.map(chunk, jnp.arange(s // MOBA_QCHUNK))
    return out.transpose(1, 2, 0, 3, 4).reshape(b, h, s, d)


def mla_attention(q_nope, q_pe, k_nope, k_pe, v):
    b, h, s, _ = q_nope.shape
    scale = (B_NOPE + B_ROPE) ** -0.5
    kpos = jnp.arange(s)

    def blk(i):
        st = i * ATTN_QBLOCK
        qn = lax.dynamic_slice_in_dim(q_nope, st, ATTN_QBLOCK, axis=2)
        qr = lax.dynamic_slice_in_dim(q_pe, st, ATTN_QBLOCK, axis=2)
        sc = (jnp.einsum('bhqd,bhkd->bhqk', qn, k_nope, preferred_element_type=F32)
              + jnp.einsum('bhqr,bkr->bhqk', qr, k_pe, preferred_element_type=F32)) * scale
        qpos = st + jnp.arange(ATTN_QBLOCK)
        sc = jnp.where(kpos[None, :] <= qpos[:, None], sc, -jnp.inf)
        p = jax.nn.softmax(sc, axis=-1).astype(v.dtype)
        return jnp.einsum('bhqk,bhkd->bhqd', p, v)

    out = lax.map(blk, jnp.arange(s // ATTN_QBLOCK))
    return out.transpose(1, 2, 0, 3, 4).reshape(b, h, s, B_VDIM)


def parallel_mixer(h, pos, w_in, q_lat_norm, w_uq, kv_lat_norm, w_ukv, w_branch_a, w_branch_b, w_out):
    splits = list(np.cumsum([A_WIDTH, A_WIDTH, A_WIDTH, B_Q_LORA, B_KV_LORA, B_ROPE, D_MODEL]))
    qa, ka, va, q_lat, kv_lat, k_pe, g_a, g_b = jnp.split(h @ w_in, splits, axis=-1)
    o_a = moba_attention(rope(_heads(qa, A_HEADS), pos), rope(_heads(ka, A_HEADS), pos), _heads(va, A_HEADS))
    q = _heads(rmsnorm(q_lat, q_lat_norm) @ w_uq, B_HEADS)
    q_nope, q_pe = q[..., :B_NOPE], rope(q[..., B_NOPE:], pos)
    kv = _heads(rmsnorm(kv_lat, kv_lat_norm) @ w_ukv, B_HEADS)
    k_nope, v_b = kv[..., :B_NOPE], kv[..., B_NOPE:]
    k_pe = rope(k_pe[:, None], pos)[:, 0]
    o_b = mla_attention(q_nope, q_pe, k_nope, k_pe, v_b)
    merged = (jax.nn.sigmoid(g_a) * (_merge(o_a) @ w_branch_a)
              + jax.nn.sigmoid(g_b) * (_merge(o_b) @ w_branch_b))
    return merged @ w_out


def memory_cross_attention(h, m, w_xq, w_xkv, w_xo):
    q = _heads(h @ w_xq, X_HEADS)
    k, v = jnp.split(m @ w_xkv, 2, axis=-1)
    k, v = _heads(k, X_HEADS), _heads(v, X_HEADS)
    sc = jnp.einsum('bhqd,bhkd->bhqk', q, k, preferred_element_type=F32) * (X_HEAD_DIM ** -0.5)
    p = jax.nn.softmax(sc, axis=-1).astype(v.dtype)
    return _merge(jnp.einsum('bhqk,bhkd->bhqd', p, v)) @ w_xo


def swiglu(h, w_gate_up, w_down):
    gt, up = jnp.split(h @ w_gate_up, 2, axis=-1)
    return (jax.nn.silu(gt) * up) @ w_down


def setup_inputs(seed: int = 0) -> dict:
    key = jax.random.key(seed)
    ks = jax.random.split(key, 24)
    out_scale = (2 * DEPTH) ** -0.5

    def dense(k, shape, fan_in, scale=1.0):
        return jax.random.normal(k, shape, F32) * (scale * fan_in ** -0.5)

    def gain(k, shape):
        return 1.0 + 0.05 * jax.random.normal(k, shape, F32)

    L = DEPTH
    offsets = jax.random.randint(ks[2], (BATCH,), 0, 1024, dtype=jnp.int32)
    positions = offsets[:, None] + jnp.arange(SEQ, dtype=jnp.int32)[None, :]
    return {
        "x": jax.random.normal(ks[0], (BATCH, SEQ, D_MODEL), F32),
        "mem": jax.random.normal(ks[1], (BATCH, MEM_LEN, D_MODEL), F32),
        "positions": positions,
        "norm_mix": gain(ks[3], (L, D_MODEL)),
        "w_in": dense(ks[4], (L, D_MODEL, IN_WIDTH), D_MODEL),
        "q_lat_norm": gain(ks[5], (L, B_Q_LORA)),
        "w_uq": dense(ks[6], (L, B_Q_LORA, B_HEADS * (B_NOPE + B_ROPE)), B_Q_LORA),
        "kv_lat_norm": gain(ks[7], (L, B_KV_LORA)),
        "w_ukv": dense(ks[8], (L, B_KV_LORA, B_HEADS * (B_NOPE + B_VDIM)), B_KV_LORA),
        "w_branch_a": dense(ks[9], (L, A_WIDTH, D_MODEL), A_WIDTH),
        "w_branch_b": dense(ks[10], (L, B_WIDTH, D_MODEL), B_WIDTH),
        "w_out": dense(ks[11], (L, D_MODEL, D_MODEL), D_MODEL, out_scale),
        "norm_xattn": gain(ks[12], (L, D_MODEL)),
        "norm_mem": gain(ks[13], (L, D_MODEL)),
        "w_xq": dense(ks[14], (L, D_MODEL, X_WIDTH), D_MODEL),
        "w_xkv": dense(ks[15], (L, D_MODEL, 2 * X_WIDTH), D_MODEL),
        "w_xo": dense(ks[16], (L, X_WIDTH, D_MODEL), X_WIDTH, out_scale),
        "norm_ffn": gain(ks[17], (L, D_MODEL)),
        "w_gate_up": dense(ks[18], (L, D_MODEL, 2 * D_FF), D_MODEL),
        "w_down": dense(ks[19], (L, D_FF, D_MODEL), D_FF, out_scale),
        "norm_final": gain(ks[20], (D_MODEL,)),
    }


def reference(x, mem, positions, norm_mix, w_in, q_lat_norm, w_uq, kv_lat_norm, w_ukv,
              w_branch_a, w_branch_b, w_out, norm_xattn, norm_mem, w_xq, w_xkv, w_xo,
              norm_ffn, w_gate_up, w_down, norm_final):
    for l in range(DEPTH):
        x = x + parallel_mixer(rmsnorm(x, norm_mix[l]), positions, w_in[l], q_lat_norm[l], w_uq[l],
                               kv_lat_norm[l], w_ukv[l], w_branch_a[l], w_branch_b[l], w_out[l])
        x = x + memory_cross_attention(rmsnorm(x, norm_xattn[l]), rmsnorm(mem, norm_mem[l]),
                                       w_xq[l], w_xkv[l], w_xo[l])
        x = x + swiglu(rmsnorm(x, norm_ffn[l]), w_gate_up[l], w_down[l])
    return rmsnorm(x, norm_final)
```

```cpp
#include <hip/hip_runtime.h>
#include <hip/hip_cooperative_groups.h>
#include <cstdio>
#include <cstdint>
namespace cg = cooperative_groups;

#ifndef ONE_LAUNCH
#define ONE_LAUNCH 1
#endif

#ifndef PHMASK
#define PHMASK 0xFFFF
#endif
#ifndef P2MASK
#define P2MASK 0xF
#endif
#define P2ON(k) (((P2MASK) >> (k)) & 1)
#define PHON(k) (((PHMASK) >> (k)) & 1)
#define LAS __attribute__((address_space(3)))
typedef unsigned short bf16_t;
typedef short bf16x8 __attribute__((ext_vector_type(8)));
typedef float f32x4 __attribute__((ext_vector_type(4)));
typedef float f32x16 __attribute__((ext_vector_type(16)));
typedef unsigned u32x4 __attribute__((ext_vector_type(4)));
typedef unsigned u32x2 __attribute__((ext_vector_type(2)));

constexpr int NBATCH = 16, SEQ = 2048, DM = 1024, DEPTH = 4, MEMLEN = 256;
constexpr int M = NBATCH * SEQ;
constexpr int MM = NBATCH * MEMLEN;
constexpr int IN_W = 4256, IN_WP = 4352;
constexpr int DFF = 2816;
constexpr float EPS = 1e-6f;
constexpr float LOG2E = 1.4426950408889634f;
constexpr float C2A = 0.125f * LOG2E;
constexpr float C2B = 0.10206207261596575f * LOG2E;
constexpr float C2X = 0.08838834764831845f * LOG2E;

constexpr size_t MiB = 1u << 20;
constexpr size_t WS_WIN = 0 * MiB, WS_WUQ = 9 * MiB, WS_WUKV = 10 * MiB, WS_WBA = 11 * MiB, WS_WBB = 12 * MiB, WS_WOUT = 13 * MiB,
                 WS_WXQ = 15 * MiB, WS_WXKV = 16 * MiB, WS_WXO = 18 * MiB, WS_WGU = 19 * MiB, WS_WDN = 30 * MiB;
constexpr size_t WS_XB = 36 * MiB;
constexpr size_t WS_QKVA = 100 * MiB;
constexpr size_t WS_LAT = 196 * MiB;
constexpr size_t WS_KVLAT = 228 * MiB;
constexpr size_t WS_GATES = 244 * MiB;
constexpr size_t WS_ACT = 100 * MiB;
constexpr size_t WS_KVB = 372 * MiB;
constexpr size_t WS_KVX = 436 * MiB;
constexpr size_t WS_MEMB = 444 * MiB;
constexpr size_t WS_KPE = 452 * MiB;
constexpr size_t WS_COSA = 454 * MiB, WS_SINA = 458 * MiB;
constexpr size_t WS_COSB = 462 * MiB, WS_SINB = 464 * MiB;
constexpr size_t WS_SSQ = 466 * MiB;
constexpr size_t WS_LSSQ = 468 * MiB;
constexpr size_t WS_RSTDM = 470 * MiB;
constexpr size_t WS_KBAR = 470 * MiB + 65536;
constexpr size_t WS_END = 471 * MiB;

__device__ __forceinline__ unsigned cvt_pk_bf16(float lo, float hi) { unsigned r; asm volatile("v_cvt_pk_bf16_f32 %0, %1, %2" : "=v"(r) : "v"(lo), "v"(hi)); return r; }
__device__ __forceinline__ float bf2f(unsigned short b) { return __uint_as_float(((unsigned)b) << 16); }
__device__ __forceinline__ float bflo(unsigned w) { return __uint_as_float(w << 16); }
__device__ __forceinline__ float bfhi(unsigned w) { return __uint_as_float(w & 0xffff0000u); }
__device__ __forceinline__ unsigned short f2bf1(float f) { return (unsigned short)(cvt_pk_bf16(f, 0.f) & 0xffffu); }

namespace pg8 {
constexpr int BM = 256, BK = 64, HALF = 128, HTB = HALF * BK * 2, STAGE_BYTES = 8 * HTB, NXCD = 8, WGM = 8;
__host__ __device__ __forceinline__ int lds_byte(int r, int c) { const int st = (r >> 4) * 2 + (c >> 5), rr = r & 15, cc = c & 31, ob = rr * 64 + cc * 2; return st * 1024 + (ob ^ (((ob >> 9) & 1) << 5)); }
__host__ __device__ __forceinline__ void stage_rc(int b, int& R, int& C) { const int st = b / 1024, sb = b % 1024, swz = sb ^ (((sb >> 9) & 1) << 5); R = (st >> 1) * 16 + swz / 64; C = (st & 1) * 32 + (swz % 64) / 2; }
__host__ __device__ __forceinline__ int perm32(int rho) { const int n = rho >> 4, i = rho & 15; return 8 * (i >> 2) + 4 * n + (i & 3); }

struct Unit { int pm, pn; };
struct Gemm { const bf16_t* A; const bf16_t* Bt; int M, N, K, lda; };

struct StaticOrder {
    int nM, nN, nwg, G, c;
    __device__ void init(int M_, int N_, int G_, int c_) { nM = M_ / BM; nN = N_ / BM; nwg = nM * nN; G = G_; c = c_; }
    __device__ bool next(int i, Unit& u) const {
        const long L = (long)i * G + c; if (L >= nwg) return false;
        int wgid = (int)L; { const int q = nwg / NXCD, r = nwg % NXCD, xcd = wgid % NXCD, off = wgid / NXCD; wgid = (xcd < r ? xcd * (q + 1) : r * (q + 1) + (xcd - r) * q) + off; }
        const int nig = WGM * nN, gid = wgid / nig, fm = gid * WGM, gsz = (nM - fm) < WGM ? (nM - fm) : WGM;
        u.pm = fm + ((wgid % nig) % gsz); u.pn = (wgid % nig) / gsz; return true;
    }
};

template <class Epi>
__device__ __forceinline__ void gemm_phase(LAS unsigned char* lds, const int tid, const Gemm g, const StaticOrder& S, const Epi& E) {
    const int wid = __builtin_amdgcn_readfirstlane(tid >> 6), lane = tid & 63, wr = wid >> 2, wc = wid & 3, fr = lane & 15, fq = lane >> 4;
    const int K = g.K, nt = K / BK;
    unsigned voffA[2], voffB[2];
#pragma unroll
    for (int i = 0; i < 2; ++i) { int R, C; stage_rc(tid * 16 + i * 8192, R, C); const int Rb = Epi::PERM ? ((R & ~31) + perm32(R & 31)) : R;
        voffA[i] = (unsigned)(R * g.lda + C) * 2u; voffB[i] = (unsigned)(Rb * K + C) * 2u; }
    const size_t kstep = (size_t)(BK * 2);
    const size_t hstepA = (size_t)HALF * g.lda * 2, hstepB = (size_t)HALF * K * 2;
    const size_t tstepA = 2 * hstepA, tstepB = 2 * hstepB;
    const unsigned ldsw = (unsigned)wid * 1024u;
    const int aoff = lds_byte(wr * 64 + fr, fq * 8), boff = lds_byte(wc * 32 + fr, fq * 8);
#define PG8_SA(b, h) (((b) * 2 + (h)) * HTB)
#define PG8_SB(b, h) ((4 + (b) * 2 + (h)) * HTB)
#define PG8_STAGE(bufoff, gbase, voff) do { _Pragma("unroll") for (int _i = 0; _i < 2; ++_i) \
        __builtin_amdgcn_global_load_lds((const unsigned*)((const char*)(gbase) + (voff)[_i]), (LAS unsigned*)(lds + (bufoff) + ldsw + _i * 8192), 16, 0, 0); } while (0)
#define PG8_LDA(dst, b, h) do { _Pragma("unroll") for (int m = 0; m < 4; ++m) _Pragma("unroll") for (int k = 0; k < 2; ++k) dst[m][k] = *(const LAS bf16x8*)(lds + PG8_SA(b, h) + aoff + m * 2048 + k * 1024); } while (0)
#define PG8_LDB(dst, b, h) do { _Pragma("unroll") for (int n = 0; n < 2; ++n) _Pragma("unroll") for (int k = 0; k < 2; ++k) dst[n][k] = *(const LAS bf16x8*)(lds + PG8_SB(b, h) + boff + n * 2048 + k * 1024); } while (0)
#define PG8_MMA(ai, bj, At, Bt) do { __builtin_amdgcn_s_setprio(1); _Pragma("unroll") for (int m = 0; m < 4; ++m) _Pragma("unroll") for (int n = 0; n < 2; ++n) _Pragma("unroll") for (int k = 0; k < 2; ++k) \
        acc[ai][bj][m][n] = __builtin_amdgcn_mfma_f32_16x16x32_bf16(Bt[n][k], At[m][k], acc[ai][bj][m][n], 0, 0, 0); __builtin_amdgcn_s_setprio(0); } while (0)
#define PG8_WAIT_V(n) asm volatile("s_waitcnt vmcnt(" #n ")" ::: "memory")
#define PG8_WAIT_L(n) asm volatile("s_waitcnt lgkmcnt(" #n ")" ::: "memory")
#define PG8_BAR __builtin_amdgcn_s_barrier()
#define PG8_SCHED __builtin_amdgcn_sched_barrier(0)
    Unit cur, nxt; int ui = 0;
    if (!S.next(0, cur)) return;
    f32x4 acc[2][2][4][2];
#pragma unroll
    for (int a = 0; a < 2; ++a)
#pragma unroll
        for (int b = 0; b < 2; ++b)
#pragma unroll
            for (int m = 0; m < 4; ++m)
#pragma unroll
                for (int n = 0; n < 2; ++n) acc[a][b][m][n] = (f32x4){0.f, 0.f, 0.f, 0.f};
    bf16x8 At[4][2], B0[2][2], B1[2][2];
    const char* cA = (const char*)g.A + (size_t)cur.pm * tstepA; const char* cB = (const char*)g.Bt + (size_t)cur.pn * tstepB;
    PG8_STAGE(PG8_SB(0, 0), cB, voffB); PG8_STAGE(PG8_SB(0, 1), cB + hstepB, voffB); PG8_STAGE(PG8_SA(0, 0), cA, voffA); PG8_STAGE(PG8_SA(0, 1), cA + hstepA, voffA);
    if (wr == 1) PG8_BAR;
    PG8_WAIT_V(2); PG8_BAR;
    PG8_STAGE(PG8_SB(1, 0), cB + kstep, voffB); PG8_STAGE(PG8_SA(1, 0), cA + kstep, voffA); PG8_STAGE(PG8_SB(1, 1), cB + hstepB + kstep, voffB);
    PG8_WAIT_V(6); PG8_BAR;
    for (;;) {
        const bool has_next = S.next(ui + 1, nxt);
        const char* nA = has_next ? (const char*)g.A + (size_t)nxt.pm * tstepA : cA; const char* nB = has_next ? (const char*)g.Bt + (size_t)nxt.pn * tstepB : cB;
#pragma unroll 1
        for (int t = 0; t < nt; t += 2) {
            const bool last = (t == nt - 2);
            const char* a1 = cA + (size_t)(t + 1) * kstep;
            const char* a2 = last ? nA : cA + (size_t)(t + 2) * kstep; const char* b2 = last ? nB : cB + (size_t)(t + 2) * kstep;
            const char* a3 = a2 + kstep; const char* b3 = b2 + kstep;
            PG8_LDB(B0, 0, 0); PG8_LDB(B1, 0, 1); PG8_SCHED; PG8_LDA(At, 0, 0); PG8_STAGE(PG8_SA(1, 1), a1 + hstepA, voffA);
            PG8_WAIT_V(8); PG8_WAIT_L(0); PG8_BAR; PG8_MMA(0, 0, At, B0); PG8_MMA(0, 1, At, B1); PG8_BAR; PG8_SCHED;
            PG8_LDA(At, 0, 1); PG8_STAGE(PG8_SB(0, 0), b2, voffB); PG8_STAGE(PG8_SB(0, 1), b2 + hstepB, voffB); PG8_STAGE(PG8_SA(0, 0), a2, voffA);
            PG8_WAIT_V(8); PG8_WAIT_L(0); PG8_BAR; PG8_MMA(1, 0, At, B0); PG8_MMA(1, 1, At, B1); PG8_BAR; PG8_SCHED;
            PG8_LDB(B0, 1, 0); PG8_LDB(B1, 1, 1); PG8_SCHED; PG8_LDA(At, 1, 0); PG8_STAGE(PG8_SA(0, 1), a2 + hstepA, voffA);
            PG8_WAIT_V(8); PG8_WAIT_L(0); PG8_BAR; PG8_MMA(0, 0, At, B0); PG8_MMA(0, 1, At, B1); PG8_BAR; PG8_SCHED;
            PG8_LDA(At, 1, 1); PG8_STAGE(PG8_SB(1, 0), b3, voffB); PG8_STAGE(PG8_SB(1, 1), b3 + hstepB, voffB); PG8_STAGE(PG8_SA(1, 0), a3, voffA);
            PG8_WAIT_V(8); PG8_WAIT_L(0); PG8_BAR; PG8_MMA(1, 0, At, B0); PG8_MMA(1, 1, At, B1); PG8_BAR; PG8_SCHED;
        }
        if (wr == 0) PG8_BAR;
        E(acc, cur, wr, wc, fr, fq);
        if (!has_next) break;
#pragma unroll
        for (int a = 0; a < 2; ++a)
#pragma unroll
            for (int b = 0; b < 2; ++b)
#pragma unroll
                for (int m = 0; m < 4; ++m)
#pragma unroll
                    for (int n = 0; n < 2; ++n) acc[a][b][m][n] = (f32x4){0.f, 0.f, 0.f, 0.f};
        cur = nxt; cA = nA; cB = nB; ++ui;
        if (wr == 1) PG8_BAR;
    }
    PG8_WAIT_V(0);
    PG8_BAR;
#undef PG8_SA
#undef PG8_SB
#undef PG8_STAGE
#undef PG8_LDA
#undef PG8_LDB
#undef PG8_MMA
#undef PG8_WAIT_V
#undef PG8_WAIT_L
#undef PG8_BAR
#undef PG8_SCHED
}
}

typedef const f32x4 (&AccRef)[2][2][4][2];

__device__ __forceinline__ float row_sum16(const float* p, int fq) {
    const f32x4 v = *(const f32x4*)(p + 4 * fq);
    float s = (v.x + v.y) + (v.z + v.w); s += __shfl_xor(s, 16); s += __shfl_xor(s, 32); return s;
}
__device__ __forceinline__ float quad_sum(float s) { s += __shfl_xor(s, 16); s += __shfl_xor(s, 32); return s; }
__device__ __forceinline__ float sq4(f32x4 v) { return (v.x * v.x + v.y * v.y) + (v.z * v.z + v.w * v.w); }
__device__ __forceinline__ u32x4 pack8(f32x4 a, f32x4 b) { u32x4 w; w.x = cvt_pk_bf16(a.x, a.y); w.y = cvt_pk_bf16(a.z, a.w); w.z = cvt_pk_bf16(b.x, b.y); w.w = cvt_pk_bf16(b.z, b.w); return w; }
__device__ __forceinline__ float sigmoidf_(float v) { return 1.0f / (1.0f + __expf(-v)); }
__device__ __forceinline__ f32x4 sig4(f32x4 v) { return (f32x4){sigmoidf_(v.x), sigmoidf_(v.y), sigmoidf_(v.z), sigmoidf_(v.w)}; }

struct EpiIn {
    static constexpr bool PERM = true;
    const float* ssq; bf16_t* qkva; bf16_t* lat; bf16_t* kvlat; bf16_t* gates; float* lssq; const float* cosA; const float* sinA;
    __device__ __forceinline__ void operator()(AccRef acc, const pg8::Unit& u, int wr, int wc, int fr, int fq) const {
        const int pn = u.pn;
#pragma unroll
        for (int ai = 0; ai < 2; ++ai)
#pragma unroll
            for (int m = 0; m < 4; ++m) {
                const int row = u.pm * 256 + ai * 128 + wr * 64 + m * 16 + fr;
                const float rs = rsqrtf(row_sum16(ssq + (size_t)row * 16, fq) * (1.0f / 1024.0f) + EPS);
                f32x4 v00 = acc[ai][0][m][0] * rs, v01 = acc[ai][0][m][1] * rs, v10 = acc[ai][1][m][0] * rs, v11 = acc[ai][1][m][1] * rs;
                if (pn < 4) {
                    const f32x4 c0 = *(const f32x4*)(cosA + (size_t)row * 32 + 8 * fq), c1 = *(const f32x4*)(cosA + (size_t)row * 32 + 8 * fq + 4);
                    const f32x4 s0 = *(const f32x4*)(sinA + (size_t)row * 32 + 8 * fq), s1 = *(const f32x4*)(sinA + (size_t)row * 32 + 8 * fq + 4);
                    f32x4 o00 = v00 * c0 - v10 * s0, o01 = v01 * c1 - v11 * s1, o10 = v10 * c0 + v00 * s0, o11 = v11 * c1 + v01 * s1;
                    if (pn < 2) { o00 = o00 * C2A; o01 = o01 * C2A; o10 = o10 * C2A; o11 = o11 * C2A; }
                    bf16_t* d = qkva + (size_t)row * 1536 + (pn >> 1) * 512 + ((pn & 1) * 4 + wc) * 64 + 8 * fq;
                    *(u32x4*)d = pack8(o00, o01); *(u32x4*)(d + 32) = pack8(o10, o11);
                } else if (pn < 6) {
                    bf16_t* d = qkva + (size_t)row * 1536 + pn * 256 + wc * 32 + 8 * fq;
                    *(u32x4*)d = pack8(v00, v01); *(u32x4*)(d + 128) = pack8(v10, v11);
                } else if (pn < 8) {
                    bf16_t* d = lat + (size_t)row * 512 + (pn - 6) * 256 + wc * 32 + 8 * fq;
                    *(u32x4*)d = pack8(v00, v01); *(u32x4*)(d + 128) = pack8(v10, v11);
                    float s = sq4(v00) + sq4(v01); if (pn == 6) s += sq4(v10) + sq4(v11);
                    s = quad_sum(s);
                    if (fq == 0) lssq[(size_t)row * 16 + (pn - 6) * 4 + wc] = s;
                } else if (pn == 8) {
                    bf16_t* d = kvlat + (size_t)row * 256 + wc * 32 + 8 * fq;
                    *(u32x4*)d = pack8(v00, v01); *(u32x4*)(d + 128) = pack8(v10, v11);
                    float s = quad_sum(sq4(v00) + sq4(v01) + sq4(v10) + sq4(v11));
                    if (fq == 0) lssq[(size_t)row * 16 + 8 + wc] = s;
                } else {
                    bf16_t* d = gates + (size_t)row * 2048 + (pn - 9) * 256 + wc * 32 + 8 * fq;
                    *(u32x4*)d = pack8(sig4(v00), sig4(v01)); *(u32x4*)(d + 128) = pack8(sig4(v10), sig4(v11));
                }
            }
    }
};

struct EpiUq {
    static constexpr bool PERM = true;
    const float* lssq; bf16_t* qb; const float* cosB; const float* sinB;
    __device__ __forceinline__ void operator()(AccRef acc, const pg8::Unit& u, int wr, int wc, int fr, int fq) const {
        const int pn = u.pn;
#pragma unroll
        for (int ai = 0; ai < 2; ++ai)
#pragma unroll
            for (int m = 0; m < 4; ++m) {
                const int row = u.pm * 256 + ai * 128 + wr * 64 + m * 16 + fr;
                float s; { const f32x4 v = *(const f32x4*)(lssq + (size_t)row * 16 + 4 * (fq & 1)); s = (fq < 2) ? (v.x + v.y) + (v.z + v.w) : 0.f; s = quad_sum(s); }
                const float rs = rsqrtf(s * (1.0f / 384.0f) + EPS) * C2B;
                f32x4 v00 = acc[ai][0][m][0] * rs, v01 = acc[ai][0][m][1] * rs, v10 = acc[ai][1][m][0] * rs, v11 = acc[ai][1][m][1] * rs;
                if (pn < 2) {
                    const int c0 = pn * 256 + wc * 32 + 8 * fq;
                    bf16_t* d0 = qb + (size_t)row * 768 + (c0 >> 6) * 96 + (c0 & 63);
                    const int c1 = c0 + 128;
                    bf16_t* d1 = qb + (size_t)row * 768 + (c1 >> 6) * 96 + (c1 & 63);
                    *(u32x4*)d0 = pack8(v00, v01); *(u32x4*)d1 = pack8(v10, v11);
                } else {
                    const int head = 2 * wc + (fq >> 1), i0 = 8 * (fq & 1);
                    const f32x4 c0 = *(const f32x4*)(cosB + (size_t)row * 16 + i0), c1 = *(const f32x4*)(cosB + (size_t)row * 16 + i0 + 4);
                    const f32x4 s0 = *(const f32x4*)(sinB + (size_t)row * 16 + i0), s1 = *(const f32x4*)(sinB + (size_t)row * 16 + i0 + 4);
                    const f32x4 o00 = v00 * c0 - v10 * s0, o01 = v01 * c1 - v11 * s1, o10 = v10 * c0 + v00 * s0, o11 = v11 * c1 + v01 * s1;
                    bf16_t* d = qb + (size_t)row * 768 + head * 96 + 64 + i0;
                    *(u32x4*)d = pack8(o00, o01); *(u32x4*)(d + 16) = pack8(o10, o11);
                }
            }
    }
};

template <int MODE> struct EpiRowScale {
    static constexpr bool PERM = true;
    const float* stat; bf16_t* O; int ldc; float cs;
    __device__ __forceinline__ void operator()(AccRef acc, const pg8::Unit& u, int wr, int wc, int fr, int fq) const {
#pragma unroll
        for (int ai = 0; ai < 2; ++ai)
#pragma unroll
            for (int m = 0; m < 4; ++m) {
                const int row = u.pm * 256 + ai * 128 + wr * 64 + m * 16 + fr;
                float rs;
                if (MODE == 0) { const f32x4 v = *(const f32x4*)(stat + (size_t)row * 16 + 8); rs = rsqrtf(((v.x + v.y) + (v.z + v.w)) * (1.0f / 256.0f) + EPS); }
                else if (MODE == 1) rs = stat[row];
                else rs = rsqrtf(row_sum16(stat + (size_t)row * 16, fq) * (1.0f / 1024.0f) + EPS) * cs;
                bf16_t* d = O + (size_t)row * ldc + u.pn * 256 + wc * 32 + 8 * fq;
                *(u32x4*)d = pack8(acc[ai][0][m][0] * rs, acc[ai][0][m][1] * rs);
                *(u32x4*)(d + 128) = pack8(acc[ai][1][m][0] * rs, acc[ai][1][m][1] * rs);
            }
    }
};

template <int Z> struct EpiBranch {
    static constexpr bool PERM = true;
    bf16_t* gates;
    __device__ __forceinline__ void operator()(AccRef acc, const pg8::Unit& u, int wr, int wc, int fr, int fq) const {
#pragma unroll
        for (int ai = 0; ai < 2; ++ai)
#pragma unroll
            for (int m = 0; m < 4; ++m) {
                const int row = u.pm * 256 + ai * 128 + wr * 64 + m * 16 + fr;
#pragma unroll
                for (int bj = 0; bj < 2; ++bj) {
                    bf16_t* d = gates + (size_t)row * 2048 + u.pn * 256 + bj * 128 + wc * 32 + 8 * fq;
                    const f32x4 a0 = acc[ai][bj][m][0], a1 = acc[ai][bj][m][1];
                    if (Z == 0) {
                        const u32x4 g = *(const u32x4*)d;
                        const f32x4 r0 = {bflo(g.x) * a0.x, bfhi(g.x) * a0.y, bflo(g.y) * a0.z, bfhi(g.y) * a0.w};
                        const f32x4 r1 = {bflo(g.z) * a1.x, bfhi(g.z) * a1.y, bflo(g.w) * a1.z, bfhi(g.w) * a1.w};
                        *(u32x4*)d = pack8(r0, r1);
                    } else {
                        const u32x4 t = *(const u32x4*)d; const u32x4 g = *(const u32x4*)(d + 1024);
                        const f32x4 r0 = {bflo(t.x) + bflo(g.x) * a0.x, bfhi(t.x) + bfhi(g.x) * a0.y, bflo(t.y) + bflo(g.y) * a0.z, bfhi(t.y) + bfhi(g.y) * a0.w};
                        const f32x4 r1 = {bflo(t.z) + bflo(g.z) * a1.x, bfhi(t.z) + bfhi(g.z) * a1.y, bflo(t.w) + bflo(g.w) * a1.z, bfhi(t.w) + bfhi(g.w) * a1.w};
                        *(u32x4*)d = pack8(r0, r1);
                    }
                }
            }
    }
};

struct EpiRes {
    static constexpr bool PERM = false;
    const float* xin; float* xout; bf16_t* xb; float* ssq;
    __device__ __forceinline__ void operator()(AccRef acc, const pg8::Unit& u, int wr, int wc, int fr, int fq) const {
#pragma unroll
        for (int ai = 0; ai < 2; ++ai)
#pragma unroll
            for (int m = 0; m < 4; ++m) {
                const int row = u.pm * 256 + ai * 128 + wr * 64 + m * 16 + fr;
                float s = 0.f;
#pragma unroll
                for (int bj = 0; bj < 2; ++bj)
#pragma unroll
                    for (int n = 0; n < 2; ++n) {
                        const size_t off = (size_t)row * 1024 + u.pn * 256 + bj * 128 + wc * 32 + n * 16 + 4 * fq;
                        const f32x4 o = *(const f32x4*)(xin + off) + acc[ai][bj][m][n];
                        *(f32x4*)(xout + off) = o; s += sq4(o);
                        u32x2 w; w.x = cvt_pk_bf16(o.x, o.y); w.y = cvt_pk_bf16(o.z, o.w); *(u32x2*)(xb + off) = w;
                    }
                s = quad_sum(s);
                if (fq == 0) ssq[(size_t)row * 16 + u.pn * 4 + wc] = s;
            }
    }
};

struct EpiGU {
    static constexpr bool PERM = true;
    const float* ssq; bf16_t* act;
    __device__ __forceinline__ void operator()(AccRef acc, const pg8::Unit& u, int wr, int wc, int fr, int fq) const {
#pragma unroll
        for (int ai = 0; ai < 2; ++ai)
#pragma unroll
            for (int m = 0; m < 4; ++m) {
                const int row = u.pm * 256 + ai * 128 + wr * 64 + m * 16 + fr;
                const float rs = rsqrtf(row_sum16(ssq + (size_t)row * 16, fq) * (1.0f / 1024.0f) + EPS);
                const f32x4 g0 = acc[ai][0][m][0] * rs, g1 = acc[ai][0][m][1] * rs, u0 = acc[ai][1][m][0] * rs, u1 = acc[ai][1][m][1] * rs;
                const f32x4 a0 = g0 * sig4(g0) * u0, a1 = g1 * sig4(g1) * u1;
                *(u32x4*)(act + (size_t)row * DFF + u.pn * 128 + wc * 32 + 8 * fq) = pack8(a0, a1);
            }
    }
};

template <int DQK, int DV, int MODE>
__device__ __forceinline__ void attn_unit(LAS unsigned char* lds, const int tid, const bf16_t* Qg, int ldq, const bf16_t* Kg, int ldk, const bf16_t* K2g,
                                          const bf16_t* Vg, int ldv, bf16_t* Og, int ldo, int qbase, int NT, const float* kbar, int cur) {
    constexpr int KS = DQK + 8, VS = 76;
    constexpr int KBUF = 64 * KS * 2, VBUF = DV * VS * 2;
    constexpr int KMAIN = (MODE == 1) ? 64 : DQK;
    constexpr int KCH = KMAIN / 8, NK = (64 * KCH) / 512, VCH = DV / 8, NV = (64 * VCH) / 512;
    constexpr int NJ = DQK / 16, ND = DV / 32;
    const int lane = tid & 63, wid = __builtin_amdgcn_readfirstlane(tid >> 6), r32 = lane & 31, hi = lane >> 5;
    bf16x8 qf[NJ];
    { const bf16_t* qrow = Qg + (size_t)(wid * 32 + r32) * ldq + 8 * hi;
#pragma unroll
      for (int j = 0; j < NJ; ++j) qf[j] = *(const bf16x8*)(qrow + 16 * j); }
    unsigned selmask = 0xffu;
    if (MODE == 0 && cur > 3) {
        float g[7];
#pragma unroll
        for (int j = 0; j < 7; ++j) {
            float a = 0.f;
            if (j < cur) {
#pragma unroll
                for (int jj = 0; jj < 4; ++jj) {
                    const f32x4 k0 = *(const f32x4*)(kbar + j * 64 + 16 * jj + 8 * hi), k1 = *(const f32x4*)(kbar + j * 64 + 16 * jj + 8 * hi + 4);
                    a += bf2f((unsigned short)qf[jj][0]) * k0.x + bf2f((unsigned short)qf[jj][1]) * k0.y + bf2f((unsigned short)qf[jj][2]) * k0.z + bf2f((unsigned short)qf[jj][3]) * k0.w
                       + bf2f((unsigned short)qf[jj][4]) * k1.x + bf2f((unsigned short)qf[jj][5]) * k1.y + bf2f((unsigned short)qf[jj][6]) * k1.z + bf2f((unsigned short)qf[jj][7]) * k1.w;
                }
                a += __shfl_xor(a, 32);
            }
            g[j] = a;
        }
        unsigned sm = 0u;
#pragma unroll
        for (int j = 0; j < 7; ++j) {
            int rank = 0;
#pragma unroll
            for (int i = 0; i < 7; ++i) if (i != j) rank += (i < cur && (g[i] > g[j] || (g[i] == g[j] && i < j))) ? 1 : 0;
            if (j < cur && rank < 3) sm |= (1u << j);
        }
        selmask = sm | (1u << cur);
    }
    u32x4 kreg[NK], vreg[NV], k2reg = {0u, 0u, 0u, 0u};
#define ATT_LOAD(t) do { \
    _Pragma("unroll") for (int i = 0; i < NK; ++i) { const int idx = tid + 512 * i, kv = idx / KCH, c = idx % KCH; kreg[i] = *(const u32x4*)(Kg + (size_t)(64 * (t) + kv) * ldk + 8 * c); } \
    if (MODE == 1) { if (tid < 256) k2reg = *(const u32x4*)(K2g + (size_t)(64 * (t) + (tid >> 2)) * 32 + 8 * (tid & 3)); } \
    _Pragma("unroll") for (int i = 0; i < NV; ++i) { const int idx = tid + 512 * i, kv = idx / VCH, c = idx % VCH; vreg[i] = *(const u32x4*)(Vg + (size_t)(64 * (t) + kv) * ldv + 8 * c); } } while (0)
#define ATT_STORE(buf) do { LAS unsigned char* kb_ = lds + (buf) * KBUF; LAS unsigned char* vb_ = lds + 2 * KBUF + (buf) * VBUF; \
    _Pragma("unroll") for (int i = 0; i < NK; ++i) { const int idx = tid + 512 * i, kv = idx / KCH, c = idx % KCH; *(LAS u32x4*)(kb_ + (kv * KS + 8 * c) * 2) = kreg[i]; } \
    if (MODE == 1) { if (tid < 256) *(LAS u32x4*)(kb_ + ((tid >> 2) * KS + 64 + 8 * (tid & 3)) * 2) = k2reg; } \
    _Pragma("unroll") for (int i = 0; i < NV; ++i) { const int idx = tid + 512 * i, kv = idx / VCH, c = idx % VCH; LAS unsigned short* vp_ = (LAS unsigned short*)(vb_ + ((8 * c) * VS + kv) * 2); \
        vp_[0 * VS] = (unsigned short)(vreg[i].x & 0xffffu); vp_[1 * VS] = (unsigned short)(vreg[i].x >> 16); vp_[2 * VS] = (unsigned short)(vreg[i].y & 0xffffu); vp_[3 * VS] = (unsigned short)(vreg[i].y >> 16); \
        vp_[4 * VS] = (unsigned short)(vreg[i].z & 0xffffu); vp_[5 * VS] = (unsigned short)(vreg[i].z >> 16); vp_[6 * VS] = (unsigned short)(vreg[i].w & 0xffffu); vp_[7 * VS] = (unsigned short)(vreg[i].w >> 16); } } while (0)
    ATT_LOAD(0); ATT_STORE(0);
    __syncthreads();
    f32x16 o[ND];
#pragma unroll
    for (int d0 = 0; d0 < ND; ++d0)
#pragma unroll
        for (int r = 0; r < 16; ++r) o[d0][r] = 0.f;
    float mrun = -INFINITY, lrun = 0.f;
    const int qabs = qbase + wid * 32 + r32;
    const int qwmax = qbase + wid * 32 + 31;
    for (int t = 0; t < NT; ++t) {
        const int buf = t & 1;
        if (t + 1 < NT) ATT_LOAD(t + 1);
        bool lane_ok = true, causal = false, active = true;
        if (MODE == 0) { const int blk = t >> 2; if (blk < cur) lane_ok = ((selmask >> blk) & 1u) != 0u; else causal = true; active = __any(lane_ok ? 1 : 0) != 0; }
        if (MODE == 1) { causal = (64 * t + 63 > qbase + wid * 32); active = (64 * t <= qwmax); }
        if (active) {
            const LAS unsigned char* kb = lds + buf * KBUF + (r32 * KS + 8 * hi) * 2;
            f32x16 s0, s1;
#pragma unroll
            for (int r = 0; r < 16; ++r) { s0[r] = 0.f; s1[r] = 0.f; }
#pragma unroll
            for (int j = 0; j < NJ; ++j) {
                const bf16x8 k0 = *(const LAS bf16x8*)(kb + j * 32), k1 = *(const LAS bf16x8*)(kb + 32 * KS * 2 + j * 32);
                s0 = __builtin_amdgcn_mfma_f32_32x32x16_bf16(k0, qf[j], s0, 0, 0, 0);
                s1 = __builtin_amdgcn_mfma_f32_32x32x16_bf16(k1, qf[j], s1, 0, 0, 0);
            }
            if (MODE != 2) {
                if (!lane_ok) {
#pragma unroll
                    for (int r = 0; r < 16; ++r) { s0[r] = -INFINITY; s1[r] = -INFINITY; }
                } else if (causal) {
                    const int kb0 = 64 * t + 4 * hi;
#pragma unroll
                    for (int r = 0; r < 16; ++r) { const int kv = kb0 + (r & 3) + 8 * (r >> 2); if (kv > qabs) s0[r] = -INFINITY; if (kv + 32 > qabs) s1[r] = -INFINITY; }
                }
            }
            float mx = fmaxf(s0[0], s1[0]);
#pragma unroll
            for (int r = 1; r < 16; ++r) mx = fmaxf(mx, fmaxf(s0[r], s1[r]));
            mx = fmaxf(mx, __shfl_xor(mx, 32));
            const float mnew = fmaxf(mrun, mx);
            const float muse = (mnew == -INFINITY) ? 0.f : mnew;
            const float alpha = __builtin_amdgcn_exp2f(mrun - muse);
            mrun = mnew;
            float ps = 0.f;
#pragma unroll
            for (int r = 0; r < 16; ++r) { s0[r] = __builtin_amdgcn_exp2f(s0[r] - muse); s1[r] = __builtin_amdgcn_exp2f(s1[r] - muse); ps += s0[r] + s1[r]; }
            lrun = lrun * alpha + ps;
#pragma unroll
            for (int d0 = 0; d0 < ND; ++d0)
#pragma unroll
                for (int r = 0; r < 16; ++r) o[d0][r] *= alpha;
            bf16x8 pb[4];
            { u32x4 w;
              w.x = cvt_pk_bf16(s0[0], s0[1]); w.y = cvt_pk_bf16(s0[2], s0[3]); w.z = cvt_pk_bf16(s0[4], s0[5]); w.w = cvt_pk_bf16(s0[6], s0[7]); pb[0] = __builtin_bit_cast(bf16x8, w);
              w.x = cvt_pk_bf16(s0[8], s0[9]); w.y = cvt_pk_bf16(s0[10], s0[11]); w.z = cvt_pk_bf16(s0[12], s0[13]); w.w = cvt_pk_bf16(s0[14], s0[15]); pb[1] = __builtin_bit_cast(bf16x8, w);
              w.x = cvt_pk_bf16(s1[0], s1[1]); w.y = cvt_pk_bf16(s1[2], s1[3]); w.z = cvt_pk_bf16(s1[4], s1[5]); w.w = cvt_pk_bf16(s1[6], s1[7]); pb[2] = __builtin_bit_cast(bf16x8, w);
              w.x = cvt_pk_bf16(s1[8], s1[9]); w.y = cvt_pk_bf16(s1[10], s1[11]); w.z = cvt_pk_bf16(s1[12], s1[13]); w.w = cvt_pk_bf16(s1[14], s1[15]); pb[3] = __builtin_bit_cast(bf16x8, w); }
            const LAS unsigned char* vb = lds + 2 * KBUF + buf * VBUF + (r32 * VS + 4 * hi) * 2;
#pragma unroll
            for (int d0 = 0; d0 < ND; ++d0)
#pragma unroll
                for (int kk = 0; kk < 4; ++kk) {
                    const u32x2 a = *(const LAS u32x2*)(vb + (32 * d0 * VS + 16 * kk) * 2), b = *(const LAS u32x2*)(vb + (32 * d0 * VS + 16 * kk + 8) * 2);
                    const u32x4 w = {a.x, a.y, b.x, b.y};
                    o[d0] = __builtin_amdgcn_mfma_f32_32x32x16_bf16(__builtin_bit_cast(bf16x8, w), pb[kk], o[d0], 0, 0, 0);
                }
        }
        if (t + 1 < NT) ATT_STORE(buf ^ 1);
        __syncthreads();
    }
#undef ATT_LOAD
#undef ATT_STORE
    lrun += __shfl_xor(lrun, 32);
    const float inv = 1.0f / lrun;
    bf16_t* orow = Og + (size_t)(wid * 32 + r32) * ldo + 4 * hi;
#pragma unroll
    for (int d0 = 0; d0 < ND; ++d0)
#pragma unroll
        for (int rg = 0; rg < 4; ++rg) {
            u32x2 w; w.x = cvt_pk_bf16(o[d0][4 * rg] * inv, o[d0][4 * rg + 1] * inv); w.y = cvt_pk_bf16(o[d0][4 * rg + 2] * inv, o[d0][4 * rg + 3] * inv);
            *(u32x2*)(orow + 32 * d0 + 8 * rg) = w;
        }
}

__device__ __forceinline__ float wave_sum(float v) {
#pragma unroll
    for (int o = 1; o < 64; o <<= 1) v += __shfl_xor(v, o);
    return v;
}
template <class MapFn>
__device__ __forceinline__ void transpose_item(const float* W, int K, int N, bf16_t* WT, const float* gain, LAS float* scr, int item, int lane, MapFn map) {
    const int nblk = N / 32, kb = item / nblk, nb = item % nblk, k0 = 64 * kb, n0 = 32 * nb;
#pragma unroll 8
    for (int i = 0; i < 32; ++i) { const int kk = 2 * i + (lane >> 5); float w = W[(size_t)(k0 + kk) * N + n0 + (lane & 31)]; if (gain) w *= gain[k0 + kk]; scr[kk * 33 + (lane & 31)] = w; }
    asm volatile("s_waitcnt lgkmcnt(0)" ::: "memory");
    const int c = lane & 7;
#pragma unroll
    for (int j = 0; j < 4; ++j) { const int n = (lane >> 3) + 8 * j; const LAS float* s = scr + (8 * c) * 33 + n;
        u32x4 o; o.x = cvt_pk_bf16(s[0 * 33], s[1 * 33]); o.y = cvt_pk_bf16(s[2 * 33], s[3 * 33]); o.z = cvt_pk_bf16(s[4 * 33], s[5 * 33]); o.w = cvt_pk_bf16(s[6 * 33], s[7 * 33]);
        *(u32x4*)(WT + (size_t)map(n0 + n) * K + k0 + 8 * c) = o; }
    asm volatile("s_waitcnt lgkmcnt(0)" ::: "memory");
}
__device__ __forceinline__ int map_in(int n) {
    if (n < 1024) { const int base = n & 512, mm = n & 511, head = mm >> 6, e = mm & 63; return base + 256 * (head >> 2) + 128 * (e >> 5) + 32 * (head & 3) + (e & 31); }
    if (n < 1920) return n;
    if (n < 2176) return 2048 + (n - 1920);
    if (n < 2208) return 1920 + (n - 2176);
    return 2304 + (n - 2208);
}
__device__ __forceinline__ int map_uq(int n) { const int head = n / 96, e = n % 96; if (e < 64) return 64 * head + e; const int r = e - 64; return 512 + 128 * (r >> 4) + 16 * head + (r & 15); }
__device__ __forceinline__ int map_gu(int n) { if (n < DFF) return 256 * (n >> 7) + (n & 127); const int a = n - DFF; return 256 * (a >> 7) + 128 + (a & 127); }
__device__ __forceinline__ int map_id(int n) { return n; }

struct Args {
    const float* x; const float* mem; const int* pos;
    const float* norm_mix; const float* w_in; const float* q_lat_norm; const float* w_uq; const float* kv_lat_norm; const float* w_ukv;
    const float* w_ba; const float* w_bb; const float* w_out; const float* norm_x; const float* norm_mem; const float* w_xq; const float* w_xkv; const float* w_xo;
    const float* norm_ffn; const float* w_gu; const float* w_dn; const float* norm_final;
    float* out; unsigned char* ws; int ph_lo, ph_hi;
};

constexpr int PH_PER_LAYER = 11, N_PHASES = DEPTH * PH_PER_LAYER + 1;
constexpr int LDS_TOTAL = pg8::STAGE_BYTES;

__global__ void __launch_bounds__(512, 2) fwd_kernel(Args a_in) {
    __shared__ __attribute__((aligned(16))) unsigned char lds_raw[LDS_TOTAL];
    LAS unsigned char* lds = (LAS unsigned char*)lds_raw;
    const int ph_lo = a_in.ph_lo, ph_hi = a_in.ph_hi;
    for (int ph = ph_lo; ph < ph_hi; ++ph) {
        if (ph > ph_lo) { cg::this_grid().sync(); }
        int tid = threadIdx.x; asm volatile("" : "+v"(tid));
        int G = gridDim.x, bx = blockIdx.x; asm volatile("" : "+s"(G), "+s"(bx));
        const int lane = tid & 63, wave = __builtin_amdgcn_readfirstlane(tid >> 6);
        const int vcu = (G % 8 == 0) ? (bx % 8) * (G / 8) + bx / 8 : bx;
        const int gw = vcu * 8 + wave, NGW = G * 8;
        const __attribute__((address_space(4))) Args* ap = (const __attribute__((address_space(4))) Args*)__builtin_amdgcn_kernarg_segment_ptr(); asm volatile("" : "+s"(ap));
        const __attribute__((address_space(4))) Args& a = *ap;
        unsigned char* ws = a.ws; float* aout = a.out; const float* ax = a.x;
        asm volatile("" : "+s"(ws), "+s"(aout), "+s"(ax));
        bf16_t* Win_t = (bf16_t*)(ws + WS_WIN); bf16_t* Wuq_t = (bf16_t*)(ws + WS_WUQ); bf16_t* Wukv_t = (bf16_t*)(ws + WS_WUKV);
        bf16_t* Wba_t = (bf16_t*)(ws + WS_WBA); bf16_t* Wbb_t = (bf16_t*)(ws + WS_WBB); bf16_t* Wout_t = (bf16_t*)(ws + WS_WOUT);
        bf16_t* Wxq_t = (bf16_t*)(ws + WS_WXQ); bf16_t* Wxkv_t = (bf16_t*)(ws + WS_WXKV); bf16_t* Wxo_t = (bf16_t*)(ws + WS_WXO);
        bf16_t* Wgu_t = (bf16_t*)(ws + WS_WGU); bf16_t* Wdn_t = (bf16_t*)(ws + WS_WDN);
        bf16_t* XB = (bf16_t*)(ws + WS_XB); bf16_t* QB = (bf16_t*)(ws + WS_XB);
        bf16_t* QKVA = (bf16_t*)(ws + WS_QKVA); bf16_t* QX = (bf16_t*)(ws + WS_QKVA);
        bf16_t* LAT = (bf16_t*)(ws + WS_LAT); bf16_t* OB = (bf16_t*)(ws + WS_LAT);
        bf16_t* KVLAT = (bf16_t*)(ws + WS_KVLAT); bf16_t* GATES = (bf16_t*)(ws + WS_GATES); bf16_t* ACT = (bf16_t*)(ws + WS_ACT);
        bf16_t* KVB = (bf16_t*)(ws + WS_KVB); bf16_t* KVX = (bf16_t*)(ws + WS_KVX); bf16_t* MEMB = (bf16_t*)(ws + WS_MEMB); bf16_t* KPE = (bf16_t*)(ws + WS_KPE);
        float* COSA = (float*)(ws + WS_COSA); float* SINA = (float*)(ws + WS_SINA); float* COSB = (float*)(ws + WS_COSB); float* SINB = (float*)(ws + WS_SINB);
        float* SSQ = (float*)(ws + WS_SSQ); float* LSSQ = (float*)(ws + WS_LSSQ); float* RSTDM = (float*)(ws + WS_RSTDM); float* KBAR = (float*)(ws + WS_KBAR);

        if (ph == N_PHASES - 1) {
            if (!PHON(11)) continue;
            for (int row = gw; row < M; row += NGW) {
                const f32x4* sp = (const f32x4*)(SSQ + (size_t)row * 16);
                const f32x4 p0 = sp[0], p1 = sp[1], p2 = sp[2], p3 = sp[3];
                const float s = ((p0.x + p0.y) + (p0.z + p0.w)) + ((p1.x + p1.y) + (p1.z + p1.w)) + ((p2.x + p2.y) + (p2.z + p2.w)) + ((p3.x + p3.y) + (p3.z + p3.w));
                const float rs = rsqrtf(s * (1.0f / 1024.0f) + EPS);
                f32x4* xr = (f32x4*)(aout + (size_t)row * DM) + lane; const f32x4* gr = (const f32x4*)a.norm_final + lane;
#pragma unroll
                for (int j = 0; j < 4; ++j) { const f32x4 v = xr[64 * j], g = gr[64 * j]; xr[64 * j] = v * rs * g; }
            }
            continue;
        }
        const int l = ph / PH_PER_LAYER, p = ph % PH_PER_LAYER;
        const float* xin = (l == 0 && p == 5) ? ax : aout;
        if (!PHON(p)) continue;
        if (p == 0) {
            LAS float* scr = (LAS float*)(lds + wave * 16384);
            constexpr int I_IN = 16 * (IN_W / 32), I_UQ = 6 * 24, I_UKV = 4 * 32, I_BA = 8 * 32, I_OUT = 16 * 32, I_XQ = 16 * 16, I_XKV = 16 * 32, I_XO = 8 * 32, I_GU = 16 * (2 * DFF / 32), I_DN = (DFF / 64) * 32;
            constexpr int NIT = I_IN + I_UQ + I_UKV + 2 * I_BA + I_OUT + I_XQ + I_XKV + I_XO + I_GU + I_DN;
            for (int it = gw; it < NIT; it += NGW) {
                int r = it;
                if (r < I_IN) { transpose_item(a.w_in + (size_t)l * DM * IN_W, DM, IN_W, Win_t, a.norm_mix + l * DM, scr, r, lane, map_in); continue; } r -= I_IN;
                if (r < I_UQ) { transpose_item(a.w_uq + (size_t)l * 384 * 768, 384, 768, Wuq_t, a.q_lat_norm + l * 384, scr, r, lane, map_uq); continue; } r -= I_UQ;
                if (r < I_UKV) { transpose_item(a.w_ukv + (size_t)l * 256 * 1024, 256, 1024, Wukv_t, a.kv_lat_norm + l * 256, scr, r, lane, map_id); continue; } r -= I_UKV;
                if (r < I_BA) { transpose_item(a.w_ba + (size_t)l * 512 * 1024, 512, 1024, Wba_t, nullptr, scr, r, lane, map_id); continue; } r -= I_BA;
                if (r < I_BA) { transpose_item(a.w_bb + (size_t)l * 512 * 1024, 512, 1024, Wbb_t, nullptr, scr, r, lane, map_id); continue; } r -= I_BA;
                if (r < I_OUT) { transpose_item(a.w_out + (size_t)l * 1024 * 1024, 1024, 1024, Wout_t, nullptr, scr, r, lane, map_id); continue; } r -= I_OUT;
                if (r < I_XQ) { transpose_item(a.w_xq + (size_t)l * 1024 * 512, 1024, 512, Wxq_t, a.norm_x + l * DM, scr, r, lane, map_id); continue; } r -= I_XQ;
                if (r < I_XKV) { transpose_item(a.w_xkv + (size_t)l * 1024 * 1024, 1024, 1024, Wxkv_t, a.norm_mem + l * DM, scr, r, lane, map_id); continue; } r -= I_XKV;
                if (r < I_XO) { transpose_item(a.w_xo + (size_t)l * 512 * 1024, 512, 1024, Wxo_t, nullptr, scr, r, lane, map_id); continue; } r -= I_XO;
                if (r < I_GU) { transpose_item(a.w_gu + (size_t)l * 1024 * 2 * DFF, 1024, 2 * DFF, Wgu_t, a.norm_ffn + l * DM, scr, r, lane, map_gu); continue; } r -= I_GU;
                transpose_item(a.w_dn + (size_t)l * DFF * 1024, DFF, 1024, Wdn_t, nullptr, scr, r, lane, map_id);
            }
            for (int i = vcu * 512 + tid; i < 96 * 1024 / 8; i += G * 512) *(u32x4*)(Win_t + (size_t)1952 * 1024 + (size_t)i * 8) = (u32x4){0u, 0u, 0u, 0u};
            if (l == 0) {
                for (int row = gw; row < M + MM; row += NGW) {
                    const bool ism = row >= M; const int r = ism ? row - M : row;
                    const f32x4* xr = (const f32x4*)((ism ? a.mem : ax) + (size_t)r * DM) + lane;
                    f32x4 v[4]; float s = 0.f;
#pragma unroll
                    for (int j = 0; j < 4; ++j) { v[j] = xr[64 * j]; s += sq4(v[j]); }
                    s = wave_sum(s);
                    u32x2* o8 = (u32x2*)((ism ? MEMB : XB) + (size_t)r * DM) + lane;
#pragma unroll
                    for (int j = 0; j < 4; ++j) { u32x2 w; w.x = cvt_pk_bf16(v[j].x, v[j].y); w.y = cvt_pk_bf16(v[j].z, v[j].w); o8[64 * j] = w; }
                    if (ism) { if (lane == 0) RSTDM[r] = rsqrtf(s * (1.0f / 1024.0f) + EPS); }
                    else if (lane < 16) SSQ[(size_t)r * 16 + lane] = (lane == 0) ? s : 0.f;
                }
                for (int i = vcu * 512 + tid; i < M * 32; i += G * 512) {
                    const int row = i >> 5, k = i & 31; const float posf = (float)a.pos[row];
                    const float inv = expf(-9.210340371976184f * (2.0f / 64.0f) * (float)k);
                    float sn, cs; sincosf(posf * inv, &sn, &cs); COSA[i] = cs; SINA[i] = sn;
                    if (k < 16) { const float invb = expf(-9.210340371976184f * (2.0f / 32.0f) * (float)k); float sb, cb; sincosf(posf * invb, &sb, &cb); COSB[row * 16 + k] = cb; SINB[row * 16 + k] = sb; }
                }
            }
            __syncthreads();
        } else if (p == 1) {
            pg8::Gemm g{XB, Win_t, M, IN_WP, DM, DM}; pg8::StaticOrder S; S.init(M, IN_WP, G, bx);
            EpiIn E{SSQ, QKVA, LAT, KVLAT, GATES, LSSQ, COSA, SINA};
            pg8::gemm_phase(lds, tid, g, S, E);
        } else if (p == 2) {
            if (P2ON(0)) { LAS float* red = (LAS float*)lds;
              for (int it = vcu; it < 128 * 8; it += G) {
                  const int bh = it >> 3, j = it & 7, b = bh >> 3, h = bh & 7;
                  const bf16_t* kp = QKVA + (size_t)(b * SEQ + j * 256 + wave * 32) * 1536 + 512 + h * 64 + lane;
                  float s = 0.f;
#pragma unroll 8
                  for (int r = 0; r < 32; ++r) s += bf2f(kp[(size_t)r * 1536]);
                  red[wave * 64 + lane] = s;
                  __syncthreads();
                  if (wave == 0) { float t = 0.f;
#pragma unroll
                      for (int w = 0; w < 8; ++w) t += red[w * 64 + lane];
                      KBAR[(size_t)it * 64 + lane] = t * (1.0f / 256.0f); }
                  __syncthreads();
              }
              for (int i = vcu * 512 + tid; i < M * 16; i += G * 512) {
                  const int row = i >> 4, k = i & 15;
                  const float x1 = bf2f(LAT[(size_t)row * 512 + 384 + k]), x2 = bf2f(LAT[(size_t)row * 512 + 400 + k]);
                  const float c = COSB[i], s = SINB[i];
                  KPE[(size_t)row * 32 + k] = f2bf1(x1 * c - x2 * s); KPE[(size_t)row * 32 + 16 + k] = f2bf1(x2 * c + x1 * s);
              }
              __syncthreads(); }
            if (P2ON(1)) { unsigned char* w = ws; int tl = tid; asm volatile("" : "+s"(w), "+v"(tl));
              pg8::Gemm g{(bf16_t*)(w + WS_LAT), (bf16_t*)(w + WS_WUQ), M, 768, 384, 512}; pg8::StaticOrder S; S.init(M, 768, G, bx);
              EpiUq E{(float*)(w + WS_LSSQ), (bf16_t*)(w + WS_XB), (float*)(w + WS_COSB), (float*)(w + WS_SINB)}; pg8::gemm_phase(lds, tl, g, S, E); }
            if (P2ON(2)) { unsigned char* w = ws; int tl = tid; asm volatile("" : "+s"(w), "+v"(tl));
              pg8::Gemm g{(bf16_t*)(w + WS_KVLAT), (bf16_t*)(w + WS_WUKV), M, 1024, 256, 256}; pg8::StaticOrder S; S.init(M, 1024, G, G - 1 - bx);
              EpiRowScale<0> E{(float*)(w + WS_LSSQ), (bf16_t*)(w + WS_KVB), 1024, 1.f}; pg8::gemm_phase(lds, tl, g, S, E); }
            if (P2ON(3)) { unsigned char* w = ws; int tl = tid; asm volatile("" : "+s"(w), "+v"(tl));
              pg8::Gemm g{(bf16_t*)(w + WS_MEMB), (bf16_t*)(w + WS_WXKV), MM, 1024, 1024, 1024}; pg8::StaticOrder S; S.init(MM, 1024, G, (bx + 128) % G);
              EpiRowScale<1> E{(float*)(w + WS_RSTDM), (bf16_t*)(w + WS_KVX), 1024, 1.f}; pg8::gemm_phase(lds, tl, g, S, E); }
        } else if (p == 3) {
            for (int v = vcu; v < 256; v += G) {
                const int bh = v >> 1, b = bh >> 3, h = bh & 7;
#pragma unroll 1
                for (int i = 0; i < 4; ++i) {
                    const int cur = (v & 1) ? ((i == 0) ? 2 : (i == 1) ? 5 : (i == 2) ? 3 : 4) : ((i == 0) ? 0 : (i == 1) ? 7 : (i == 2) ? 1 : 6);
                    const size_t rowb = (size_t)b * SEQ, rowq = rowb + cur * 256;
                    attn_unit<64, 64, 0>(lds, tid, QKVA + rowq * 1536 + h * 64, 1536, QKVA + rowb * 1536 + 512 + h * 64, 1536, nullptr,
                                         QKVA + rowb * 1536 + 1024 + h * 64, 1536, QKVA + rowq * 1536 + h * 64, 1536, cur * 256, 4 * (cur + 1), KBAR + (size_t)bh * 512, cur);
                }
#pragma unroll 1
                for (int i = 0; i < 4; ++i) {
                    const int cur = (v & 1) ? ((i == 0) ? 2 : (i == 1) ? 5 : (i == 2) ? 3 : 4) : ((i == 0) ? 0 : (i == 1) ? 7 : (i == 2) ? 1 : 6);
                    const size_t rowb = (size_t)b * SEQ, rowq = rowb + cur * 256;
                    attn_unit<96, 64, 1>(lds, tid, QB + rowq * 768 + h * 96, 768, KVB + rowb * 1024 + h * 128, 1024, KPE + rowb * 32,
                                         KVB + rowb * 1024 + h * 128 + 64, 1024, OB + rowq * 512 + h * 64, 512, cur * 256, 4 * (cur + 1), nullptr, cur);
                }
            }
        } else if (p == 4) {
            { unsigned char* w = ws; int tl = tid; asm volatile("" : "+s"(w), "+v"(tl));
              pg8::Gemm g{(bf16_t*)(w + WS_QKVA), (bf16_t*)(w + WS_WBA), M, 1024, 512, 1536}; pg8::StaticOrder S; S.init(M, 1024, G, bx); EpiBranch<0> E{(bf16_t*)(w + WS_GATES)}; pg8::gemm_phase(lds, tl, g, S, E); }
            { unsigned char* w = ws; int tl = tid; asm volatile("" : "+s"(w), "+v"(tl));
              pg8::Gemm g{(bf16_t*)(w + WS_LAT), (bf16_t*)(w + WS_WBB), M, 1024, 512, 512}; pg8::StaticOrder S; S.init(M, 1024, G, bx); EpiBranch<1> E{(bf16_t*)(w + WS_GATES)}; pg8::gemm_phase(lds, tl, g, S, E); }
        } else if (p == 5) {
            pg8::Gemm g{GATES, Wout_t, M, 1024, 1024, 2048}; pg8::StaticOrder S; S.init(M, 1024, G, bx);
            EpiRes E{xin, aout, XB, SSQ}; pg8::gemm_phase(lds, tid, g, S, E);
        } else if (p == 6) {
            pg8::Gemm g{XB, Wxq_t, M, 512, 1024, 1024}; pg8::StaticOrder S; S.init(M, 512, G, bx);
            EpiRowScale<2> E{SSQ, QX, 512, C2X}; pg8::gemm_phase(lds, tid, g, S, E);
        } else if (p == 7) {
            for (int un = vcu * 2; un < 512; un += 2 * G)
#pragma unroll 1
                for (int i = 0; i < 2; ++i) {
                    const int unit = un + i, bh = unit >> 3, qb = unit & 7, b = bh >> 2, h = bh & 3;
                    const size_t rowq = (size_t)b * SEQ + qb * 256, rowm = (size_t)b * MEMLEN;
                    attn_unit<128, 128, 2>(lds, tid, QX + rowq * 512 + h * 128, 512, KVX + rowm * 1024 + h * 128, 1024, nullptr,
                                           KVX + rowm * 1024 + 512 + h * 128, 1024, QX + rowq * 512 + h * 128, 512, 0, 4, nullptr, 0);
                }
        } else if (p == 8) {
            pg8::Gemm g{QX, Wxo_t, M, 1024, 512, 512}; pg8::StaticOrder S; S.init(M, 1024, G, bx);
            EpiRes E{aout, aout, XB, SSQ}; pg8::gemm_phase(lds, tid, g, S, E);
        } else if (p == 9) {
            pg8::Gemm g{XB, Wgu_t, M, 2 * DFF, 1024, 1024}; pg8::StaticOrder S; S.init(M, 2 * DFF, G, bx);
            EpiGU E{SSQ, ACT}; pg8::gemm_phase(lds, tid, g, S, E);
        } else {
            pg8::Gemm g{ACT, Wdn_t, M, 1024, DFF, DFF}; pg8::StaticOrder S; S.init(M, 1024, G, bx);
            EpiRes E{aout, aout, XB, SSQ}; pg8::gemm_phase(lds, tid, g, S, E);
        }
    }
}

extern "C" void kernel_launch(void* const* d_in, const int* in_sizes, int n_in, void* d_out, int out_size, void* d_ws, size_t ws_size, hipStream_t stream) {
    static int grid = 0;
    if (grid == 0) {
        if (n_in != 21 || in_sizes[0] != M * DM || out_size != M * DM || ws_size < WS_END) {
            fprintf(stderr, "kernel_launch: unexpected shapes (n_in %d, in0 %d, out %d, ws %zu); nothing launched\n", n_in, n_in > 0 ? in_sizes[0] : -1, out_size, ws_size); grid = -1; return; }
        int dev = 0, cus = 0, per_cu = 0;
        hipGetDevice(&dev); hipDeviceGetAttribute(&cus, hipDeviceAttributeMultiprocessorCount, dev);
        if (hipOccupancyMaxActiveBlocksPerMultiprocessor(&per_cu, (const void*)fwd_kernel, 512, 0) != hipSuccess || per_cu < 1) per_cu = 1;
        (void)hipGetLastError();
        grid = cus * 1;
        if (grid <= 0) grid = 256;
    }
    if (grid < 0) return;
    Args a{};
    a.x = (const float*)d_in[0]; a.mem = (const float*)d_in[1]; a.pos = (const int*)d_in[2];
    a.norm_mix = (const float*)d_in[3]; a.w_in = (const float*)d_in[4]; a.q_lat_norm = (const float*)d_in[5]; a.w_uq = (const float*)d_in[6];
    a.kv_lat_norm = (const float*)d_in[7]; a.w_ukv = (const float*)d_in[8]; a.w_ba = (const float*)d_in[9]; a.w_bb = (const float*)d_in[10]; a.w_out = (const float*)d_in[11];
    a.norm_x = (const float*)d_in[12]; a.norm_mem = (const float*)d_in[13]; a.w_xq = (const float*)d_in[14]; a.w_xkv = (const float*)d_in[15]; a.w_xo = (const float*)d_in[16];
    a.norm_ffn = (const float*)d_in[17]; a.w_gu = (const float*)d_in[18]; a.w_dn = (const float*)d_in[19]; a.norm_final = (const float*)d_in[20];
    a.out = (float*)d_out; a.ws = (unsigned char*)d_ws;
#if ONE_LAUNCH
    a.ph_lo = 0; a.ph_hi = N_PHASES;
    void* args[] = {&a};
    hipError_t e = hipLaunchCooperativeKernel((const void*)fwd_kernel, dim3(grid), dim3(512), args, 0, stream);
    if (e != hipSuccess) fprintf(stderr, "cooperative launch failed: %s (grid %d)\n", hipGetErrorString(e), grid);
#else
    for (int ph = 0; ph < N_PHASES; ++ph) {
        a.ph_lo = ph; a.ph_hi = ph + 1;
        hipLaunchKernelGGL(fwd_kernel, dim3(grid), dim3(512), 0, stream, a);
    }
#endif
}
```

```cpp
#include <hip/hip_runtime.h>
#include <hip/hip_cooperative_groups.h>
#include <cstdio>
#include <cstdint>
namespace cg = cooperative_groups;

#ifndef ONE_LAUNCH
#define ONE_LAUNCH 1
#endif

#ifndef PHMASK
#define PHMASK 0xFFFF
#endif
#ifndef P2MASK
#define P2MASK 0xF
#endif
#define P2ON(k) (((P2MASK) >> (k)) & 1)
#ifndef DUPMASK
#define DUPMASK 0
#endif
#ifndef XSYNC
#define XSYNC 0
#endif
#define DUP(k) (((DUPMASK) >> (k)) & 1)
#define PHON(k) (((PHMASK) >> (k)) & 1)
#define LAS __attribute__((address_space(3)))
typedef unsigned short bf16_t;
typedef short bf16x8 __attribute__((ext_vector_type(8)));
typedef float f32x4 __attribute__((ext_vector_type(4)));
typedef float f32x16 __attribute__((ext_vector_type(16)));
typedef unsigned u32x4 __attribute__((ext_vector_type(4)));
typedef unsigned u32x2 __attribute__((ext_vector_type(2)));

constexpr int NBATCH = 16, SEQ = 2048, DM = 1024, DEPTH = 4, MEMLEN = 256;
constexpr int M = NBATCH * SEQ;
constexpr int MM = NBATCH * MEMLEN;
constexpr int IN_W = 4256, IN_WP = 4352;
constexpr int DFF = 2816;
constexpr float EPS = 1e-6f;
constexpr float LOG2E = 1.4426950408889634f;
constexpr float C2A = 0.125f * LOG2E;
constexpr float C2B = 0.10206207261596575f * LOG2E;
constexpr float C2X = 0.08838834764831845f * LOG2E;

constexpr size_t MiB = 1u << 20;
constexpr size_t WS_WIN = 0 * MiB, WS_WUQ = 9 * MiB, WS_WUKV = 10 * MiB, WS_WBA = 11 * MiB, WS_WBB = 12 * MiB, WS_WOUT = 13 * MiB,
                 WS_WXQ = 15 * MiB, WS_WXKV = 16 * MiB, WS_WXO = 18 * MiB, WS_WGU = 19 * MiB, WS_WDN = 30 * MiB;
constexpr size_t WS_XB = 36 * MiB;
constexpr size_t WS_QKVA = 100 * MiB;
constexpr size_t WS_LAT = 196 * MiB;
constexpr size_t WS_KVLAT = 228 * MiB;
constexpr size_t WS_GATES = 244 * MiB;
constexpr size_t WS_ACT = 100 * MiB;
constexpr size_t WS_KVB = 372 * MiB;
constexpr size_t WS_KVX = 436 * MiB;
constexpr size_t WS_MEMB = 444 * MiB;
constexpr size_t WS_KPE = 452 * MiB;
constexpr size_t WS_COSA = 454 * MiB, WS_SINA = 458 * MiB;
constexpr size_t WS_COSB = 462 * MiB, WS_SINB = 464 * MiB;
constexpr size_t WS_SSQ = 466 * MiB;
constexpr size_t WS_LSSQ = 468 * MiB;
constexpr size_t WS_RSTDM = 470 * MiB;
constexpr size_t WS_KBAR = 470 * MiB + 65536;
constexpr size_t WS_CTL = 471 * MiB;
constexpr size_t WS_END = 472 * MiB;

__device__ __forceinline__ unsigned cvt_pk_bf16(float lo, float hi) { unsigned r; asm volatile("v_cvt_pk_bf16_f32 %0, %1, %2" : "=v"(r) : "v"(lo), "v"(hi)); return r; }
__device__ __forceinline__ float bf2f(unsigned short b) { return __uint_as_float(((unsigned)b) << 16); }
__device__ __forceinline__ float bflo(unsigned w) { return __uint_as_float(w << 16); }
__device__ __forceinline__ float bfhi(unsigned w) { return __uint_as_float(w & 0xffff0000u); }
__device__ __forceinline__ unsigned short f2bf1(float f) { return (unsigned short)(cvt_pk_bf16(f, 0.f) & 0xffffu); }

namespace pg8 {
constexpr int BM = 256, BK = 64, HALF = 128, HTB = HALF * BK * 2, STAGE_BYTES = 8 * HTB, NXCD = 8, WGM = 8;
__host__ __device__ __forceinline__ int lds_byte(int r, int c) { const int st = (r >> 4) * 2 + (c >> 5), rr = r & 15, cc = c & 31, ob = rr * 64 + cc * 2; return st * 1024 + (ob ^ (((ob >> 9) & 1) << 5)); }
__host__ __device__ __forceinline__ void stage_rc(int b, int& R, int& C) { const int st = b / 1024, sb = b % 1024, swz = sb ^ (((sb >> 9) & 1) << 5); R = (st >> 1) * 16 + swz / 64; C = (st & 1) * 32 + (swz % 64) / 2; }
__host__ __device__ __forceinline__ int perm32(int rho) { const int n = rho >> 4, i = rho & 15; return 8 * (i >> 2) + 4 * n + (i & 3); }

struct Unit { int pm, pn; };
struct Gemm { const bf16_t* A; const bf16_t* Bt; int M, N, K, lda; };

struct StaticOrder {
    int nM, nN, nwg, G, c;
    __device__ void init(int M_, int N_, int G_, int c_) { nM = M_ / BM; nN = N_ / BM; nwg = nM * nN; G = G_; c = c_; }
    __device__ bool next(int i, Unit& u) const {
        const long L = (long)i * G + c; if (L >= nwg) return false;
        int wgid = (int)L; { const int q = nwg / NXCD, r = nwg % NXCD, xcd = wgid % NXCD, off = wgid / NXCD; wgid = (xcd < r ? xcd * (q + 1) : r * (q + 1) + (xcd - r) * q) + off; }
        const int nig = WGM * nN, gid = wgid / nig, fm = gid * WGM, gsz = (nM - fm) < WGM ? (nM - fm) : WGM;
        u.pm = fm + ((wgid % nig) % gsz); u.pn = (wgid % nig) / gsz; return true;
    }
};

template <class Epi>
__device__ __forceinline__ void gemm_phase(LAS unsigned char* lds, const int tid, const Gemm g, const StaticOrder& S, const Epi& E) {
    const int wid = __builtin_amdgcn_readfirstlane(tid >> 6), lane = tid & 63, wr = wid >> 2, wc = wid & 3, fr = lane & 15, fq = lane >> 4;
    const int K = g.K, nt = K / BK;
    unsigned voffA[2], voffB[2];
#pragma unroll
    for (int i = 0; i < 2; ++i) { int R, C; stage_rc(tid * 16 + i * 8192, R, C); const int Rb = Epi::PERM ? ((R & ~31) + perm32(R & 31)) : R;
        voffA[i] = (unsigned)(R * g.lda + C) * 2u; voffB[i] = (unsigned)(Rb * K + C) * 2u; }
    const size_t kstep = (size_t)(BK * 2);
    const size_t hstepA = (size_t)HALF * g.lda * 2, hstepB = (size_t)HALF * K * 2;
    const size_t tstepA = 2 * hstepA, tstepB = 2 * hstepB;
    const unsigned ldsw = (unsigned)wid * 1024u;
    const int aoff = lds_byte(wr * 64 + fr, fq * 8), boff = lds_byte(wc * 32 + fr, fq * 8);
#define PG8_SA(b, h) (((b) * 2 + (h)) * HTB)
#define PG8_SB(b, h) ((4 + (b) * 2 + (h)) * HTB)
#define PG8_STAGE(bufoff, gbase, voff) do { _Pragma("unroll") for (int _i = 0; _i < 2; ++_i) \
        __builtin_amdgcn_global_load_lds((const unsigned*)((const char*)(gbase) + (voff)[_i]), (LAS unsigned*)(lds + (bufoff) + ldsw + _i * 8192), 16, 0, 0); } while (0)
#define PG8_LDA(dst, b, h) do { _Pragma("unroll") for (int m = 0; m < 4; ++m) _Pragma("unroll") for (int k = 0; k < 2; ++k) dst[m][k] = *(const LAS bf16x8*)(lds + PG8_SA(b, h) + aoff + m * 2048 + k * 1024); } while (0)
#define PG8_LDB(dst, b, h) do { _Pragma("unroll") for (int n = 0; n < 2; ++n) _Pragma("unroll") for (int k = 0; k < 2; ++k) dst[n][k] = *(const LAS bf16x8*)(lds + PG8_SB(b, h) + boff + n * 2048 + k * 1024); } while (0)
#define PG8_MMA(ai, bj, At, Bt) do { __builtin_amdgcn_s_setprio(1); _Pragma("unroll") for (int m = 0; m < 4; ++m) _Pragma("unroll") for (int n = 0; n < 2; ++n) _Pragma("unroll") for (int k = 0; k < 2; ++k) \
        acc[ai][bj][m][n] = __builtin_amdgcn_mfma_f32_16x16x32_bf16(Bt[n][k], At[m][k], acc[ai][bj][m][n], 0, 0, 0); __builtin_amdgcn_s_setprio(0); } while (0)
#define PG8_WAIT_V(n) asm volatile("s_waitcnt vmcnt(" #n ")" ::: "memory")
#define PG8_WAIT_L(n) asm volatile("s_waitcnt lgkmcnt(" #n ")" ::: "memory")
#define PG8_BAR __builtin_amdgcn_s_barrier()
#define PG8_SCHED __builtin_amdgcn_sched_barrier(0)
    Unit cur, nxt; int ui = 0;
    if (!S.next(0, cur)) return;
    f32x4 acc[2][2][4][2];
#pragma unroll
    for (int a = 0; a < 2; ++a)
#pragma unroll
        for (int b = 0; b < 2; ++b)
#pragma unroll
            for (int m = 0; m < 4; ++m)
#pragma unroll
                for (int n = 0; n < 2; ++n) acc[a][b][m][n] = (f32x4){0.f, 0.f, 0.f, 0.f};
    bf16x8 At[4][2], B0[2][2], B1[2][2];
    const char* cA = (const char*)g.A + (size_t)cur.pm * tstepA; const char* cB = (const char*)g.Bt + (size_t)cur.pn * tstepB;
    PG8_STAGE(PG8_SB(0, 0), cB, voffB); PG8_STAGE(PG8_SB(0, 1), cB + hstepB, voffB); PG8_STAGE(PG8_SA(0, 0), cA, voffA); PG8_STAGE(PG8_SA(0, 1), cA + hstepA, voffA);
    if (wr == 1) PG8_BAR;
    PG8_WAIT_V(2); PG8_BAR;
    PG8_STAGE(PG8_SB(1, 0), cB + kstep, voffB); PG8_STAGE(PG8_SA(1, 0), cA + kstep, voffA); PG8_STAGE(PG8_SB(1, 1), cB + hstepB + kstep, voffB);
    PG8_WAIT_V(6); PG8_BAR;
    for (;;) {
        const bool has_next = S.next(ui + 1, nxt);
        const char* nA = has_next ? (const char*)g.A + (size_t)nxt.pm * tstepA : cA; const char* nB = has_next ? (const char*)g.Bt + (size_t)nxt.pn * tstepB : cB;
#pragma unroll 1
        for (int t = 0; t < nt; t += 2) {
            const bool last = (t == nt - 2);
            const char* a1 = cA + (size_t)(t + 1) * kstep;
            const char* a2 = last ? nA : cA + (size_t)(t + 2) * kstep; const char* b2 = last ? nB : cB + (size_t)(t + 2) * kstep;
            const char* a3 = a2 + kstep; const char* b3 = b2 + kstep;
            PG8_LDB(B0, 0, 0); PG8_LDB(B1, 0, 1); PG8_SCHED; PG8_LDA(At, 0, 0); PG8_STAGE(PG8_SA(1, 1), a1 + hstepA, voffA);
            PG8_WAIT_V(8); PG8_WAIT_L(0); PG8_BAR; PG8_MMA(0, 0, At, B0); PG8_MMA(0, 1, At, B1); PG8_BAR; PG8_SCHED;
            PG8_LDA(At, 0, 1); PG8_STAGE(PG8_SB(0, 0), b2, voffB); PG8_STAGE(PG8_SB(0, 1), b2 + hstepB, voffB); PG8_STAGE(PG8_SA(0, 0), a2, voffA);
            PG8_WAIT_V(8); PG8_WAIT_L(0); PG8_BAR; PG8_MMA(1, 0, At, B0); PG8_MMA(1, 1, At, B1); PG8_BAR; PG8_SCHED;
            PG8_LDB(B0, 1, 0); PG8_LDB(B1, 1, 1); PG8_SCHED; PG8_LDA(At, 1, 0); PG8_STAGE(PG8_SA(0, 1), a2 + hstepA, voffA);
            PG8_WAIT_V(8); PG8_WAIT_L(0); PG8_BAR; PG8_MMA(0, 0, At, B0); PG8_MMA(0, 1, At, B1); PG8_BAR; PG8_SCHED;
            PG8_LDA(At, 1, 1); PG8_STAGE(PG8_SB(1, 0), b3, voffB); PG8_STAGE(PG8_SB(1, 1), b3 + hstepB, voffB); PG8_STAGE(PG8_SA(1, 0), a3, voffA);
            PG8_WAIT_V(8); PG8_WAIT_L(0); PG8_BAR; PG8_MMA(1, 0, At, B0); PG8_MMA(1, 1, At, B1); PG8_BAR; PG8_SCHED;
        }
        if (wr == 0) PG8_BAR;
        E(acc, cur, wr, wc, fr, fq);
        if (!has_next) break;
#pragma unroll
        for (int a = 0; a < 2; ++a)
#pragma unroll
            for (int b = 0; b < 2; ++b)
#pragma unroll
                for (int m = 0; m < 4; ++m)
#pragma unroll
                    for (int n = 0; n < 2; ++n) acc[a][b][m][n] = (f32x4){0.f, 0.f, 0.f, 0.f};
        cur = nxt; cA = nA; cB = nB; ++ui;
        if (wr == 1) PG8_BAR;
    }
    PG8_WAIT_V(0);
    PG8_BAR;
#undef PG8_SA
#undef PG8_SB
#undef PG8_STAGE
#undef PG8_LDA
#undef PG8_LDB
#undef PG8_MMA
#undef PG8_WAIT_V
#undef PG8_WAIT_L
#undef PG8_BAR
#undef PG8_SCHED
}
}

typedef const f32x4 (&AccRef)[2][2][4][2];

__device__ __forceinline__ float row_sum16(const float* p, int fq) {
    const f32x4 v = *(const f32x4*)(p + 4 * fq);
    float s = (v.x + v.y) + (v.z + v.w); s += __shfl_xor(s, 16); s += __shfl_xor(s, 32); return s;
}
__device__ __forceinline__ float quad_sum(float s) { s += __shfl_xor(s, 16); s += __shfl_xor(s, 32); return s; }
__device__ __forceinline__ float sq4(f32x4 v) { return (v.x * v.x + v.y * v.y) + (v.z * v.z + v.w * v.w); }
__device__ __forceinline__ u32x4 pack8(f32x4 a, f32x4 b) { u32x4 w; w.x = cvt_pk_bf16(a.x, a.y); w.y = cvt_pk_bf16(a.z, a.w); w.z = cvt_pk_bf16(b.x, b.y); w.w = cvt_pk_bf16(b.z, b.w); return w; }
__device__ __forceinline__ float sigmoidf_(float v) { return 1.0f / (1.0f + __expf(-v)); }
__device__ __forceinline__ f32x4 sig4(f32x4 v) { return (f32x4){sigmoidf_(v.x), sigmoidf_(v.y), sigmoidf_(v.z), sigmoidf_(v.w)}; }

struct EpiIn {
    static constexpr bool PERM = true;
    const float* ssq; bf16_t* qkva; bf16_t* lat; bf16_t* kvlat; bf16_t* gates; float* lssq; const float* cosA; const float* sinA;
    __device__ __forceinline__ void operator()(AccRef acc, const pg8::Unit& u, int wr, int wc, int fr, int fq) const {
        const int pn = u.pn;
#pragma unroll
        for (int ai = 0; ai < 2; ++ai)
#pragma unroll
            for (int m = 0; m < 4; ++m) {
                const int row = u.pm * 256 + ai * 128 + wr * 64 + m * 16 + fr;
                const float rs = rsqrtf(row_sum16(ssq + (size_t)row * 16, fq) * (1.0f / 1024.0f) + EPS);
                f32x4 v00 = acc[ai][0][m][0] * rs, v01 = acc[ai][0][m][1] * rs, v10 = acc[ai][1][m][0] * rs, v11 = acc[ai][1][m][1] * rs;
                if (pn < 4) {
                    const f32x4 c0 = *(const f32x4*)(cosA + (size_t)row * 32 + 8 * fq), c1 = *(const f32x4*)(cosA + (size_t)row * 32 + 8 * fq + 4);
                    const f32x4 s0 = *(const f32x4*)(sinA + (size_t)row * 32 + 8 * fq), s1 = *(const f32x4*)(sinA + (size_t)row * 32 + 8 * fq + 4);
                    f32x4 o00 = v00 * c0 - v10 * s0, o01 = v01 * c1 - v11 * s1, o10 = v10 * c0 + v00 * s0, o11 = v11 * c1 + v01 * s1;
                    if (pn < 2) { o00 = o00 * C2A; o01 = o01 * C2A; o10 = o10 * C2A; o11 = o11 * C2A; }
                    bf16_t* d = qkva + (size_t)row * 1536 + (pn >> 1) * 512 + ((pn & 1) * 4 + wc) * 64 + 8 * fq;
                    *(u32x4*)d = pack8(o00, o01); *(u32x4*)(d + 32) = pack8(o10, o11);
                } else if (pn < 6) {
                    bf16_t* d = qkva + (size_t)row * 1536 + pn * 256 + wc * 32 + 8 * fq;
                    *(u32x4*)d = pack8(v00, v01); *(u32x4*)(d + 128) = pack8(v10, v11);
                } else if (pn < 8) {
                    bf16_t* d = lat + (size_t)row * 512 + (pn - 6) * 256 + wc * 32 + 8 * fq;
                    *(u32x4*)d = pack8(v00, v01); *(u32x4*)(d + 128) = pack8(v10, v11);
                    float s = sq4(v00) + sq4(v01); if (pn == 6) s += sq4(v10) + sq4(v11);
                    s = quad_sum(s);
                    if (fq == 0) lssq[(size_t)row * 16 + (pn - 6) * 4 + wc] = s;
                } else if (pn == 8) {
                    bf16_t* d = kvlat + (size_t)row * 256 + wc * 32 + 8 * fq;
                    *(u32x4*)d = pack8(v00, v01); *(u32x4*)(d + 128) = pack8(v10, v11);
                    float s = quad_sum(sq4(v00) + sq4(v01) + sq4(v10) + sq4(v11));
                    if (fq == 0) lssq[(size_t)row * 16 + 8 + wc] = s;
                } else {
                    bf16_t* d = gates + (size_t)row * 2048 + (pn - 9) * 256 + wc * 32 + 8 * fq;
                    *(u32x4*)d = pack8(sig4(v00), sig4(v01)); *(u32x4*)(d + 128) = pack8(sig4(v10), sig4(v11));
                }
            }
    }
};

struct EpiUq {
    static constexpr bool PERM = true;
    const float* lssq; bf16_t* qb; const float* cosB; const float* sinB;
    __device__ __forceinline__ void operator()(AccRef acc, const pg8::Unit& u, int wr, int wc, int fr, int fq) const {
        const int pn = u.pn;
#pragma unroll
        for (int ai = 0; ai < 2; ++ai)
#pragma unroll
            for (int m = 0; m < 4; ++m) {
                const int row = u.pm * 256 + ai * 128 + wr * 64 + m * 16 + fr;
                float s; { const f32x4 v = *(const f32x4*)(lssq + (size_t)row * 16 + 4 * (fq & 1)); s = (fq < 2) ? (v.x + v.y) + (v.z + v.w) : 0.f; s = quad_sum(s); }
                const float rs = rsqrtf(s * (1.0f / 384.0f) + EPS) * C2B;
                f32x4 v00 = acc[ai][0][m][0] * rs, v01 = acc[ai][0][m][1] * rs, v10 = acc[ai][1][m][0] * rs, v11 = acc[ai][1][m][1] * rs;
                if (pn < 2) {
                    const int c0 = pn * 256 + wc * 32 + 8 * fq;
                    bf16_t* d0 = qb + (size_t)row * 768 + (c0 >> 6) * 96 + (c0 & 63);
                    const int c1 = c0 + 128;
                    bf16_t* d1 = qb + (size_t)row * 768 + (c1 >> 6) * 96 + (c1 & 63);
                    *(u32x4*)d0 = pack8(v00, v01); *(u32x4*)d1 = pack8(v10, v11);
                } else {
                    const int head = 2 * wc + (fq >> 1), i0 = 8 * (fq & 1);
                    const f32x4 c0 = *(const f32x4*)(cosB + (size_t)row * 16 + i0), c1 = *(const f32x4*)(cosB + (size_t)row * 16 + i0 + 4);
                    const f32x4 s0 = *(const f32x4*)(sinB + (size_t)row * 16 + i0), s1 = *(const f32x4*)(sinB + (size_t)row * 16 + i0 + 4);
                    const f32x4 o00 = v00 * c0 - v10 * s0, o01 = v01 * c1 - v11 * s1, o10 = v10 * c0 + v00 * s0, o11 = v11 * c1 + v01 * s1;
                    bf16_t* d = qb + (size_t)row * 768 + head * 96 + 64 + i0;
                    *(u32x4*)d = pack8(o00, o01); *(u32x4*)(d + 16) = pack8(o10, o11);
                }
            }
    }
};

template <int MODE> struct EpiRowScale {
    static constexpr bool PERM = true;
    const float* stat; bf16_t* O; int ldc; float cs;
    __device__ __forceinline__ void operator()(AccRef acc, const pg8::Unit& u, int wr, int wc, int fr, int fq) const {
#pragma unroll
        for (int ai = 0; ai < 2; ++ai)
#pragma unroll
            for (int m = 0; m < 4; ++m) {
                const int row = u.pm * 256 + ai * 128 + wr * 64 + m * 16 + fr;
                float rs;
                if (MODE == 0) { const f32x4 v = *(const f32x4*)(stat + (size_t)row * 16 + 8); rs = rsqrtf(((v.x + v.y) + (v.z + v.w)) * (1.0f / 256.0f) + EPS); }
                else if (MODE == 1) rs = stat[row];
                else rs = rsqrtf(row_sum16(stat + (size_t)row * 16, fq) * (1.0f / 1024.0f) + EPS) * cs;
                bf16_t* d = O + (size_t)row * ldc + u.pn * 256 + wc * 32 + 8 * fq;
                *(u32x4*)d = pack8(acc[ai][0][m][0] * rs, acc[ai][0][m][1] * rs);
                *(u32x4*)(d + 128) = pack8(acc[ai][1][m][0] * rs, acc[ai][1][m][1] * rs);
            }
    }
};

template <int Z> struct EpiBranch {
    static constexpr bool PERM = true;
    bf16_t* gates;
    __device__ __forceinline__ void operator()(AccRef acc, const pg8::Unit& u, int wr, int wc, int fr, int fq) const {
#pragma unroll
        for (int ai = 0; ai < 2; ++ai)
#pragma unroll
            for (int m = 0; m < 4; ++m) {
                const int row = u.pm * 256 + ai * 128 + wr * 64 + m * 16 + fr;
#pragma unroll
                for (int bj = 0; bj < 2; ++bj) {
                    bf16_t* d = gates + (size_t)row * 2048 + u.pn * 256 + bj * 128 + wc * 32 + 8 * fq;
                    const f32x4 a0 = acc[ai][bj][m][0], a1 = acc[ai][bj][m][1];
                    if (Z == 0) {
                        const u32x4 g = *(const u32x4*)d;
                        const f32x4 r0 = {bflo(g.x) * a0.x, bfhi(g.x) * a0.y, bflo(g.y) * a0.z, bfhi(g.y) * a0.w};
                        const f32x4 r1 = {bflo(g.z) * a1.x, bfhi(g.z) * a1.y, bflo(g.w) * a1.z, bfhi(g.w) * a1.w};
                        *(u32x4*)d = pack8(r0, r1);
                    } else {
                        const u32x4 t = *(const u32x4*)d; const u32x4 g = *(const u32x4*)(d + 1024);
                        const f32x4 r0 = {bflo(t.x) + bflo(g.x) * a0.x, bfhi(t.x) + bfhi(g.x) * a0.y, bflo(t.y) + bflo(g.y) * a0.z, bfhi(t.y) + bfhi(g.y) * a0.w};
                        const f32x4 r1 = {bflo(t.z) + bflo(g.z) * a1.x, bfhi(t.z) + bfhi(g.z) * a1.y, bflo(t.w) + bflo(g.w) * a1.z, bfhi(t.w) + bfhi(g.w) * a1.w};
                        *(u32x4*)d = pack8(r0, r1);
                    }
                }
            }
    }
};

struct EpiRes {
    static constexpr bool PERM = false;
    const float* xin; float* xout; bf16_t* xb; float* ssq;
    __device__ __forceinline__ void operator()(AccRef acc, const pg8::Unit& u, int wr, int wc, int fr, int fq) const {
#pragma unroll
        for (int ai = 0; ai < 2; ++ai)
#pragma unroll
            for (int m = 0; m < 4; ++m) {
                const int row = u.pm * 256 + ai * 128 + wr * 64 + m * 16 + fr;
                float s = 0.f;
#pragma unroll
                for (int bj = 0; bj < 2; ++bj)
#pragma unroll
                    for (int n = 0; n < 2; ++n) {
                        const size_t off = (size_t)row * 1024 + u.pn * 256 + bj * 128 + wc * 32 + n * 16 + 4 * fq;
                        const f32x4 o = *(const f32x4*)(xin + off) + acc[ai][bj][m][n];
                        *(f32x4*)(xout + off) = o; s += sq4(o);
                        u32x2 w; w.x = cvt_pk_bf16(o.x, o.y); w.y = cvt_pk_bf16(o.z, o.w); *(u32x2*)(xb + off) = w;
                    }
                s = quad_sum(s);
                if (fq == 0) ssq[(size_t)row * 16 + u.pn * 4 + wc] = s;
            }
    }
};

struct EpiGU {
    static constexpr bool PERM = true;
    const float* ssq; bf16_t* act;
    __device__ __forceinline__ void operator()(AccRef acc, const pg8::Unit& u, int wr, int wc, int fr, int fq) const {
#pragma unroll
        for (int ai = 0; ai < 2; ++ai)
#pragma unroll
            for (int m = 0; m < 4; ++m) {
                const int row = u.pm * 256 + ai * 128 + wr * 64 + m * 16 + fr;
                const float rs = rsqrtf(row_sum16(ssq + (size_t)row * 16, fq) * (1.0f / 1024.0f) + EPS);
                const f32x4 g0 = acc[ai][0][m][0] * rs, g1 = acc[ai][0][m][1] * rs, u0 = acc[ai][1][m][0] * rs, u1 = acc[ai][1][m][1] * rs;
                const f32x4 a0 = g0 * sig4(g0) * u0, a1 = g1 * sig4(g1) * u1;
                *(u32x4*)(act + (size_t)row * DFF + u.pn * 128 + wc * 32 + 8 * fq) = pack8(a0, a1);
            }
    }
};

typedef short v4i16_t __attribute__((ext_vector_type(4)));
__device__ __forceinline__ v4i16_t vtr(const LAS unsigned char* p) { return __builtin_amdgcn_ds_read_tr16_b64_v4i16((LAS v4i16_t*)p); }
template <int DQK, int DV, int MODE>
__device__ __forceinline__ void attn_unit(LAS unsigned char* lds, const int tid, const bf16_t* Qg, int ldq, const bf16_t* Kg, int ldk, const bf16_t* K2g,
                                          const bf16_t* Vg, int ldv, bf16_t* Og, int ldo, int qbase, int NT, const float* kbar, int cur) {
    constexpr int KS = DQK + 8;
    constexpr int KBUF = 64 * KS * 2, VBUF = (DV / 32) * 4096;
    constexpr int KMAIN = (MODE == 1) ? 64 : DQK;
    constexpr int KCH = KMAIN / 8, NK = (64 * KCH) / 512, VCH = DV / 8, NV = (64 * VCH) / 512;
    constexpr int NJ = DQK / 16, ND = DV / 32;
    constexpr float THR = 8.0f;
    const int lane = tid & 63, wid = __builtin_amdgcn_readfirstlane(tid >> 6), r32 = lane & 31, hi = lane >> 5;
    bf16x8 qf[NJ];
    { const bf16_t* qrow = Qg + (size_t)(wid * 32 + r32) * ldq + 8 * hi;
#pragma unroll
      for (int j = 0; j < NJ; ++j) qf[j] = *(const bf16x8*)(qrow + 16 * j); }
    unsigned selmask = 0xffu;
    if (MODE == 0 && cur > 3) {
        float g[7];
#pragma unroll
        for (int j = 0; j < 7; ++j) {
            float a = 0.f;
            if (j < cur) {
#pragma unroll
                for (int jj = 0; jj < 4; ++jj) {
                    const f32x4 k0 = *(const f32x4*)(kbar + j * 64 + 16 * jj + 8 * hi), k1 = *(const f32x4*)(kbar + j * 64 + 16 * jj + 8 * hi + 4);
                    a += bf2f((unsigned short)qf[jj][0]) * k0.x + bf2f((unsigned short)qf[jj][1]) * k0.y + bf2f((unsigned short)qf[jj][2]) * k0.z + bf2f((unsigned short)qf[jj][3]) * k0.w
                       + bf2f((unsigned short)qf[jj][4]) * k1.x + bf2f((unsigned short)qf[jj][5]) * k1.y + bf2f((unsigned short)qf[jj][6]) * k1.z + bf2f((unsigned short)qf[jj][7]) * k1.w;
                }
                a += __shfl_xor(a, 32);
            }
            g[j] = a;
        }
        unsigned sm = 0u;
#pragma unroll
        for (int j = 0; j < 7; ++j) {
            int rank = 0;
#pragma unroll
            for (int i = 0; i < 7; ++i) if (i != j) rank += (i < cur && (g[i] > g[j] || (g[i] == g[j] && i < j))) ? 1 : 0;
            if (j < cur && rank < 3) sm |= (1u << j);
        }
        selmask = sm | (1u << cur);
    }
    u32x4 kreg[NK], vreg[NV], k2reg = {0u, 0u, 0u, 0u};
#define ATT_LOAD(t) do { \
    _Pragma("unroll") for (int i = 0; i < NK; ++i) { const int idx = tid + 512 * i, kv = idx / KCH, c = idx % KCH; kreg[i] = *(const u32x4*)(Kg + (size_t)(64 * (t) + kv) * ldk + 8 * c); } \
    if (MODE == 1) { if (tid < 256) k2reg = *(const u32x4*)(K2g + (size_t)(64 * (t) + (tid >> 2)) * 32 + 8 * (tid & 3)); } \
    _Pragma("unroll") for (int i = 0; i < NV; ++i) { const int idx = tid + 512 * i, kv = idx / VCH, c = idx % VCH; vreg[i] = *(const u32x4*)(Vg + (size_t)(64 * (t) + kv) * ldv + 8 * c); } } while (0)
#define ATT_STORE(buf) do { LAS unsigned char* kb_ = lds + (buf) * KBUF; LAS unsigned char* vb_ = lds + 2 * KBUF + (buf) * VBUF; \
    _Pragma("unroll") for (int i = 0; i < NK; ++i) { const int idx = tid + 512 * i, kv = idx / KCH, c = idx % KCH; *(LAS u32x4*)(kb_ + (kv * KS + 8 * c) * 2) = kreg[i]; } \
    if (MODE == 1) { if (tid < 256) *(LAS u32x4*)(kb_ + ((tid >> 2) * KS + 64 + 8 * (tid & 3)) * 2) = k2reg; } \
    _Pragma("unroll") for (int i = 0; i < NV; ++i) { const int idx = tid + 512 * i, kv = idx / VCH, c = idx % VCH; *(LAS u32x4*)(vb_ + (c >> 2) * 4096 + kv * 64 + (c & 3) * 16) = vreg[i]; } } while (0)
    ATT_LOAD(0); ATT_STORE(0);
    __syncthreads();
    f32x16 o[ND];
#pragma unroll
    for (int d0 = 0; d0 < ND; ++d0)
#pragma unroll
        for (int r = 0; r < 16; ++r) o[d0][r] = 0.f;
    f32x16 negm;
#pragma unroll
    for (int r = 0; r < 16; ++r) negm[r] = 0.f;
    float mref = 0.f, lrun = 0.f;
    const int qabs = qbase + wid * 32 + r32;
    const int qwmax = qbase + wid * 32 + 31;
    const int vlane = (4 * hi + ((lane & 15) >> 2)) * 64 + ((lane >> 4) & 1) * 32 + (lane & 3) * 8;
    for (int t = 0; t < NT; ++t) {
        const int buf = t & 1;
        if (t + 1 < NT) ATT_LOAD(t + 1);
        bool lane_ok = true, causal = false, active = true;
        if (MODE == 0) { const int blk = t >> 2; if (blk < cur) lane_ok = ((selmask >> blk) & 1u) != 0u; else causal = (64 * t + 63 > qbase + wid * 32); active = (__any(lane_ok ? 1 : 0) != 0) && (64 * t <= qwmax); }
        if (MODE == 1) { causal = (64 * t + 63 > qbase + wid * 32); active = (64 * t <= qwmax); }
        if (active) {
            const LAS unsigned char* kb = lds + buf * KBUF + (r32 * KS + 8 * hi) * 2;
            f32x16 s0 = negm, s1 = negm;
#pragma unroll
            for (int j = 0; j < NJ; ++j) {
                const bf16x8 k0 = *(const LAS bf16x8*)(kb + j * 32), k1 = *(const LAS bf16x8*)(kb + 32 * KS * 2 + j * 32);
                s0 = __builtin_amdgcn_mfma_f32_32x32x16_bf16(k0, qf[j], s0, 0, 0, 0);
                s1 = __builtin_amdgcn_mfma_f32_32x32x16_bf16(k1, qf[j], s1, 0, 0, 0);
            }
            if (MODE != 2) {
                if (!lane_ok) {
#pragma unroll
                    for (int r = 0; r < 16; ++r) { s0[r] = -INFINITY; s1[r] = -INFINITY; }
                } else if (causal) {
                    const int kb0 = 64 * t + 4 * hi;
#pragma unroll
                    for (int r = 0; r < 16; ++r) { const int kv = kb0 + (r & 3) + 8 * (r >> 2); if (kv > qabs) s0[r] = -INFINITY; if (kv + 32 > qabs) s1[r] = -INFINITY; }
                }
            }
            float mxa = fmaxf(fmaxf(s0[0], s0[1]), s1[0]), mxb = fmaxf(fmaxf(s0[2], s0[3]), s1[1]);
            mxa = fmaxf(fmaxf(mxa, s1[2]), s1[3]);
#pragma unroll
            for (int r = 4; r < 16; r += 4) { mxa = fmaxf(fmaxf(mxa, s0[r]), s0[r + 1]); mxb = fmaxf(fmaxf(mxb, s0[r + 2]), s0[r + 3]); mxa = fmaxf(fmaxf(mxa, s1[r]), s1[r + 1]); mxb = fmaxf(fmaxf(mxb, s1[r + 2]), s1[r + 3]); }
            float mx = fmaxf(mxa, mxb);
            mx = fmaxf(mx, __shfl_xor(mx, 32));
            if (__any(mx > THR ? 1 : 0)) {
                const float dl = (mx > THR) ? mx : 0.f;
                mref += dl;
#pragma unroll
                for (int r = 0; r < 16; ++r) { s0[r] -= dl; s1[r] -= dl; negm[r] = -mref; }
                const float alpha = __builtin_amdgcn_exp2f(-dl);
                lrun *= alpha;
#pragma unroll
                for (int d0 = 0; d0 < ND; ++d0)
#pragma unroll
                    for (int r = 0; r < 16; ++r) o[d0][r] *= alpha;
            }
            float psa = 0.f, psb = 0.f;
#pragma unroll
            for (int r = 0; r < 16; ++r) { s0[r] = __builtin_amdgcn_exp2f(s0[r]); s1[r] = __builtin_amdgcn_exp2f(s1[r]); psa += s0[r]; psb += s1[r]; }
            lrun += psa + psb;
            bf16x8 pb[4];
            { u32x4 w;
              w.x = cvt_pk_bf16(s0[0], s0[1]); w.y = cvt_pk_bf16(s0[2], s0[3]); w.z = cvt_pk_bf16(s0[4], s0[5]); w.w = cvt_pk_bf16(s0[6], s0[7]); pb[0] = __builtin_bit_cast(bf16x8, w);
              w.x = cvt_pk_bf16(s0[8], s0[9]); w.y = cvt_pk_bf16(s0[10], s0[11]); w.z = cvt_pk_bf16(s0[12], s0[13]); w.w = cvt_pk_bf16(s0[14], s0[15]); pb[1] = __builtin_bit_cast(bf16x8, w);
              w.x = cvt_pk_bf16(s1[0], s1[1]); w.y = cvt_pk_bf16(s1[2], s1[3]); w.z = cvt_pk_bf16(s1[4], s1[5]); w.w = cvt_pk_bf16(s1[6], s1[7]); pb[2] = __builtin_bit_cast(bf16x8, w);
              w.x = cvt_pk_bf16(s1[8], s1[9]); w.y = cvt_pk_bf16(s1[10], s1[11]); w.z = cvt_pk_bf16(s1[12], s1[13]); w.w = cvt_pk_bf16(s1[14], s1[15]); pb[3] = __builtin_bit_cast(bf16x8, w); }
            const LAS unsigned char* vb = lds + 2 * KBUF + buf * VBUF + vlane;
#pragma unroll
            for (int d0 = 0; d0 < ND; ++d0)
#pragma unroll
                for (int kk = 0; kk < 4; ++kk) {
                    const v4i16_t a = vtr(vb + d0 * 4096 + kk * 1024), b = vtr(vb + d0 * 4096 + kk * 1024 + 512);
                    const bf16x8 vf = {a[0], a[1], a[2], a[3], b[0], b[1], b[2], b[3]};
                    o[d0] = __builtin_amdgcn_mfma_f32_32x32x16_bf16(vf, pb[kk], o[d0], 0, 0, 0);
                }
        }
        if (t + 1 < NT) ATT_STORE(buf ^ 1);
        __syncthreads();
    }
#undef ATT_LOAD
#undef ATT_STORE
    lrun += __shfl_xor(lrun, 32);
    const float inv = 1.0f / lrun;
    bf16_t* orow = Og + (size_t)(wid * 32 + r32) * ldo + 4 * hi;
#pragma unroll
    for (int d0 = 0; d0 < ND; ++d0)
#pragma unroll
        for (int rg = 0; rg < 4; ++rg) {
            u32x2 w; w.x = cvt_pk_bf16(o[d0][4 * rg] * inv, o[d0][4 * rg + 1] * inv); w.y = cvt_pk_bf16(o[d0][4 * rg + 2] * inv, o[d0][4 * rg + 3] * inv);
            *(u32x2*)(orow + 32 * d0 + 8 * rg) = w;
        }
}

__device__ __forceinline__ float wave_sum(float v) {
#pragma unroll
    for (int o = 1; o < 64; o <<= 1) v += __shfl_xor(v, o);
    return v;
}
template <class MapFn>
__device__ __forceinline__ void transpose_item(const float* W, int K, int N, bf16_t* WT, const float* gain, LAS float* scr, int item, int lane, MapFn map) {
    const int nblk = N / 32, kb = item / nblk, nb = item % nblk, k0 = 64 * kb, n0 = 32 * nb;
#pragma unroll 8
    for (int i = 0; i < 32; ++i) { const int kk = 2 * i + (lane >> 5); float w = W[(size_t)(k0 + kk) * N + n0 + (lane & 31)]; if (gain) w *= gain[k0 + kk]; scr[kk * 33 + (lane & 31)] = w; }
    asm volatile("s_waitcnt lgkmcnt(0)" ::: "memory");
    const int c = lane & 7;
#pragma unroll
    for (int j = 0; j < 4; ++j) { const int n = (lane >> 3) + 8 * j; const LAS float* s = scr + (8 * c) * 33 + n;
        u32x4 o; o.x = cvt_pk_bf16(s[0 * 33], s[1 * 33]); o.y = cvt_pk_bf16(s[2 * 33], s[3 * 33]); o.z = cvt_pk_bf16(s[4 * 33], s[5 * 33]); o.w = cvt_pk_bf16(s[6 * 33], s[7 * 33]);
        *(u32x4*)(WT + (size_t)map(n0 + n) * K + k0 + 8 * c) = o; }
    asm volatile("s_waitcnt lgkmcnt(0)" ::: "memory");
}
__device__ __forceinline__ int map_in(int n) {
    if (n < 1024) { const int base = n & 512, mm = n & 511, head = mm >> 6, e = mm & 63; return base + 256 * (head >> 2) + 128 * (e >> 5) + 32 * (head & 3) + (e & 31); }
    if (n < 1920) return n;
    if (n < 2176) return 2048 + (n - 1920);
    if (n < 2208) return 1920 + (n - 2176);
    return 2304 + (n - 2208);
}
__device__ __forceinline__ int map_uq(int n) { const int head = n / 96, e = n % 96; if (e < 64) return 64 * head + e; const int r = e - 64; return 512 + 128 * (r >> 4) + 16 * head + (r & 15); }
__device__ __forceinline__ int map_gu(int n) { if (n < DFF) return 256 * (n >> 7) + (n & 127); const int a = n - DFF; return 256 * (a >> 7) + 128 + (a & 127); }
__device__ __forceinline__ int map_id(int n) { return n; }

#define XB_TMO      128
#define XB_XCNT(j)  (256  + 64 * (j))
#define XB_XSUB(j)  (1280 + 64 * (j))
#define XB_XGEN(j)  (2304 + 64 * (j))
#define XB_TOP      3328
#define XB_TOPGEN   3392
#define XCD_BAR_WORDS 3456
#define XB_SPIN_CAP (1u << 18)
__device__ __forceinline__ unsigned xb_ld(unsigned* p)              { return __hip_atomic_load(p, __ATOMIC_RELAXED, __HIP_MEMORY_SCOPE_AGENT); }
__device__ __forceinline__ unsigned xb_add(unsigned* p, unsigned v) { return __hip_atomic_fetch_add(p, v, __ATOMIC_RELAXED, __HIP_MEMORY_SCOPE_AGENT); }
__device__ __forceinline__ unsigned xb_xcc_id() { return (unsigned)__builtin_amdgcn_s_getreg((3 << 11) | 20) & 0xFu; }
#define XB_SPIN(cond, bar) do { unsigned _sp = 0; while (cond) { __builtin_amdgcn_s_sleep(1); \
    if ((++_sp & 255u) == 0u) { if (xb_ld(&(bar)[XB_TMO])) break; if (_sp > XB_SPIN_CAP) { atomicAdd(&(bar)[XB_TMO], 1u); break; } } } } while (0)
struct XcdBarrier { unsigned* bar; unsigned x; volatile LAS unsigned* st; };
__device__ __forceinline__ XcdBarrier xcd_barrier_post(unsigned* bar, volatile LAS unsigned* st) {
    XcdBarrier b; b.bar = bar; b.x = xb_xcc_id(); b.st = st;
    if (threadIdx.x == 0) (void)xb_add(&bar[XB_XCNT(b.x)], 1u);
    return b;
}
__device__ __forceinline__ void xcd_barrier_complete(unsigned* bar, unsigned x, unsigned& nloc, unsigned& nx) {
    const unsigned G = gridDim.x * gridDim.y * gridDim.z;
    unsigned sum, cnt, mine, sp = 0u;
    for (;;) {
        sum = 0u; cnt = 0u; mine = 0u;
#pragma unroll
        for (unsigned j = 0; j < 16; ++j) { const unsigned c = xb_ld(&bar[XB_XCNT(j)]); sum += c; cnt += (c > 0u) ? 1u : 0u; mine = (j == x) ? c : mine; }
        if (sum == G) break;
        __builtin_amdgcn_s_sleep(1);
        if ((++sp & 255u) == 0u) { if (xb_ld(&bar[XB_TMO])) break; if (sp > XB_SPIN_CAP) { atomicAdd(&bar[XB_TMO], 1u); break; } }
    }
    nloc = mine > 0u ? mine : 1u; nx = cnt > 0u ? cnt : 1u;
}
__device__ __forceinline__ void xcd_barrier(const XcdBarrier& b) {
    asm volatile("s_waitcnt vmcnt(0)" ::: "memory");
    __syncthreads();
    if (threadIdx.x == 0) {
        unsigned* bar = b.bar;
        __builtin_amdgcn_s_waitcnt(0);
        unsigned nloc = b.st[0], nx = b.st[1];
        if (nloc == 0u) { xcd_barrier_complete(bar, b.x, nloc, nx); b.st[0] = nloc; b.st[1] = nx; }
        const unsigned old = xb_add(&bar[XB_XSUB(b.x)], 1u);
        const unsigned gen = old / nloc;
        if (old + 1u == (gen + 1u) * nloc) {
            __builtin_amdgcn_fence(__ATOMIC_RELEASE, "agent");
            asm volatile("s_waitcnt vmcnt(0)" ::: "memory");
            const unsigned og = xb_add(&bar[XB_TOP], 1u);
            const unsigned tg = og / nx;
            if (og + 1u == (tg + 1u) * nx) xb_add(&bar[XB_TOPGEN], 1u);
            else XB_SPIN(xb_ld(&bar[XB_TOPGEN]) == tg, bar);
            __builtin_amdgcn_fence(__ATOMIC_ACQUIRE, "agent");
            xb_add(&bar[XB_XGEN(b.x)], 1u);
            asm volatile("s_waitcnt vmcnt(0)" ::: "memory");
        } else {
            XB_SPIN(xb_ld(&bar[XB_XGEN(b.x)]) == gen, bar);
            __builtin_amdgcn_fence(__ATOMIC_ACQUIRE, "agent");
            asm volatile("s_waitcnt vmcnt(0)" ::: "memory");
        }
    }
    __syncthreads();
}

struct Args {
    const float* x; const float* mem; const int* pos;
    const float* norm_mix; const float* w_in; const float* q_lat_norm; const float* w_uq; const float* kv_lat_norm; const float* w_ukv;
    const float* w_ba; const float* w_bb; const float* w_out; const float* norm_x; const float* norm_mem; const float* w_xq; const float* w_xkv; const float* w_xo;
    const float* norm_ffn; const float* w_gu; const float* w_dn; const float* norm_final;
    float* out; unsigned char* ws; int ph_lo, ph_hi;
};

constexpr int PH_PER_LAYER = 11, N_PHASES = DEPTH * PH_PER_LAYER + 1;
constexpr int LDS_TOTAL = pg8::STAGE_BYTES;

__global__ void __launch_bounds__(512, 2) fwd_kernel(Args a_in) {
    __shared__ __attribute__((aligned(16))) unsigned char lds_raw[LDS_TOTAL];
    LAS unsigned char* lds = (LAS unsigned char*)lds_raw;
    const int ph_lo = a_in.ph_lo, ph_hi = a_in.ph_hi;
    __shared__ __attribute__((aligned(16))) unsigned bar_st[4];
    if (threadIdx.x < 4) bar_st[threadIdx.x] = 0u;
    __syncthreads();
    XcdBarrier bar; bar.bar = (unsigned*)(a_in.ws + WS_CTL); bar.x = 0; bar.st = (volatile LAS unsigned*)bar_st;
    if (ph_hi - ph_lo > 1) bar = xcd_barrier_post((unsigned*)(a_in.ws + WS_CTL), (volatile LAS unsigned*)bar_st);
    for (int ph = ph_lo; ph < ph_hi; ++ph) {
        if (ph > ph_lo) { if (ph == ph_lo + 1) cg::this_grid().sync(); else xcd_barrier(bar); if (XSYNC) { xcd_barrier(bar); xcd_barrier(bar); } }
        int tid = threadIdx.x; asm volatile("" : "+v"(tid));
        int G = gridDim.x, bx = blockIdx.x; asm volatile("" : "+s"(G), "+s"(bx));
        const int lane = tid & 63, wave = __builtin_amdgcn_readfirstlane(tid >> 6);
        const int vcu = (G % 8 == 0) ? (bx % 8) * (G / 8) + bx / 8 : bx;
        const int gw = vcu * 8 + wave, NGW = G * 8;
        const __attribute__((address_space(4))) Args* ap = (const __attribute__((address_space(4))) Args*)__builtin_amdgcn_kernarg_segment_ptr(); asm volatile("" : "+s"(ap));
        const __attribute__((address_space(4))) Args& a = *ap;
        unsigned char* ws = a.ws; float* aout = a.out; const float* ax = a.x;
        asm volatile("" : "+s"(ws), "+s"(aout), "+s"(ax));
        bf16_t* Win_t = (bf16_t*)(ws + WS_WIN); bf16_t* Wuq_t = (bf16_t*)(ws + WS_WUQ); bf16_t* Wukv_t = (bf16_t*)(ws + WS_WUKV);
        bf16_t* Wba_t = (bf16_t*)(ws + WS_WBA); bf16_t* Wbb_t = (bf16_t*)(ws + WS_WBB); bf16_t* Wout_t = (bf16_t*)(ws + WS_WOUT);
        bf16_t* Wxq_t = (bf16_t*)(ws + WS_WXQ); bf16_t* Wxkv_t = (bf16_t*)(ws + WS_WXKV); bf16_t* Wxo_t = (bf16_t*)(ws + WS_WXO);
        bf16_t* Wgu_t = (bf16_t*)(ws + WS_WGU); bf16_t* Wdn_t = (bf16_t*)(ws + WS_WDN);
        bf16_t* XB = (bf16_t*)(ws + WS_XB); bf16_t* QB = (bf16_t*)(ws + WS_XB);
        bf16_t* QKVA = (bf16_t*)(ws + WS_QKVA); bf16_t* QX = (bf16_t*)(ws + WS_QKVA);
        bf16_t* LAT = (bf16_t*)(ws + WS_LAT); bf16_t* OB = (bf16_t*)(ws + WS_LAT);
        bf16_t* KVLAT = (bf16_t*)(ws + WS_KVLAT); bf16_t* GATES = (bf16_t*)(ws + WS_GATES); bf16_t* ACT = (bf16_t*)(ws + WS_ACT);
        bf16_t* KVB = (bf16_t*)(ws + WS_KVB); bf16_t* KVX = (bf16_t*)(ws + WS_KVX); bf16_t* MEMB = (bf16_t*)(ws + WS_MEMB); bf16_t* KPE = (bf16_t*)(ws + WS_KPE);
        float* COSA = (float*)(ws + WS_COSA); float* SINA = (float*)(ws + WS_SINA); float* COSB = (float*)(ws + WS_COSB); float* SINB = (float*)(ws + WS_SINB);
        float* SSQ = (float*)(ws + WS_SSQ); float* LSSQ = (float*)(ws + WS_LSSQ); float* RSTDM = (float*)(ws + WS_RSTDM); float* KBAR = (float*)(ws + WS_KBAR);

        if (ph == N_PHASES - 1) {
            if (!PHON(11)) continue;
            for (int row = gw; row < M; row += NGW) {
                const f32x4* sp = (const f32x4*)(SSQ + (size_t)row * 16);
                const f32x4 p0 = sp[0], p1 = sp[1], p2 = sp[2], p3 = sp[3];
                const float s = ((p0.x + p0.y) + (p0.z + p0.w)) + ((p1.x + p1.y) + (p1.z + p1.w)) + ((p2.x + p2.y) + (p2.z + p2.w)) + ((p3.x + p3.y) + (p3.z + p3.w));
                const float rs = rsqrtf(s * (1.0f / 1024.0f) + EPS);
                f32x4* xr = (f32x4*)(aout + (size_t)row * DM) + lane; const f32x4* gr = (const f32x4*)a.norm_final + lane;
#pragma unroll
                for (int j = 0; j < 4; ++j) { const f32x4 v = xr[64 * j], g = gr[64 * j]; xr[64 * j] = v * rs * g; }
            }
            continue;
        }
        const int l = ph / PH_PER_LAYER, p = ph % PH_PER_LAYER;
        const float* xin = (l == 0 && p == 5) ? ax : aout;
        if (!PHON(p)) continue;
        if (p == 0) {
            LAS float* scr = (LAS float*)(lds + wave * 16384);
            constexpr int I_IN = 16 * (IN_W / 32), I_UQ = 6 * 24, I_UKV = 4 * 32, I_BA = 8 * 32, I_OUT = 16 * 32, I_XQ = 16 * 16, I_XKV = 16 * 32, I_XO = 8 * 32, I_GU = 16 * (2 * DFF / 32), I_DN = (DFF / 64) * 32;
            constexpr int NIT = I_IN + I_UQ + I_UKV + 2 * I_BA + I_OUT + I_XQ + I_XKV + I_XO + I_GU + I_DN;
            for (int rep = 0; rep < 1 + DUP(0); ++rep)
            for (int it = gw; it < NIT; it += NGW) {
                int r = it;
                if (r < I_IN) { transpose_item(a.w_in + (size_t)l * DM * IN_W, DM, IN_W, Win_t, a.norm_mix + l * DM, scr, r, lane, map_in); continue; } r -= I_IN;
                if (r < I_UQ) { transpose_item(a.w_uq + (size_t)l * 384 * 768, 384, 768, Wuq_t, a.q_lat_norm + l * 384, scr, r, lane, map_uq); continue; } r -= I_UQ;
                if (r < I_UKV) { transpose_item(a.w_ukv + (size_t)l * 256 * 1024, 256, 1024, Wukv_t, a.kv_lat_norm + l * 256, scr, r, lane, map_id); continue; } r -= I_UKV;
                if (r < I_BA) { transpose_item(a.w_ba + (size_t)l * 512 * 1024, 512, 1024, Wba_t, nullptr, scr, r, lane, map_id); continue; } r -= I_BA;
                if (r < I_BA) { transpose_item(a.w_bb + (size_t)l * 512 * 1024, 512, 1024, Wbb_t, nullptr, scr, r, lane, map_id); continue; } r -= I_BA;
                if (r < I_OUT) { transpose_item(a.w_out + (size_t)l * 1024 * 1024, 1024, 1024, Wout_t, nullptr, scr, r, lane, map_id); continue; } r -= I_OUT;
                if (r < I_XQ) { transpose_item(a.w_xq + (size_t)l * 1024 * 512, 1024, 512, Wxq_t, a.norm_x + l * DM, scr, r, lane, map_id); continue; } r -= I_XQ;
                if (r < I_XKV) { transpose_item(a.w_xkv + (size_t)l * 1024 * 1024, 1024, 1024, Wxkv_t, a.norm_mem + l * DM, scr, r, lane, map_id); continue; } r -= I_XKV;
                if (r < I_XO) { transpose_item(a.w_xo + (size_t)l * 512 * 1024, 512, 1024, Wxo_t, nullptr, scr, r, lane, map_id); continue; } r -= I_XO;
                if (r < I_GU) { transpose_item(a.w_gu + (size_t)l * 1024 * 2 * DFF, 1024, 2 * DFF, Wgu_t, a.norm_ffn + l * DM, scr, r, lane, map_gu); continue; } r -= I_GU;
                transpose_item(a.w_dn + (size_t)l * DFF * 1024, DFF, 1024, Wdn_t, nullptr, scr, r, lane, map_id);
            }
            for (int i = vcu * 512 + tid; i < 96 * 1024 / 8; i += G * 512) *(u32x4*)(Win_t + (size_t)1952 * 1024 + (size_t)i * 8) = (u32x4){0u, 0u, 0u, 0u};
            if (l == 0) {
                for (int row = gw; row < M + MM; row += NGW) {
                    const bool ism = row >= M; const int r = ism ? row - M : row;
                    const f32x4* xr = (const f32x4*)((ism ? a.mem : ax) + (size_t)r * DM) + lane;
                    f32x4 v[4]; float s = 0.f;
#pragma unroll
                    for (int j = 0; j < 4; ++j) { v[j] = xr[64 * j]; s += sq4(v[j]); }
                    s = wave_sum(s);
                    u32x2* o8 = (u32x2*)((ism ? MEMB : XB) + (size_t)r * DM) + lane;
#pragma unroll
                    for (int j = 0; j < 4; ++j) { u32x2 w; w.x = cvt_pk_bf16(v[j].x, v[j].y); w.y = cvt_pk_bf16(v[j].z, v[j].w); o8[64 * j] = w; }
                    if (ism) { if (lane == 0) RSTDM[r] = rsqrtf(s * (1.0f / 1024.0f) + EPS); }
                    else if (lane < 16) SSQ[(size_t)r * 16 + lane] = (lane == 0) ? s : 0.f;
                }
                for (int i = vcu * 512 + tid; i < M * 32; i += G * 512) {
                    const int row = i >> 5, k = i & 31; const float posf = (float)a.pos[row];
                    const float inv = expf(-9.210340371976184f * (2.0f / 64.0f) * (float)k);
                    float sn, cs; sincosf(posf * inv, &sn, &cs); COSA[i] = cs; SINA[i] = sn;
                    if (k < 16) { const float invb = expf(-9.210340371976184f * (2.0f / 32.0f) * (float)k); float sb, cb; sincosf(posf * invb, &sb, &cb); COSB[row * 16 + k] = cb; SINB[row * 16 + k] = sb; }
                }
            }
            __syncthreads();
        } else if (p == 1) {
            pg8::Gemm g{XB, Win_t, M, IN_WP, DM, DM}; pg8::StaticOrder S; S.init(M, IN_WP, G, bx);
            EpiIn E{SSQ, QKVA, LAT, KVLAT, GATES, LSSQ, COSA, SINA};
            for (int rep = 0; rep < 1 + DUP(1); ++rep) { int tl = tid; asm volatile("" : "+v"(tl)); pg8::gemm_phase(lds, tl, g, S, E); }
        } else if (p == 2) {
            if (P2ON(0)) { LAS float* red = (LAS float*)lds;
              for (int it = vcu; it < 128 * 8; it += G) {
                  const int bh = it >> 3, j = it & 7, b = bh >> 3, h = bh & 7;
                  const bf16_t* kp = QKVA + (size_t)(b * SEQ + j * 256 + wave * 32) * 1536 + 512 + h * 64 + lane;
                  float s = 0.f;
#pragma unroll 8
                  for (int r = 0; r < 32; ++r) s += bf2f(kp[(size_t)r * 1536]);
                  red[wave * 64 + lane] = s;
                  __syncthreads();
                  if (wave == 0) { float t = 0.f;
#pragma unroll
                      for (int w = 0; w < 8; ++w) t += red[w * 64 + lane];
                      KBAR[(size_t)it * 64 + lane] = t * (1.0f / 256.0f); }
                  __syncthreads();
              }
              for (int i = vcu * 512 + tid; i < M * 16; i += G * 512) {
                  const int row = i >> 4, k = i & 15;
                  const float x1 = bf2f(LAT[(size_t)row * 512 + 384 + k]), x2 = bf2f(LAT[(size_t)row * 512 + 400 + k]);
                  const float c = COSB[i], s = SINB[i];
                  KPE[(size_t)row * 32 + k] = f2bf1(x1 * c - x2 * s); KPE[(size_t)row * 32 + 16 + k] = f2bf1(x2 * c + x1 * s);
              }
              __syncthreads(); }
            if (P2ON(1)) { unsigned char* w = ws; int tl = tid; asm volatile("" : "+s"(w), "+v"(tl));
              pg8::Gemm g{(bf16_t*)(w + WS_LAT), (bf16_t*)(w + WS_WUQ), M, 768, 384, 512}; pg8::StaticOrder S; S.init(M, 768, G, bx);
              EpiUq E{(float*)(w + WS_LSSQ), (bf16_t*)(w + WS_XB), (float*)(w + WS_COSB), (float*)(w + WS_SINB)}; pg8::gemm_phase(lds, tl, g, S, E); }
            if (P2ON(2)) { unsigned char* w = ws; int tl = tid; asm volatile("" : "+s"(w), "+v"(tl));
              pg8::Gemm g{(bf16_t*)(w + WS_KVLAT), (bf16_t*)(w + WS_WUKV), M, 1024, 256, 256}; pg8::StaticOrder S; S.init(M, 1024, G, G - 1 - bx);
              EpiRowScale<0> E{(float*)(w + WS_LSSQ), (bf16_t*)(w + WS_KVB), 1024, 1.f}; pg8::gemm_phase(lds, tl, g, S, E); }
            if (P2ON(3)) { unsigned char* w = ws; int tl = tid; asm volatile("" : "+s"(w), "+v"(tl));
              pg8::Gemm g{(bf16_t*)(w + WS_MEMB), (bf16_t*)(w + WS_WXKV), MM, 1024, 1024, 1024}; pg8::StaticOrder S; S.init(MM, 1024, G, (bx + 128) % G);
              EpiRowScale<1> E{(float*)(w + WS_RSTDM), (bf16_t*)(w + WS_KVX), 1024, 1.f}; pg8::gemm_phase(lds, tl, g, S, E); }
        } else if (p == 3) {
            for (int v = vcu; v < 256; v += G) {
                const int bh = v >> 1, b = bh >> 3, h = bh & 7;
                for (int rep = DUP(3) ? 0 : 1; rep < 2; ++rep)
#pragma unroll 1
                for (int i = 0; i < 4; ++i) {
                    const int cur = (v & 1) ? ((i == 0) ? 2 : (i == 1) ? 5 : (i == 2) ? 3 : 4) : ((i == 0) ? 0 : (i == 1) ? 7 : (i == 2) ? 1 : 6);
                    const size_t rowb = (size_t)b * SEQ, rowq = rowb + cur * 256;
                    attn_unit<64, 64, 0>(lds, tid, QKVA + rowq * 1536 + h * 64, 1536, QKVA + rowb * 1536 + 512 + h * 64, 1536, nullptr,
                                         QKVA + rowb * 1536 + 1024 + h * 64, 1536, rep ? QKVA + rowq * 1536 + h * 64 : (bf16_t*)(ws + 473 * MiB) + rowq * 512 + h * 64, rep ? 1536 : 512, cur * 256, 4 * (cur + 1), KBAR + (size_t)bh * 512, cur);
                }
                for (int rep = 0; rep < 1 + DUP(4); ++rep)
#pragma unroll 1
                for (int i = 0; i < 4; ++i) {
                    const int cur = (v & 1) ? ((i == 0) ? 2 : (i == 1) ? 5 : (i == 2) ? 3 : 4) : ((i == 0) ? 0 : (i == 1) ? 7 : (i == 2) ? 1 : 6);
                    const size_t rowb = (size_t)b * SEQ, rowq = rowb + cur * 256;
                    attn_unit<96, 64, 1>(lds, tid, QB + rowq * 768 + h * 96, 768, KVB + rowb * 1024 + h * 128, 1024, KPE + rowb * 32,
                                         KVB + rowb * 1024 + h * 128 + 64, 1024, OB + rowq * 512 + h * 64, 512, cur * 256, 4 * (cur + 1), nullptr, cur);
                }
            }
        } else if (p == 4) {
            { unsigned char* w = ws; int tl = tid; asm volatile("" : "+s"(w), "+v"(tl));
              pg8::Gemm g{(bf16_t*)(w + WS_QKVA), (bf16_t*)(w + WS_WBA), M, 1024, 512, 1536}; pg8::StaticOrder S; S.init(M, 1024, G, bx); EpiBranch<0> E{(bf16_t*)(w + WS_GATES)}; pg8::gemm_phase(lds, tl, g, S, E); }
            { unsigned char* w = ws; int tl = tid; asm volatile("" : "+s"(w), "+v"(tl));
              pg8::Gemm g{(bf16_t*)(w + WS_LAT), (bf16_t*)(w + WS_WBB), M, 1024, 512, 512}; pg8::StaticOrder S; S.init(M, 1024, G, bx); EpiBranch<1> E{(bf16_t*)(w + WS_GATES)}; pg8::gemm_phase(lds, tl, g, S, E); }
        } else if (p == 5) {
            pg8::Gemm g{GATES, Wout_t, M, 1024, 1024, 2048}; pg8::StaticOrder S; S.init(M, 1024, G, bx);
            EpiRes E{xin, aout, XB, SSQ}; pg8::gemm_phase(lds, tid, g, S, E);
        } else if (p == 6) {
            pg8::Gemm g{XB, Wxq_t, M, 512, 1024, 1024}; pg8::StaticOrder S; S.init(M, 512, G, bx);
            EpiRowScale<2> E{SSQ, QX, 512, C2X}; pg8::gemm_phase(lds, tid, g, S, E);
        } else if (p == 7) {
            for (int un = vcu * 2; un < 512; un += 2 * G)
                for (int rep = DUP(7) ? 0 : 1; rep < 2; ++rep)
#pragma unroll 1
                for (int i = 0; i < 2; ++i) {
                    const int unit = un + i, bh = unit >> 3, qb = unit & 7, b = bh >> 2, h = bh & 3;
                    const size_t rowq = (size_t)b * SEQ + qb * 256, rowm = (size_t)b * MEMLEN;
                    attn_unit<128, 128, 2>(lds, tid, QX + rowq * 512 + h * 128, 512, KVX + rowm * 1024 + h * 128, 1024, nullptr,
                                           KVX + rowm * 1024 + 512 + h * 128, 1024, (rep ? QX : (bf16_t*)(ws + 473 * MiB)) + rowq * 512 + h * 128, 512, 0, 4, nullptr, 0);
                }
        } else if (p == 8) {
            pg8::Gemm g{QX, Wxo_t, M, 1024, 512, 512}; pg8::StaticOrder S; S.init(M, 1024, G, bx);
            EpiRes E{aout, aout, XB, SSQ}; pg8::gemm_phase(lds, tid, g, S, E);
        } else if (p == 9) {
            pg8::Gemm g{XB, Wgu_t, M, 2 * DFF, 1024, 1024}; pg8::StaticOrder S; S.init(M, 2 * DFF, G, bx);
            EpiGU E{SSQ, ACT}; for (int rep = 0; rep < 1 + DUP(9); ++rep) { int tl = tid; asm volatile("" : "+v"(tl)); pg8::gemm_phase(lds, tl, g, S, E); }
        } else {
            pg8::Gemm g{ACT, Wdn_t, M, 1024, DFF, DFF}; pg8::StaticOrder S; S.init(M, 1024, G, bx);
            EpiRes E{aout, aout, XB, SSQ}; pg8::gemm_phase(lds, tid, g, S, E);
        }
    }
}

extern "C" void kernel_launch(void* const* d_in, const int* in_sizes, int n_in, void* d_out, int out_size, void* d_ws, size_t ws_size, hipStream_t stream) {
    static int grid = 0;
    if (grid == 0) {
        if (n_in != 21 || in_sizes[0] != M * DM || out_size != M * DM || ws_size < WS_END) {
            fprintf(stderr, "kernel_launch: unexpected shapes (n_in %d, in0 %d, out %d, ws %zu); nothing launched\n", n_in, n_in > 0 ? in_sizes[0] : -1, out_size, ws_size); grid = -1; return; }
        int dev = 0, cus = 0, per_cu = 0;
        hipGetDevice(&dev); hipDeviceGetAttribute(&cus, hipDeviceAttributeMultiprocessorCount, dev);
        if (hipOccupancyMaxActiveBlocksPerMultiprocessor(&per_cu, (const void*)fwd_kernel, 512, 0) != hipSuccess || per_cu < 1) per_cu = 1;
        (void)hipGetLastError();
        grid = cus * 1;
        if (grid <= 0) grid = 256;
    }
    if (grid < 0) return;
    Args a{};
    a.x = (const float*)d_in[0]; a.mem = (const float*)d_in[1]; a.pos = (const int*)d_in[2];
    a.norm_mix = (const float*)d_in[3]; a.w_in = (const float*)d_in[4]; a.q_lat_norm = (const float*)d_in[5]; a.w_uq = (const float*)d_in[6];
    a.kv_lat_norm = (const float*)d_in[7]; a.w_ukv = (const float*)d_in[8]; a.w_ba = (const float*)d_in[9]; a.w_bb = (const float*)d_in[10]; a.w_out = (const float*)d_in[11];
    a.norm_x = (const float*)d_in[12]; a.norm_mem = (const float*)d_in[13]; a.w_xq = (const float*)d_in[14]; a.w_xkv = (const float*)d_in[15]; a.w_xo = (const float*)d_in[16];
    a.norm_ffn = (const float*)d_in[17]; a.w_gu = (const float*)d_in[18]; a.w_dn = (const float*)d_in[19]; a.norm_final = (const float*)d_in[20];
    a.out = (float*)d_out; a.ws = (unsigned char*)d_ws;
#if ONE_LAUNCH
    if (hipMemsetAsync((char*)d_ws + WS_CTL, 0, 65536, stream) != hipSuccess) { fprintf(stderr, "kernel_launch: memset of the barrier words failed\n"); return; }
    a.ph_lo = 0; a.ph_hi = N_PHASES;
    void* args[] = {&a};
    hipError_t e = hipLaunchCooperativeKernel((const void*)fwd_kernel, dim3(grid), dim3(512), args, 0, stream);
    if (e != hipSuccess) fprintf(stderr, "cooperative launch failed: %s (grid %d)\n", hipGetErrorString(e), grid);
#else
    for (int ph = 0; ph < N_PHASES; ++ph) {
        a.ph_lo = ph; a.ph_hi = ph + 1;
        hipLaunchKernelGGL(fwd_kernel, dim3(grid), dim3(512), 0, stream, a);
    }
#endif
}
```

```cpp
#include <hip/hip_runtime.h>
#include <hip/hip_cooperative_groups.h>
#include <cstdio>
#include <cstdint>
namespace cg = cooperative_groups;

#ifndef ONE_LAUNCH
#define ONE_LAUNCH 1
#endif

#ifndef PHMASK
#define PHMASK 0xFFFF
#endif
#ifndef P2MASK
#define P2MASK 0xF
#endif
#define P2ON(k) (((P2MASK) >> (k)) & 1)
#ifndef DUPMASK
#define DUPMASK 0
#endif
#ifndef XSYNC
#define XSYNC 0
#endif
#define DUP(k) (((DUPMASK) >> (k)) & 1)
#define PHON(k) (((PHMASK) >> (k)) & 1)
#define LAS __attribute__((address_space(3)))
typedef unsigned short bf16_t;
typedef short bf16x8 __attribute__((ext_vector_type(8)));
typedef float f32x4 __attribute__((ext_vector_type(4)));
typedef float f32x16 __attribute__((ext_vector_type(16)));
typedef unsigned u32x4 __attribute__((ext_vector_type(4)));
typedef unsigned u32x2 __attribute__((ext_vector_type(2)));

constexpr int NBATCH = 16, SEQ = 2048, DM = 1024, DEPTH = 4, MEMLEN = 256;
constexpr int M = NBATCH * SEQ;
constexpr int MM = NBATCH * MEMLEN;
constexpr int IN_W = 4256, IN_WP = 4352;
constexpr int DFF = 2816;
constexpr float EPS = 1e-6f;
constexpr float LOG2E = 1.4426950408889634f;
constexpr float C2A = 0.125f * LOG2E;
constexpr float C2B = 0.10206207261596575f * LOG2E;
constexpr float C2X = 0.08838834764831845f * LOG2E;

constexpr size_t MiB = 1u << 20;
constexpr size_t WS_WIN = 0 * MiB, WS_WUQ = 9 * MiB, WS_WUKV = 10 * MiB, WS_WBA = 11 * MiB, WS_WBB = 12 * MiB, WS_WOUT = 13 * MiB,
                 WS_WXQ = 15 * MiB, WS_WXKV = 16 * MiB, WS_WXO = 18 * MiB, WS_WGU = 19 * MiB, WS_WDN = 30 * MiB;
constexpr size_t WS_XB = 36 * MiB;
constexpr size_t WS_QKVA = 100 * MiB;
constexpr size_t WS_LAT = 196 * MiB;
constexpr size_t WS_KVLAT = 228 * MiB;
constexpr size_t WS_GATES = 244 * MiB;
constexpr size_t WS_ACT = 100 * MiB;
constexpr size_t WS_KVB = 372 * MiB;
constexpr size_t WS_KVX = 436 * MiB;
constexpr size_t WS_MEMB = 444 * MiB;
constexpr size_t WS_KPE = 452 * MiB;
constexpr size_t WS_COSA = 454 * MiB, WS_SINA = 458 * MiB;
constexpr size_t WS_COSB = 462 * MiB, WS_SINB = 464 * MiB;
constexpr size_t WS_SSQ = 466 * MiB;
constexpr size_t WS_LSSQ = 468 * MiB;
constexpr size_t WS_RSTDM = 470 * MiB;
constexpr size_t WS_KBAR = 470 * MiB + 65536;
constexpr size_t WS_CTL = 471 * MiB;
constexpr size_t WS_END = 472 * MiB;

typedef float f32x2_t __attribute__((ext_vector_type(2))); typedef __bf16 bf16x2_t __attribute__((ext_vector_type(2)));
__device__ __forceinline__ unsigned cvt_pk_bf16(float lo, float hi) { f32x2_t v = {lo, hi}; bf16x2_t b = __builtin_convertvector(v, bf16x2_t); return __builtin_bit_cast(unsigned, b); }
__device__ __forceinline__ float bf2f(unsigned short b) { return __uint_as_float(((unsigned)b) << 16); }
__device__ __forceinline__ float bflo(unsigned w) { return __uint_as_float(w << 16); }
__device__ __forceinline__ float bfhi(unsigned w) { return __uint_as_float(w & 0xffff0000u); }
__device__ __forceinline__ unsigned short f2bf1(float f) { return (unsigned short)(cvt_pk_bf16(f, 0.f) & 0xffffu); }

namespace pg8 {
constexpr int BM = 256, BK = 64, HALF = 128, HTB = HALF * BK * 2, STAGE_BYTES = 8 * HTB, NXCD = 8, WGM = 8;
__host__ __device__ __forceinline__ int lds_byte(int r, int c) { const int st = (r >> 4) * 2 + (c >> 5), rr = r & 15, cc = c & 31, ob = rr * 64 + cc * 2; return st * 1024 + (ob ^ (((ob >> 9) & 1) << 5)); }
__host__ __device__ __forceinline__ void stage_rc(int b, int& R, int& C) { const int st = b / 1024, sb = b % 1024, swz = sb ^ (((sb >> 9) & 1) << 5); R = (st >> 1) * 16 + swz / 64; C = (st & 1) * 32 + (swz % 64) / 2; }
__host__ __device__ __forceinline__ int perm32(int rho) { const int n = rho >> 4, i = rho & 15; return 8 * (i >> 2) + 4 * n + (i & 3); }

struct Unit { int pm, pn; };
struct Gemm { const bf16_t* A; const bf16_t* Bt; int M, N, K, lda; };

struct StaticOrder {
    int nM, nN, nwg, G, c;
    __device__ void init(int M_, int N_, int G_, int c_) { nM = M_ / BM; nN = N_ / BM; nwg = nM * nN; G = G_; c = c_; }
    __device__ bool next(int i, Unit& u) const {
        const long L = (long)i * G + c; if (L >= nwg) return false;
        int wgid = (int)L; { const int q = nwg / NXCD, r = nwg % NXCD, xcd = wgid % NXCD, off = wgid / NXCD; wgid = (xcd < r ? xcd * (q + 1) : r * (q + 1) + (xcd - r) * q) + off; }
        const int nig = WGM * nN, gid = wgid / nig, fm = gid * WGM, gsz = (nM - fm) < WGM ? (nM - fm) : WGM;
        u.pm = fm + ((wgid % nig) % gsz); u.pn = (wgid % nig) / gsz; return true;
    }
};

template <class Epi>
__device__ __forceinline__ void gemm_phase(LAS unsigned char* lds, const int tid, const Gemm g, const StaticOrder& S, const Epi& E) {
    const int wid = __builtin_amdgcn_readfirstlane(tid >> 6), lane = tid & 63, wr = wid >> 2, wc = wid & 3, fr = lane & 15, fq = lane >> 4;
    const int K = g.K, nt = K / BK;
    unsigned voffA[2], voffB[2];
#pragma unroll
    for (int i = 0; i < 2; ++i) { int R, C; stage_rc(tid * 16 + i * 8192, R, C); const int Rb = Epi::PERM ? ((R & ~31) + perm32(R & 31)) : R;
        voffA[i] = (unsigned)(R * g.lda + C) * 2u; voffB[i] = (unsigned)(Rb * K + C) * 2u; }
    const size_t kstep = (size_t)(BK * 2);
    const size_t hstepA = (size_t)HALF * g.lda * 2, hstepB = (size_t)HALF * K * 2;
    const size_t tstepA = 2 * hstepA, tstepB = 2 * hstepB;
    const unsigned ldsw = (unsigned)wid * 1024u;
    const int aoff = lds_byte(wr * 64 + fr, fq * 8), boff = lds_byte(wc * 32 + fr, fq * 8);
#define PG8_SA(b, h) (((b) * 2 + (h)) * HTB)
#define PG8_SB(b, h) ((4 + (b) * 2 + (h)) * HTB)
#define PG8_STAGE(bufoff, gbase, voff) do { _Pragma("unroll") for (int _i = 0; _i < 2; ++_i) \
        __builtin_amdgcn_global_load_lds((const unsigned*)((const char*)(gbase) + (voff)[_i]), (LAS unsigned*)(lds + (bufoff) + ldsw + _i * 8192), 16, 0, 0); } while (0)
#define PG8_LDA(dst, b, h) do { _Pragma("unroll") for (int m = 0; m < 4; ++m) _Pragma("unroll") for (int k = 0; k < 2; ++k) dst[m][k] = *(const LAS bf16x8*)(lds + PG8_SA(b, h) + aoff + m * 2048 + k * 1024); } while (0)
#define PG8_LDB(dst, b, h) do { _Pragma("unroll") for (int n = 0; n < 2; ++n) _Pragma("unroll") for (int k = 0; k < 2; ++k) dst[n][k] = *(const LAS bf16x8*)(lds + PG8_SB(b, h) + boff + n * 2048 + k * 1024); } while (0)
#define PG8_MMA(ai, bj, At, Bt) do { __builtin_amdgcn_s_setprio(1); _Pragma("unroll") for (int m = 0; m < 4; ++m) _Pragma("unroll") for (int n = 0; n < 2; ++n) _Pragma("unroll") for (int k = 0; k < 2; ++k) \
        acc[ai][bj][m][n] = __builtin_amdgcn_mfma_f32_16x16x32_bf16(Bt[n][k], At[m][k], acc[ai][bj][m][n], 0, 0, 0); __builtin_amdgcn_s_setprio(0); } while (0)
#define PG8_WAIT_V(n) asm volatile("s_waitcnt vmcnt(" #n ")" ::: "memory")
#define PG8_WAIT_L(n) asm volatile("s_waitcnt lgkmcnt(" #n ")" ::: "memory")
#define PG8_BAR __builtin_amdgcn_s_barrier()
#define PG8_SCHED __builtin_amdgcn_sched_barrier(0)
    Unit cur, nxt; int ui = 0;
    if (!S.next(0, cur)) return;
    f32x4 acc[2][2][4][2];
#pragma unroll
    for (int a = 0; a < 2; ++a)
#pragma unroll
        for (int b = 0; b < 2; ++b)
#pragma unroll
            for (int m = 0; m < 4; ++m)
#pragma unroll
                for (int n = 0; n < 2; ++n) acc[a][b][m][n] = (f32x4){0.f, 0.f, 0.f, 0.f};
    bf16x8 At[4][2], B0[2][2], B1[2][2];
    const char* cA = (const char*)g.A + (size_t)cur.pm * tstepA; const char* cB = (const char*)g.Bt + (size_t)cur.pn * tstepB;
    PG8_STAGE(PG8_SB(0, 0), cB, voffB); PG8_STAGE(PG8_SB(0, 1), cB + hstepB, voffB); PG8_STAGE(PG8_SA(0, 0), cA, voffA); PG8_STAGE(PG8_SA(0, 1), cA + hstepA, voffA);
    if (wr == 1) PG8_BAR;
    PG8_WAIT_V(2); PG8_BAR;
    PG8_STAGE(PG8_SB(1, 0), cB + kstep, voffB); PG8_STAGE(PG8_SA(1, 0), cA + kstep, voffA); PG8_STAGE(PG8_SB(1, 1), cB + hstepB + kstep, voffB);
    PG8_WAIT_V(6); PG8_BAR;
    for (;;) {
        const bool has_next = S.next(ui + 1, nxt);
        const char* nA = has_next ? (const char*)g.A + (size_t)nxt.pm * tstepA : cA; const char* nB = has_next ? (const char*)g.Bt + (size_t)nxt.pn * tstepB : cB;
#pragma unroll 1
        for (int t = 0; t < nt; t += 2) {
            const bool last = (t == nt - 2);
            const char* a1 = cA + (size_t)(t + 1) * kstep;
            const char* a2 = last ? nA : cA + (size_t)(t + 2) * kstep; const char* b2 = last ? nB : cB + (size_t)(t + 2) * kstep;
            const char* a3 = a2 + kstep; const char* b3 = b2 + kstep;
            PG8_LDB(B0, 0, 0); PG8_LDB(B1, 0, 1); PG8_SCHED; PG8_LDA(At, 0, 0); PG8_STAGE(PG8_SA(1, 1), a1 + hstepA, voffA);
            PG8_WAIT_V(8); PG8_WAIT_L(0); PG8_BAR; PG8_MMA(0, 0, At, B0); PG8_MMA(0, 1, At, B1); PG8_BAR; PG8_SCHED;
            PG8_LDA(At, 0, 1); PG8_STAGE(PG8_SB(0, 0), b2, voffB); PG8_STAGE(PG8_SB(0, 1), b2 + hstepB, voffB); PG8_STAGE(PG8_SA(0, 0), a2, voffA);
            PG8_WAIT_V(8); PG8_WAIT_L(0); PG8_BAR; PG8_MMA(1, 0, At, B0); PG8_MMA(1, 1, At, B1); PG8_BAR; PG8_SCHED;
            PG8_LDB(B0, 1, 0); PG8_LDB(B1, 1, 1); PG8_SCHED; PG8_LDA(At, 1, 0); PG8_STAGE(PG8_SA(0, 1), a2 + hstepA, voffA);
            PG8_WAIT_V(8); PG8_WAIT_L(0); PG8_BAR; PG8_MMA(0, 0, At, B0); PG8_MMA(0, 1, At, B1); PG8_BAR; PG8_SCHED;
            PG8_LDA(At, 1, 1); PG8_STAGE(PG8_SB(1, 0), b3, voffB); PG8_STAGE(PG8_SB(1, 1), b3 + hstepB, voffB); PG8_STAGE(PG8_SA(1, 0), a3, voffA);
            PG8_WAIT_V(8); PG8_WAIT_L(0); PG8_BAR; PG8_MMA(1, 0, At, B0); PG8_MMA(1, 1, At, B1); PG8_BAR; PG8_SCHED;
        }
        if (wr == 0) PG8_BAR;
        E(acc, cur, wr, wc, fr, fq);
        if (!has_next) break;
#pragma unroll
        for (int a = 0; a < 2; ++a)
#pragma unroll
            for (int b = 0; b < 2; ++b)
#pragma unroll
                for (int m = 0; m < 4; ++m)
#pragma unroll
                    for (int n = 0; n < 2; ++n) acc[a][b][m][n] = (f32x4){0.f, 0.f, 0.f, 0.f};
        cur = nxt; cA = nA; cB = nB; ++ui;
        if (wr == 1) PG8_BAR;
    }
    PG8_WAIT_V(0);
    PG8_BAR;
#undef PG8_SA
#undef PG8_SB
#undef PG8_STAGE
#undef PG8_LDA
#undef PG8_LDB
#undef PG8_MMA
#undef PG8_WAIT_V
#undef PG8_WAIT_L
#undef PG8_BAR
#undef PG8_SCHED
}
}

typedef f32x4 (&AccRef)[2][2][4][2];

__device__ __forceinline__ float quad_sum(float s) { s += __shfl_xor(s, 16); s += __shfl_xor(s, 32); return s; }
__device__ __forceinline__ float sq4(f32x4 v) { return (v.x * v.x + v.y * v.y) + (v.z * v.z + v.w * v.w); }
__device__ __forceinline__ float sum4(f32x4 v) { return (v.x + v.y) + (v.z + v.w); }
__device__ __forceinline__ u32x4 pack8(f32x4 a, f32x4 b) { u32x4 w; w.x = cvt_pk_bf16(a.x, a.y); w.y = cvt_pk_bf16(a.z, a.w); w.z = cvt_pk_bf16(b.x, b.y); w.w = cvt_pk_bf16(b.z, b.w); return w; }
__device__ __forceinline__ float sigmoidf_(float v) { return __builtin_amdgcn_rcpf(1.0f + __builtin_amdgcn_exp2f(v * (-LOG2E))); }
__device__ __forceinline__ f32x4 sig4(f32x4 v) { return (f32x4){sigmoidf_(v.x), sigmoidf_(v.y), sigmoidf_(v.z), sigmoidf_(v.w)}; }
#define ROWSTAT8(rs, base, inv_n, mul) do { f32x4 pv_[2][4]; \
    _Pragma("unroll") for (int ai = 0; ai < 2; ++ai) _Pragma("unroll") for (int m = 0; m < 4; ++m) pv_[ai][m] = *(const f32x4*)((base) + (size_t)(u.pm * 256 + ai * 128 + wr * 64 + m * 16 + fr) * 16 + 4 * fq); \
    _Pragma("unroll") for (int ai = 0; ai < 2; ++ai) _Pragma("unroll") for (int m = 0; m < 4; ++m) rs[ai][m] = rsqrtf(quad_sum(sum4(pv_[ai][m])) * (inv_n) + EPS) * (mul); } while (0)

struct EpiIn {
    static constexpr bool PERM = true;
    const float* ssq; bf16_t* qkva; bf16_t* lat; bf16_t* kvlat; bf16_t* gates; float* lssq; const float* cosA; const float* sinA;
    __device__ __forceinline__ void operator()(AccRef acc, const pg8::Unit& u, int wr, int wc, int fr, int fq) const {
        const int pn = u.pn;
        float rs[2][4];
        ROWSTAT8(rs, ssq, 1.0f / 1024.0f, 1.0f);
        if (pn < 4) {
            const float sc = (pn < 2) ? C2A : 1.0f;
            f32x4 cs[2][4];
#define ROPE_LOAD(ai, m0) _Pragma("unroll") for (int mm = 0; mm < 2; ++mm) { const size_t ro = (size_t)(u.pm * 256 + (ai) * 128 + wr * 64 + ((m0) + mm) * 16 + fr) * 32 + 8 * fq; \
            cs[mm][0] = *(const f32x4*)(cosA + ro); cs[mm][1] = *(const f32x4*)(cosA + ro + 4); cs[mm][2] = *(const f32x4*)(sinA + ro); cs[mm][3] = *(const f32x4*)(sinA + ro + 4); }
#define ROPE_COMP(ai, m0) _Pragma("unroll") for (int mm = 0; mm < 2; ++mm) { const int m = (m0) + mm; const float r_ = rs[ai][m] * sc; \
            const f32x4 v00 = acc[ai][0][m][0] * r_, v01 = acc[ai][0][m][1] * r_, v10 = acc[ai][1][m][0] * r_, v11 = acc[ai][1][m][1] * r_; \
            acc[ai][0][m][0] = v00 * cs[mm][0] - v10 * cs[mm][2]; acc[ai][0][m][1] = v01 * cs[mm][1] - v11 * cs[mm][3]; acc[ai][1][m][0] = v10 * cs[mm][0] + v00 * cs[mm][2]; acc[ai][1][m][1] = v11 * cs[mm][1] + v01 * cs[mm][3]; }
#define ROPE_STORE(ai, m0) _Pragma("unroll") for (int mm = 0; mm < 2; ++mm) { const int m = (m0) + mm; const int row = u.pm * 256 + (ai) * 128 + wr * 64 + m * 16 + fr; \
            bf16_t* d = qkva + (size_t)row * 1536 + (pn >> 1) * 512 + ((pn & 1) * 4 + wc) * 64 + 8 * fq; \
            *(u32x4*)d = pack8(acc[ai][0][m][0], acc[ai][0][m][1]); *(u32x4*)(d + 32) = pack8(acc[ai][1][m][0], acc[ai][1][m][1]); }
            ROPE_LOAD(0, 0); ROPE_COMP(0, 0); ROPE_LOAD(0, 2); ROPE_STORE(0, 0); ROPE_COMP(0, 2); ROPE_LOAD(1, 0); ROPE_STORE(0, 2); ROPE_COMP(1, 0); ROPE_LOAD(1, 2); ROPE_STORE(1, 0); ROPE_COMP(1, 2); ROPE_STORE(1, 2);
#undef ROPE_LOAD
#undef ROPE_COMP
#undef ROPE_STORE
            return;
        }
#pragma unroll
        for (int ai = 0; ai < 2; ++ai)
#pragma unroll
            for (int m = 0; m < 4; ++m) {
                const int row = u.pm * 256 + ai * 128 + wr * 64 + m * 16 + fr;
                const float r_ = rs[ai][m];
                const f32x4 v00 = acc[ai][0][m][0] * r_, v01 = acc[ai][0][m][1] * r_, v10 = acc[ai][1][m][0] * r_, v11 = acc[ai][1][m][1] * r_;
                if (pn < 6) {
                    bf16_t* d = qkva + (size_t)row * 1536 + pn * 256 + wc * 32 + 8 * fq;
                    *(u32x4*)d = pack8(v00, v01); *(u32x4*)(d + 128) = pack8(v10, v11);
                } else if (pn < 8) {
                    bf16_t* d = lat + (size_t)row * 512 + (pn - 6) * 256 + wc * 32 + 8 * fq;
                    *(u32x4*)d = pack8(v00, v01); *(u32x4*)(d + 128) = pack8(v10, v11);
                    float s = sq4(v00) + sq4(v01); if (pn == 6) s += sq4(v10) + sq4(v11);
                    s = quad_sum(s);
                    if (fq == 0) lssq[(size_t)row * 16 + (pn - 6) * 4 + wc] = s;
                } else if (pn == 8) {
                    bf16_t* d = kvlat + (size_t)row * 256 + wc * 32 + 8 * fq;
                    *(u32x4*)d = pack8(v00, v01); *(u32x4*)(d + 128) = pack8(v10, v11);
                    float s = quad_sum(sq4(v00) + sq4(v01) + sq4(v10) + sq4(v11));
                    if (fq == 0) lssq[(size_t)row * 16 + 8 + wc] = s;
                } else {
                    bf16_t* d = gates + (size_t)row * 2048 + (pn - 9) * 256 + wc * 32 + 8 * fq;
                    *(u32x4*)d = pack8(sig4(v00), sig4(v01)); *(u32x4*)(d + 128) = pack8(sig4(v10), sig4(v11));
                }
            }
    }
};

struct EpiUq {
    static constexpr bool PERM = true;
    const float* lssq; bf16_t* qb; const float* cosB; const float* sinB;
    __device__ __forceinline__ void operator()(AccRef acc, const pg8::Unit& u, int wr, int wc, int fr, int fq) const {
        const int pn = u.pn;
        float rs[2][4];
        { f32x4 pv_[2][4];
#pragma unroll
          for (int ai = 0; ai < 2; ++ai)
#pragma unroll
              for (int m = 0; m < 4; ++m) pv_[ai][m] = *(const f32x4*)(lssq + (size_t)(u.pm * 256 + ai * 128 + wr * 64 + m * 16 + fr) * 16 + 4 * (fq & 1));
#pragma unroll
          for (int ai = 0; ai < 2; ++ai)
#pragma unroll
              for (int m = 0; m < 4; ++m) rs[ai][m] = rsqrtf(quad_sum((fq < 2) ? sum4(pv_[ai][m]) : 0.f) * (1.0f / 384.0f) + EPS) * C2B; }
        if (pn == 2) {
            const int head = 2 * wc + (fq >> 1), i0 = 8 * (fq & 1);
            f32x4 cs[2][4];
#define ROPE_LOAD(ai, m0) _Pragma("unroll") for (int mm = 0; mm < 2; ++mm) { const size_t ro = (size_t)(u.pm * 256 + (ai) * 128 + wr * 64 + ((m0) + mm) * 16 + fr) * 16 + i0; \
            cs[mm][0] = *(const f32x4*)(cosB + ro); cs[mm][1] = *(const f32x4*)(cosB + ro + 4); cs[mm][2] = *(const f32x4*)(sinB + ro); cs[mm][3] = *(const f32x4*)(sinB + ro + 4); }
#define ROPE_COMP(ai, m0) _Pragma("unroll") for (int mm = 0; mm < 2; ++mm) { const int m = (m0) + mm; const float r_ = rs[ai][m]; \
            const f32x4 v00 = acc[ai][0][m][0] * r_, v01 = acc[ai][0][m][1] * r_, v10 = acc[ai][1][m][0] * r_, v11 = acc[ai][1][m][1] * r_; \
            acc[ai][0][m][0] = v00 * cs[mm][0] - v10 * cs[mm][2]; acc[ai][0][m][1] = v01 * cs[mm][1] - v11 * cs[mm][3]; acc[ai][1][m][0] = v10 * cs[mm][0] + v00 * cs[mm][2]; acc[ai][1][m][1] = v11 * cs[mm][1] + v01 * cs[mm][3]; }
#define ROPE_STORE(ai, m0) _Pragma("unroll") for (int mm = 0; mm < 2; ++mm) { const int m = (m0) + mm; const int row = u.pm * 256 + (ai) * 128 + wr * 64 + m * 16 + fr; \
            bf16_t* d = qb + (size_t)row * 768 + head * 96 + 64 + i0; \
            *(u32x4*)d = pack8(acc[ai][0][m][0], acc[ai][0][m][1]); *(u32x4*)(d + 16) = pack8(acc[ai][1][m][0], acc[ai][1][m][1]); }
            ROPE_LOAD(0, 0); ROPE_COMP(0, 0); ROPE_LOAD(0, 2); ROPE_STORE(0, 0); ROPE_COMP(0, 2); ROPE_LOAD(1, 0); ROPE_STORE(0, 2); ROPE_COMP(1, 0); ROPE_LOAD(1, 2); ROPE_STORE(1, 0); ROPE_COMP(1, 2); ROPE_STORE(1, 2);
#undef ROPE_LOAD
#undef ROPE_COMP
#undef ROPE_STORE
            return;
        }
#pragma unroll
        for (int ai = 0; ai < 2; ++ai)
#pragma unroll
            for (int m = 0; m < 4; ++m) {
                const int row = u.pm * 256 + ai * 128 + wr * 64 + m * 16 + fr;
                const float r_ = rs[ai][m];
                const int c0 = pn * 256 + wc * 32 + 8 * fq, c1 = c0 + 128;
                *(u32x4*)(qb + (size_t)row * 768 + (c0 >> 6) * 96 + (c0 & 63)) = pack8(acc[ai][0][m][0] * r_, acc[ai][0][m][1] * r_);
                *(u32x4*)(qb + (size_t)row * 768 + (c1 >> 6) * 96 + (c1 & 63)) = pack8(acc[ai][1][m][0] * r_, acc[ai][1][m][1] * r_);
            }
    }
};

template <int MODE> struct EpiRowScale {
    static constexpr bool PERM = true;
    const float* stat; bf16_t* O; int ldc; float cs;
    __device__ __forceinline__ void operator()(AccRef acc, const pg8::Unit& u, int wr, int wc, int fr, int fq) const {
        float rs[2][4];
        if (MODE == 0) { f32x4 pv_[2][4];
#pragma unroll
            for (int ai = 0; ai < 2; ++ai)
#pragma unroll
                for (int m = 0; m < 4; ++m) pv_[ai][m] = *(const f32x4*)(stat + (size_t)(u.pm * 256 + ai * 128 + wr * 64 + m * 16 + fr) * 16 + 8);
#pragma unroll
            for (int ai = 0; ai < 2; ++ai)
#pragma unroll
                for (int m = 0; m < 4; ++m) rs[ai][m] = rsqrtf(sum4(pv_[ai][m]) * (1.0f / 256.0f) + EPS);
        } else if (MODE == 1) {
#pragma unroll
            for (int ai = 0; ai < 2; ++ai)
#pragma unroll
                for (int m = 0; m < 4; ++m) rs[ai][m] = stat[u.pm * 256 + ai * 128 + wr * 64 + m * 16 + fr];
        } else { ROWSTAT8(rs, stat, 1.0f / 1024.0f, cs); }
#pragma unroll
        for (int ai = 0; ai < 2; ++ai)
#pragma unroll
            for (int m = 0; m < 4; ++m) {
                const int row = u.pm * 256 + ai * 128 + wr * 64 + m * 16 + fr;
                const float r_ = rs[ai][m];
                bf16_t* d = O + (size_t)row * ldc + u.pn * 256 + wc * 32 + 8 * fq;
                *(u32x4*)d = pack8(acc[ai][0][m][0] * r_, acc[ai][0][m][1] * r_);
                *(u32x4*)(d + 128) = pack8(acc[ai][1][m][0] * r_, acc[ai][1][m][1] * r_);
            }
    }
};

template <int Z> struct EpiBranch {
    static constexpr bool PERM = true;
    bf16_t* gates;
    __device__ __forceinline__ void operator()(AccRef acc, const pg8::Unit& u, int wr, int wc, int fr, int fq) const {
        u32x4 gt[4][2], tt[4][2];
#define BR_LOAD(ai) _Pragma("unroll") for (int m = 0; m < 4; ++m) _Pragma("unroll") for (int bj = 0; bj < 2; ++bj) { \
            const bf16_t* d = gates + (size_t)(u.pm * 256 + (ai) * 128 + wr * 64 + m * 16 + fr) * 2048 + u.pn * 256 + bj * 128 + wc * 32 + 8 * fq; \
            if (Z == 0) gt[m][bj] = *(const u32x4*)d; else { tt[m][bj] = *(const u32x4*)d; gt[m][bj] = *(const u32x4*)(d + 1024); } }
#define BR_COMP(ai) _Pragma("unroll") for (int m = 0; m < 4; ++m) _Pragma("unroll") for (int bj = 0; bj < 2; ++bj) { const u32x4 g = gt[m][bj]; const f32x4 a0 = acc[ai][bj][m][0], a1 = acc[ai][bj][m][1]; \
            f32x4 r0 = {bflo(g.x) * a0.x, bfhi(g.x) * a0.y, bflo(g.y) * a0.z, bfhi(g.y) * a0.w}, r1 = {bflo(g.z) * a1.x, bfhi(g.z) * a1.y, bflo(g.w) * a1.z, bfhi(g.w) * a1.w}; \
            if (Z == 1) { const u32x4 t = tt[m][bj]; r0 = r0 + (f32x4){bflo(t.x), bfhi(t.x), bflo(t.y), bfhi(t.y)}; r1 = r1 + (f32x4){bflo(t.z), bfhi(t.z), bflo(t.w), bfhi(t.w)}; } \
            acc[ai][bj][m][0] = r0; acc[ai][bj][m][1] = r1; }
#define BR_STORE(ai) _Pragma("unroll") for (int m = 0; m < 4; ++m) _Pragma("unroll") for (int bj = 0; bj < 2; ++bj) { \
            bf16_t* d = gates + (size_t)(u.pm * 256 + (ai) * 128 + wr * 64 + m * 16 + fr) * 2048 + u.pn * 256 + bj * 128 + wc * 32 + 8 * fq; \
            *(u32x4*)d = pack8(acc[ai][bj][m][0], acc[ai][bj][m][1]); }
        BR_LOAD(0); BR_COMP(0); BR_LOAD(1); BR_STORE(0); BR_COMP(1); BR_STORE(1);
#undef BR_LOAD
#undef BR_COMP
#undef BR_STORE
    }
};

struct EpiRes {
    static constexpr bool PERM = false;
    const float* xin; float* xout; bf16_t* xb; float* ssq;
    __device__ __forceinline__ void operator()(AccRef acc, const pg8::Unit& u, int wr, int wc, int fr, int fq) const {
        f32x4 xv[2][2][2];
        const size_t ubase = (size_t)(u.pm * 256 + wr * 64) * 1024 + u.pn * 256 + wc * 32;
        unsigned loff = (unsigned)(fr * 1024 + 4 * fq);
        asm volatile("" : "+v"(loff));
        typedef __attribute__((address_space(1))) float gf32; typedef __attribute__((address_space(1))) f32x4 gf32x4; typedef __attribute__((address_space(1))) u32x2 gu32x2; typedef __attribute__((address_space(1))) bf16_t gbf16;
        const gf32* xi = (const gf32*)(xin + ubase); gf32* xo = (gf32*)(xout + ubase); gbf16* xbo = (gbf16*)(xb + ubase);
#define RS_OFF(ai, m, bj, n) (((ai) * 128 + (m) * 16) * 1024 + (bj) * 128 + (n) * 16)
#define RS_LOAD(ai, m0) _Pragma("unroll") for (int mm = 0; mm < 2; ++mm) _Pragma("unroll") for (int bj = 0; bj < 2; ++bj) _Pragma("unroll") for (int n = 0; n < 2; ++n) xv[mm][bj][n] = *(const gf32x4*)(xi + RS_OFF(ai, (m0) + mm, bj, n) + loff);
#define RS_COMP(ai, m0) _Pragma("unroll") for (int mm = 0; mm < 2; ++mm) _Pragma("unroll") for (int bj = 0; bj < 2; ++bj) _Pragma("unroll") for (int n = 0; n < 2; ++n) acc[ai][bj][(m0) + mm][n] = acc[ai][bj][(m0) + mm][n] + xv[mm][bj][n];
#define RS_STORE(ai, m0) _Pragma("unroll") for (int mm = 0; mm < 2; ++mm) { const int m = (m0) + mm; float s = 0.f; \
            _Pragma("unroll") for (int bj = 0; bj < 2; ++bj) _Pragma("unroll") for (int n = 0; n < 2; ++n) { const f32x4 o = acc[ai][bj][m][n]; \
                *(gf32x4*)(xo + RS_OFF(ai, m, bj, n) + loff) = o; s += sq4(o); u32x2 w; w.x = cvt_pk_bf16(o.x, o.y); w.y = cvt_pk_bf16(o.z, o.w); *(gu32x2*)(xbo + RS_OFF(ai, m, bj, n) + loff) = w; } \
            s = quad_sum(s); if (fq == 0) ssq[(size_t)(u.pm * 256 + (ai) * 128 + wr * 64 + m * 16 + fr) * 16 + u.pn * 4 + wc] = s; }
        RS_LOAD(0, 0); RS_COMP(0, 0); RS_LOAD(0, 2); RS_STORE(0, 0); RS_COMP(0, 2); RS_LOAD(1, 0); RS_STORE(0, 2); RS_COMP(1, 0); RS_LOAD(1, 2); RS_STORE(1, 0); RS_COMP(1, 2); RS_STORE(1, 2);
#undef RS_OFF
#undef RS_LOAD
#undef RS_COMP
#undef RS_STORE
    }
};

struct EpiNull {
    static constexpr bool PERM = true;
    __device__ __forceinline__ void operator()(AccRef acc, const pg8::Unit& u, int wr, int wc, int fr, int fq) const {
#pragma unroll
        for (int ai = 0; ai < 2; ++ai)
#pragma unroll
            for (int bj = 0; bj < 2; ++bj)
#pragma unroll
                for (int m = 0; m < 4; ++m)
#pragma unroll
                    for (int n = 0; n < 2; ++n) asm volatile("" :: "v"(acc[ai][bj][m][n]));
    }
};
struct EpiGU {
    static constexpr bool PERM = true;
    const float* ssq; bf16_t* act;
    __device__ __forceinline__ void operator()(AccRef acc, const pg8::Unit& u, int wr, int wc, int fr, int fq) const {
        float rs[2][4];
        ROWSTAT8(rs, ssq, 1.0f / 1024.0f, 1.0f);
#pragma unroll
        for (int ai = 0; ai < 2; ++ai)
#pragma unroll
            for (int m = 0; m < 4; ++m) {
                const int row = u.pm * 256 + ai * 128 + wr * 64 + m * 16 + fr;
                const float r_ = rs[ai][m];
                const f32x4 g0 = acc[ai][0][m][0] * r_, g1 = acc[ai][0][m][1] * r_, u0 = acc[ai][1][m][0] * r_, u1 = acc[ai][1][m][1] * r_;
                const f32x4 a0 = g0 * sig4(g0) * u0, a1 = g1 * sig4(g1) * u1;
                *(u32x4*)(act + (size_t)row * DFF + u.pn * 128 + wc * 32 + 8 * fq) = pack8(a0, a1);
            }
    }
};

typedef short v4i16_t __attribute__((ext_vector_type(4)));
__device__ __forceinline__ v4i16_t vtr(const LAS unsigned char* p) { return __builtin_amdgcn_ds_read_tr16_b64_v4i16((LAS v4i16_t*)p); }
template <int DQK, int DV, int MODE>
__device__ __forceinline__ void attn_unit(LAS unsigned char* lds, const int tid, const bf16_t* Qg, int ldq, const bf16_t* Kg, int ldk, const bf16_t* K2g,
                                          const bf16_t* Vg, int ldv, bf16_t* Og, int ldo, int qbase, int NT, const float* kbar, int cur) {
    constexpr int KS = DQK + 8;
    constexpr int KBUF = 64 * KS * 2, VBUF = (DV / 32) * 4096;
    constexpr int KMAIN = (MODE == 1) ? 64 : DQK;
    constexpr int KCH = KMAIN / 8, NK = (64 * KCH) / 512, VCH = DV / 8, NV = (64 * VCH) / 512;
    constexpr int NJ = DQK / 16, ND = DV / 32;
    constexpr float THR = 8.0f;
    const int lane = tid & 63, wid = __builtin_amdgcn_readfirstlane(tid >> 6), r32 = lane & 31, hi = lane >> 5;
    bf16x8 qf[NJ];
    { const bf16_t* qrow = Qg + (size_t)(wid * 32 + r32) * ldq + 8 * hi;
#pragma unroll
      for (int j = 0; j < NJ; ++j) qf[j] = *(const bf16x8*)(qrow + 16 * j); }
    unsigned selmask = 0xffu;
    if (MODE == 0 && cur > 3) {
        float g[7];
#pragma unroll
        for (int j = 0; j < 7; ++j) {
            float a = 0.f;
            if (j < cur) {
#pragma unroll
                for (int jj = 0; jj < 4; ++jj) {
                    const f32x4 k0 = *(const f32x4*)(kbar + j * 64 + 16 * jj + 8 * hi), k1 = *(const f32x4*)(kbar + j * 64 + 16 * jj + 8 * hi + 4);
                    a += bf2f((unsigned short)qf[jj][0]) * k0.x + bf2f((unsigned short)qf[jj][1]) * k0.y + bf2f((unsigned short)qf[jj][2]) * k0.z + bf2f((unsigned short)qf[jj][3]) * k0.w
                       + bf2f((unsigned short)qf[jj][4]) * k1.x + bf2f((unsigned short)qf[jj][5]) * k1.y + bf2f((unsigned short)qf[jj][6]) * k1.z + bf2f((unsigned short)qf[jj][7]) * k1.w;
                }
                a += __shfl_xor(a, 32);
            }
            g[j] = a;
        }
        unsigned sm = 0u;
#pragma unroll
        for (int j = 0; j < 7; ++j) {
            int rank = 0;
#pragma unroll
            for (int i = 0; i < 7; ++i) if (i != j) rank += (i < cur && (g[i] > g[j] || (g[i] == g[j] && i < j))) ? 1 : 0;
            if (j < cur && rank < 3) sm |= (1u << j);
        }
        selmask = sm | (1u << cur);
    }
    u32x4 kreg[NK], vreg[NV], k2reg = {0u, 0u, 0u, 0u};
#define ATT_LOAD(t) do { \
    _Pragma("unroll") for (int i = 0; i < NK; ++i) { const int idx = tid + 512 * i, kv = idx / KCH, c = idx % KCH; kreg[i] = *(const u32x4*)(Kg + (size_t)(64 * (t) + kv) * ldk + 8 * c); } \
    if (MODE == 1) { if (tid < 256) k2reg = *(const u32x4*)(K2g + (size_t)(64 * (t) + (tid >> 2)) * 32 + 8 * (tid & 3)); } \
    _Pragma("unroll") for (int i = 0; i < NV; ++i) { const int idx = tid + 512 * i, kv = idx / VCH, c = idx % VCH; vreg[i] = *(const u32x4*)(Vg + (size_t)(64 * (t) + kv) * ldv + 8 * c); } } while (0)
#define ATT_STORE(buf) do { LAS unsigned char* kb_ = lds + (buf) * KBUF; LAS unsigned char* vb_ = lds + 2 * KBUF + (buf) * VBUF; \
    _Pragma("unroll") for (int i = 0; i < NK; ++i) { const int idx = tid + 512 * i, kv = idx / KCH, c = idx % KCH; *(LAS u32x4*)(kb_ + (kv * KS + 8 * c) * 2) = kreg[i]; } \
    if (MODE == 1) { if (tid < 256) *(LAS u32x4*)(kb_ + ((tid >> 2) * KS + 64 + 8 * (tid & 3)) * 2) = k2reg; } \
    _Pragma("unroll") for (int i = 0; i < NV; ++i) { const int idx = tid + 512 * i, kv = idx / VCH, c = idx % VCH; *(LAS u32x4*)(vb_ + (c >> 2) * 4096 + kv * 64 + (c & 3) * 16) = vreg[i]; } } while (0)
    ATT_LOAD(0); ATT_STORE(0);
    __syncthreads();
    f32x16 o[ND];
#pragma unroll
    for (int d0 = 0; d0 < ND; ++d0)
#pragma unroll
        for (int r = 0; r < 16; ++r) o[d0][r] = 0.f;
    f32x16 negm;
#pragma unroll
    for (int r = 0; r < 16; ++r) negm[r] = 0.f;
    float mref = 0.f, lrun = 0.f;
    const int qabs = qbase + wid * 32 + r32;
    const int qwmax = qbase + wid * 32 + 31;
    const int vlane = (4 * hi + ((lane & 15) >> 2)) * 64 + ((lane >> 4) & 1) * 32 + (lane & 3) * 8;
    for (int t = 0; t < NT; ++t) {
        const int buf = t & 1;
        if (t + 1 < NT) ATT_LOAD(t + 1);
        bool lane_ok = true, causal = false, active = true;
        if (MODE == 0) { const int blk = t >> 2; if (blk < cur) lane_ok = ((selmask >> blk) & 1u) != 0u; else causal = (64 * t + 63 > qbase + wid * 32); active = (__any(lane_ok ? 1 : 0) != 0) && (64 * t <= qwmax); }
        if (MODE == 1) { causal = (64 * t + 63 > qbase + wid * 32); active = (64 * t <= qwmax); }
        if (active) {
            const LAS unsigned char* kb = lds + buf * KBUF + (r32 * KS + 8 * hi) * 2;
            f32x16 s0 = negm, s1 = negm;
#pragma unroll
            for (int j = 0; j < NJ; ++j) {
                const bf16x8 k0 = *(const LAS bf16x8*)(kb + j * 32), k1 = *(const LAS bf16x8*)(kb + 32 * KS * 2 + j * 32);
                s0 = __builtin_amdgcn_mfma_f32_32x32x16_bf16(k0, qf[j], s0, 0, 0, 0);
                s1 = __builtin_amdgcn_mfma_f32_32x32x16_bf16(k1, qf[j], s1, 0, 0, 0);
            }
            if (MODE != 2) {
                if (!lane_ok) {
#pragma unroll
                    for (int r = 0; r < 16; ++r) { s0[r] = -INFINITY; s1[r] = -INFINITY; }
                } else if (causal) {
                    const int kb0 = 64 * t + 4 * hi;
#pragma unroll
                    for (int r = 0; r < 16; ++r) { const int kv = kb0 + (r & 3) + 8 * (r >> 2); if (kv > qabs) s0[r] = -INFINITY; if (kv + 32 > qabs) s1[r] = -INFINITY; }
                }
            }
            float mxa = fmaxf(fmaxf(s0[0], s0[1]), s1[0]), mxb = fmaxf(fmaxf(s0[2], s0[3]), s1[1]);
            mxa = fmaxf(fmaxf(mxa, s1[2]), s1[3]);
#pragma unroll
            for (int r = 4; r < 16; r += 4) { mxa = fmaxf(fmaxf(mxa, s0[r]), s0[r + 1]); mxb = fmaxf(fmaxf(mxb, s0[r + 2]), s0[r + 3]); mxa = fmaxf(fmaxf(mxa, s1[r]), s1[r + 1]); mxb = fmaxf(fmaxf(mxb, s1[r + 2]), s1[r + 3]); }
            float mx = fmaxf(mxa, mxb);
            mx = fmaxf(mx, __shfl_xor(mx, 32));
            if (__any(mx > THR ? 1 : 0)) {
                const float dl = (mx > THR) ? mx : 0.f;
                mref += dl;
#pragma unroll
                for (int r = 0; r < 16; ++r) { s0[r] -= dl; s1[r] -= dl; negm[r] = -mref; }
                const float alpha = __builtin_amdgcn_exp2f(-dl);
                lrun *= alpha;
#pragma unroll
                for (int d0 = 0; d0 < ND; ++d0)
#pragma unroll
                    for (int r = 0; r < 16; ++r) o[d0][r] *= alpha;
            }
            float psa = 0.f, psb = 0.f;
#pragma unroll
            for (int r = 0; r < 16; ++r) { s0[r] = __builtin_amdgcn_exp2f(s0[r]); s1[r] = __builtin_amdgcn_exp2f(s1[r]); psa += s0[r]; psb += s1[r]; }
            lrun += psa + psb;
            bf16x8 pb[4];
            { u32x4 w;
              w.x = cvt_pk_bf16(s0[0], s0[1]); w.y = cvt_pk_bf16(s0[2], s0[3]); w.z = cvt_pk_bf16(s0[4], s0[5]); w.w = cvt_pk_bf16(s0[6], s0[7]); pb[0] = __builtin_bit_cast(bf16x8, w);
              w.x = cvt_pk_bf16(s0[8], s0[9]); w.y = cvt_pk_bf16(s0[10], s0[11]); w.z = cvt_pk_bf16(s0[12], s0[13]); w.w = cvt_pk_bf16(s0[14], s0[15]); pb[1] = __builtin_bit_cast(bf16x8, w);
              w.x = cvt_pk_bf16(s1[0], s1[1]); w.y = cvt_pk_bf16(s1[2], s1[3]); w.z = cvt_pk_bf16(s1[4], s1[5]); w.w = cvt_pk_bf16(s1[6], s1[7]); pb[2] = __builtin_bit_cast(bf16x8, w);
              w.x = cvt_pk_bf16(s1[8], s1[9]); w.y = cvt_pk_bf16(s1[10], s1[11]); w.z = cvt_pk_bf16(s1[12], s1[13]); w.w = cvt_pk_bf16(s1[14], s1[15]); pb[3] = __builtin_bit_cast(bf16x8, w); }
            const LAS unsigned char* vb = lds + 2 * KBUF + buf * VBUF + vlane;
#pragma unroll
            for (int d0 = 0; d0 < ND; ++d0)
#pragma unroll
                for (int kk = 0; kk < 4; ++kk) {
                    const v4i16_t a = vtr(vb + d0 * 4096 + kk * 1024), b = vtr(vb + d0 * 4096 + kk * 1024 + 512);
                    const bf16x8 vf = {a[0], a[1], a[2], a[3], b[0], b[1], b[2], b[3]};
                    o[d0] = __builtin_amdgcn_mfma_f32_32x32x16_bf16(vf, pb[kk], o[d0], 0, 0, 0);
                }
        }
        if (t + 1 < NT) ATT_STORE(buf ^ 1);
        __syncthreads();
    }
#undef ATT_LOAD
#undef ATT_STORE
    lrun += __shfl_xor(lrun, 32);
    const float inv = 1.0f / lrun;
    bf16_t* orow = Og + (size_t)(wid * 32 + r32) * ldo + 4 * hi;
#pragma unroll
    for (int d0 = 0; d0 < ND; ++d0)
#pragma unroll
        for (int rg = 0; rg < 4; ++rg) {
            u32x2 w; w.x = cvt_pk_bf16(o[d0][4 * rg] * inv, o[d0][4 * rg + 1] * inv); w.y = cvt_pk_bf16(o[d0][4 * rg + 2] * inv, o[d0][4 * rg + 3] * inv);
            *(u32x2*)(orow + 32 * d0 + 8 * rg) = w;
        }
}

__device__ __forceinline__ float wave_sum(float v) {
#pragma unroll
    for (int o = 1; o < 64; o <<= 1) v += __shfl_xor(v, o);
    return v;
}
template <class MapFn>
__device__ __forceinline__ void transpose_item(const float* W, int K, int N, bf16_t* WT, const float* gain, LAS float* scr, int item, int lane, MapFn map) {
    const int nblk = N / 32, kb = item / nblk, nb = item % nblk, k0 = 64 * kb, n0 = 32 * nb;
#pragma unroll 8
    for (int i = 0; i < 32; ++i) { const int kk = 2 * i + (lane >> 5); float w = W[(size_t)(k0 + kk) * N + n0 + (lane & 31)]; if (gain) w *= gain[k0 + kk]; scr[kk * 33 + (lane & 31)] = w; }
    asm volatile("s_waitcnt lgkmcnt(0)" ::: "memory");
    const int c = lane & 7;
#pragma unroll
    for (int j = 0; j < 4; ++j) { const int n = (lane >> 3) + 8 * j; const LAS float* s = scr + (8 * c) * 33 + n;
        u32x4 o; o.x = cvt_pk_bf16(s[0 * 33], s[1 * 33]); o.y = cvt_pk_bf16(s[2 * 33], s[3 * 33]); o.z = cvt_pk_bf16(s[4 * 33], s[5 * 33]); o.w = cvt_pk_bf16(s[6 * 33], s[7 * 33]);
        *(u32x4*)(WT + (size_t)map(n0 + n) * K + k0 + 8 * c) = o; }
    asm volatile("s_waitcnt lgkmcnt(0)" ::: "memory");
}
__device__ __forceinline__ int map_in(int n) {
    if (n < 1024) { const int base = n & 512, mm = n & 511, head = mm >> 6, e = mm & 63; return base + 256 * (head >> 2) + 128 * (e >> 5) + 32 * (head & 3) + (e & 31); }
    if (n < 1920) return n;
    if (n < 2176) return 2048 + (n - 1920);
    if (n < 2208) return 1920 + (n - 2176);
    return 2304 + (n - 2208);
}
__device__ __forceinline__ int map_uq(int n) { const int head = n / 96, e = n % 96; if (e < 64) return 64 * head + e; const int r = e - 64; return 512 + 128 * (r >> 4) + 16 * head + (r & 15); }
__device__ __forceinline__ int map_gu(int n) { if (n < DFF) return 256 * (n >> 7) + (n & 127); const int a = n - DFF; return 256 * (a >> 7) + 128 + (a & 127); }
__device__ __forceinline__ int map_id(int n) { return n; }

#define XB_TMO      128
#define XB_XCNT(j)  (256  + 64 * (j))
#define XB_XSUB(j)  (1280 + 64 * (j))
#define XB_XGEN(j)  (2304 + 64 * (j))
#define XB_TOP      3328
#define XB_TOPGEN   3392
#define XCD_BAR_WORDS 3456
#define XB_SPIN_CAP (1u << 18)
__device__ __forceinline__ unsigned xb_ld(unsigned* p)              { return __hip_atomic_load(p, __ATOMIC_RELAXED, __HIP_MEMORY_SCOPE_AGENT); }
__device__ __forceinline__ unsigned xb_add(unsigned* p, unsigned v) { return __hip_atomic_fetch_add(p, v, __ATOMIC_RELAXED, __HIP_MEMORY_SCOPE_AGENT); }
__device__ __forceinline__ unsigned xb_xcc_id() { return (unsigned)__builtin_amdgcn_s_getreg((3 << 11) | 20) & 0xFu; }
#define XB_SPIN(cond, bar) do { unsigned _sp = 0; while (cond) { __builtin_amdgcn_s_sleep(1); \
    if ((++_sp & 255u) == 0u) { if (xb_ld(&(bar)[XB_TMO])) break; if (_sp > XB_SPIN_CAP) { atomicAdd(&(bar)[XB_TMO], 1u); break; } } } } while (0)
struct XcdBarrier { unsigned* bar; unsigned x; volatile LAS unsigned* st; };
__device__ __forceinline__ XcdBarrier xcd_barrier_post(unsigned* bar, volatile LAS unsigned* st) {
    XcdBarrier b; b.bar = bar; b.x = xb_xcc_id(); b.st = st;
    if (threadIdx.x == 0) (void)xb_add(&bar[XB_XCNT(b.x)], 1u);
    return b;
}
__device__ __forceinline__ void xcd_barrier_complete(unsigned* bar, unsigned x, unsigned& nloc, unsigned& nx) {
    const unsigned G = gridDim.x * gridDim.y * gridDim.z;
    unsigned sum, cnt, mine, sp = 0u;
    for (;;) {
        sum = 0u; cnt = 0u; mine = 0u;
#pragma unroll
        for (unsigned j = 0; j < 16; ++j) { const unsigned c = xb_ld(&bar[XB_XCNT(j)]); sum += c; cnt += (c > 0u) ? 1u : 0u; mine = (j == x) ? c : mine; }
        if (sum == G) break;
        __builtin_amdgcn_s_sleep(1);
        if ((++sp & 255u) == 0u) { if (xb_ld(&bar[XB_TMO])) break; if (sp > XB_SPIN_CAP) { atomicAdd(&bar[XB_TMO], 1u); break; } }
    }
    nloc = mine > 0u ? mine : 1u; nx = cnt > 0u ? cnt : 1u;
}
__device__ __forceinline__ void xcd_barrier(const XcdBarrier& b) {
    asm volatile("s_waitcnt vmcnt(0)" ::: "memory");
    __syncthreads();
    if (threadIdx.x == 0) {
        unsigned* bar = b.bar;
        __builtin_amdgcn_s_waitcnt(0);
        unsigned nloc = b.st[0], nx = b.st[1];
        if (nloc == 0u) { xcd_barrier_complete(bar, b.x, nloc, nx); b.st[0] = nloc; b.st[1] = nx; }
        const unsigned old = xb_add(&bar[XB_XSUB(b.x)], 1u);
        const unsigned gen = old / nloc;
        if (old + 1u == (gen + 1u) * nloc) {
            __builtin_amdgcn_fence(__ATOMIC_RELEASE, "agent");
            asm volatile("s_waitcnt vmcnt(0)" ::: "memory");
            const unsigned og = xb_add(&bar[XB_TOP], 1u);
            const unsigned tg = og / nx;
            if (og + 1u == (tg + 1u) * nx) xb_add(&bar[XB_TOPGEN], 1u);
            else XB_SPIN(xb_ld(&bar[XB_TOPGEN]) == tg, bar);
            __builtin_amdgcn_fence(__ATOMIC_ACQUIRE, "agent");
            xb_add(&bar[XB_XGEN(b.x)], 1u);
            asm volatile("s_waitcnt vmcnt(0)" ::: "memory");
        } else {
            XB_SPIN(xb_ld(&bar[XB_XGEN(b.x)]) == gen, bar);
            __builtin_amdgcn_fence(__ATOMIC_ACQUIRE, "agent");
            asm volatile("s_waitcnt vmcnt(0)" ::: "memory");
        }
    }
    __syncthreads();
}

struct Args {
    const float* x; const float* mem; const int* pos;
    const float* norm_mix; const float* w_in; const float* q_lat_norm; const float* w_uq; const float* kv_lat_norm; const float* w_ukv;
    const float* w_ba; const float* w_bb; const float* w_out; const float* norm_x; const float* norm_mem; const float* w_xq; const float* w_xkv; const float* w_xo;
    const float* norm_ffn; const float* w_gu; const float* w_dn; const float* norm_final;
    float* out; unsigned char* ws; int ph_lo, ph_hi;
};

constexpr int PH_PER_LAYER = 11, N_PHASES = DEPTH * PH_PER_LAYER + 1;
constexpr int LDS_TOTAL = pg8::STAGE_BYTES;

__global__ void __launch_bounds__(512, 2) fwd_kernel(Args a_in) {
    __shared__ __attribute__((aligned(16))) unsigned char lds_raw[LDS_TOTAL];
    LAS unsigned char* lds = (LAS unsigned char*)lds_raw;
    const int ph_lo = a_in.ph_lo, ph_hi = a_in.ph_hi;
    __shared__ __attribute__((aligned(16))) unsigned bar_st[4];
    if (threadIdx.x < 4) bar_st[threadIdx.x] = 0u;
    __syncthreads();
    XcdBarrier bar; bar.bar = (unsigned*)(a_in.ws + WS_CTL); bar.x = 0; bar.st = (volatile LAS unsigned*)bar_st;
    if (ph_hi - ph_lo > 1) bar = xcd_barrier_post((unsigned*)(a_in.ws + WS_CTL), (volatile LAS unsigned*)bar_st);
    for (int ph = ph_lo; ph < ph_hi; ++ph) {
        if (ph > ph_lo) { if (ph == ph_lo + 1) cg::this_grid().sync(); else xcd_barrier(bar); if (XSYNC) { xcd_barrier(bar); xcd_barrier(bar); } }
        int tid = threadIdx.x; asm volatile("" : "+v"(tid));
        int G = gridDim.x, bx = blockIdx.x; asm volatile("" : "+s"(G), "+s"(bx));
        const int lane = tid & 63, wave = __builtin_amdgcn_readfirstlane(tid >> 6);
        const int vcu = (G % 8 == 0) ? (bx % 8) * (G / 8) + bx / 8 : bx;
        const int gw = vcu * 8 + wave, NGW = G * 8;
        const __attribute__((address_space(4))) Args* ap = (const __attribute__((address_space(4))) Args*)__builtin_amdgcn_kernarg_segment_ptr(); asm volatile("" : "+s"(ap));
        const __attribute__((address_space(4))) Args& a = *ap;
        unsigned char* ws = a.ws; float* aout = a.out; const float* ax = a.x;
        asm volatile("" : "+s"(ws), "+s"(aout), "+s"(ax));
        bf16_t* Win_t = (bf16_t*)(ws + WS_WIN); bf16_t* Wuq_t = (bf16_t*)(ws + WS_WUQ); bf16_t* Wukv_t = (bf16_t*)(ws + WS_WUKV);
        bf16_t* Wba_t = (bf16_t*)(ws + WS_WBA); bf16_t* Wbb_t = (bf16_t*)(ws + WS_WBB); bf16_t* Wout_t = (bf16_t*)(ws + WS_WOUT);
        bf16_t* Wxq_t = (bf16_t*)(ws + WS_WXQ); bf16_t* Wxkv_t = (bf16_t*)(ws + WS_WXKV); bf16_t* Wxo_t = (bf16_t*)(ws + WS_WXO);
        bf16_t* Wgu_t = (bf16_t*)(ws + WS_WGU); bf16_t* Wdn_t = (bf16_t*)(ws + WS_WDN);
        bf16_t* XB = (bf16_t*)(ws + WS_XB); bf16_t* QB = (bf16_t*)(ws + WS_XB);
        bf16_t* QKVA = (bf16_t*)(ws + WS_QKVA); bf16_t* QX = (bf16_t*)(ws + WS_QKVA);
        bf16_t* LAT = (bf16_t*)(ws + WS_LAT); bf16_t* OB = (bf16_t*)(ws + WS_LAT);
        bf16_t* KVLAT = (bf16_t*)(ws + WS_KVLAT); bf16_t* GATES = (bf16_t*)(ws + WS_GATES); bf16_t* ACT = (bf16_t*)(ws + WS_ACT);
        bf16_t* KVB = (bf16_t*)(ws + WS_KVB); bf16_t* KVX = (bf16_t*)(ws + WS_KVX); bf16_t* MEMB = (bf16_t*)(ws + WS_MEMB); bf16_t* KPE = (bf16_t*)(ws + WS_KPE);
        float* COSA = (float*)(ws + WS_COSA); float* SINA = (float*)(ws + WS_SINA); float* COSB = (float*)(ws + WS_COSB); float* SINB = (float*)(ws + WS_SINB);
        float* SSQ = (float*)(ws + WS_SSQ); float* LSSQ = (float*)(ws + WS_LSSQ); float* RSTDM = (float*)(ws + WS_RSTDM); float* KBAR = (float*)(ws + WS_KBAR);

        if (ph == N_PHASES - 1) {
            if (!PHON(11)) continue;
            for (int row = gw; row < M; row += NGW) {
                const f32x4* sp = (const f32x4*)(SSQ + (size_t)row * 16);
                const f32x4 p0 = sp[0], p1 = sp[1], p2 = sp[2], p3 = sp[3];
                const float s = ((p0.x + p0.y) + (p0.z + p0.w)) + ((p1.x + p1.y) + (p1.z + p1.w)) + ((p2.x + p2.y) + (p2.z + p2.w)) + ((p3.x + p3.y) + (p3.z + p3.w));
                const float rs = rsqrtf(s * (1.0f / 1024.0f) + EPS);
                f32x4* xr = (f32x4*)(aout + (size_t)row * DM) + lane; const f32x4* gr = (const f32x4*)a.norm_final + lane;
#pragma unroll
                for (int j = 0; j < 4; ++j) { const f32x4 v = xr[64 * j], g = gr[64 * j]; xr[64 * j] = v * rs * g; }
            }
            continue;
        }
        const int l = ph / PH_PER_LAYER, p = ph % PH_PER_LAYER;
        const float* xin = (l == 0 && p == 5) ? ax : aout;
        if (!PHON(p)) continue;
        if (p == 0) {
            LAS float* scr = (LAS float*)(lds + wave * 16384);
            constexpr int I_IN = 16 * (IN_W / 32), I_UQ = 6 * 24, I_UKV = 4 * 32, I_BA = 8 * 32, I_OUT = 16 * 32, I_XQ = 16 * 16, I_XKV = 16 * 32, I_XO = 8 * 32, I_GU = 16 * (2 * DFF / 32), I_DN = (DFF / 64) * 32;
            constexpr int NIT = I_IN + I_UQ + I_UKV + 2 * I_BA + I_OUT + I_XQ + I_XKV + I_XO + I_GU + I_DN;
            for (int rep = 0; rep < 1 + DUP(0); ++rep)
            for (int it = gw; it < NIT; it += NGW) {
                int r = it;
                if (r < I_IN) { transpose_item(a.w_in + (size_t)l * DM * IN_W, DM, IN_W, Win_t, a.norm_mix + l * DM, scr, r, lane, map_in); continue; } r -= I_IN;
                if (r < I_UQ) { transpose_item(a.w_uq + (size_t)l * 384 * 768, 384, 768, Wuq_t, a.q_lat_norm + l * 384, scr, r, lane, map_uq); continue; } r -= I_UQ;
                if (r < I_UKV) { transpose_item(a.w_ukv + (size_t)l * 256 * 1024, 256, 1024, Wukv_t, a.kv_lat_norm + l * 256, scr, r, lane, map_id); continue; } r -= I_UKV;
                if (r < I_BA) { transpose_item(a.w_ba + (size_t)l * 512 * 1024, 512, 1024, Wba_t, nullptr, scr, r, lane, map_id); continue; } r -= I_BA;
                if (r < I_BA) { transpose_item(a.w_bb + (size_t)l * 512 * 1024, 512, 1024, Wbb_t, nullptr, scr, r, lane, map_id); continue; } r -= I_BA;
                if (r < I_OUT) { transpose_item(a.w_out + (size_t)l * 1024 * 1024, 1024, 1024, Wout_t, nullptr, scr, r, lane, map_id); continue; } r -= I_OUT;
                if (r < I_XQ) { transpose_item(a.w_xq + (size_t)l * 1024 * 512, 1024, 512, Wxq_t, a.norm_x + l * DM, scr, r, lane, map_id); continue; } r -= I_XQ;
                if (r < I_XKV) { transpose_item(a.w_xkv + (size_t)l * 1024 * 1024, 1024, 1024, Wxkv_t, a.norm_mem + l * DM, scr, r, lane, map_id); continue; } r -= I_XKV;
                if (r < I_XO) { transpose_item(a.w_xo + (size_t)l * 512 * 1024, 512, 1024, Wxo_t, nullptr, scr, r, lane, map_id); continue; } r -= I_XO;
                if (r < I_GU) { transpose_item(a.w_gu + (size_t)l * 1024 * 2 * DFF, 1024, 2 * DFF, Wgu_t, a.norm_ffn + l * DM, scr, r, lane, map_gu); continue; } r -= I_GU;
                transpose_item(a.w_dn + (size_t)l * DFF * 1024, DFF, 1024, Wdn_t, nullptr, scr, r, lane, map_id);
            }
            for (int i = vcu * 512 + tid; i < 96 * 1024 / 8; i += G * 512) *(u32x4*)(Win_t + (size_t)1952 * 1024 + (size_t)i * 8) = (u32x4){0u, 0u, 0u, 0u};
            if (l == 0) {
                for (int row = gw; row < M + MM; row += NGW) {
                    const bool ism = row >= M; const int r = ism ? row - M : row;
                    const f32x4* xr = (const f32x4*)((ism ? a.mem : ax) + (size_t)r * DM) + lane;
                    f32x4 v[4]; float s = 0.f;
#pragma unroll
                    for (int j = 0; j < 4; ++j) { v[j] = xr[64 * j]; s += sq4(v[j]); }
                    s = wave_sum(s);
                    u32x2* o8 = (u32x2*)((ism ? MEMB : XB) + (size_t)r * DM) + lane;
#pragma unroll
                    for (int j = 0; j < 4; ++j) { u32x2 w; w.x = cvt_pk_bf16(v[j].x, v[j].y); w.y = cvt_pk_bf16(v[j].z, v[j].w); o8[64 * j] = w; }
                    if (ism) { if (lane == 0) RSTDM[r] = rsqrtf(s * (1.0f / 1024.0f) + EPS); }
                    else if (lane < 16) SSQ[(size_t)r * 16 + lane] = (lane == 0) ? s : 0.f;
                }
                for (int i = vcu * 512 + tid; i < M * 32; i += G * 512) {
                    const int row = i >> 5, k = i & 31; const float posf = (float)a.pos[row];
                    const float inv = expf(-9.210340371976184f * (2.0f / 64.0f) * (float)k);
                    float sn, cs; sincosf(posf * inv, &sn, &cs); COSA[i] = cs; SINA[i] = sn;
                    if (k < 16) { const float invb = expf(-9.210340371976184f * (2.0f / 32.0f) * (float)k); float sb, cb; sincosf(posf * invb, &sb, &cb); COSB[row * 16 + k] = cb; SINB[row * 16 + k] = sb; }
                }
            }
            __syncthreads();
        } else if (p == 1) {
            pg8::Gemm g{XB, Win_t, M, IN_WP, DM, DM}; pg8::StaticOrder S; S.init(M, IN_WP, G, bx);
            EpiIn E{SSQ, QKVA, LAT, KVLAT, GATES, LSSQ, COSA, SINA};
            for (int rep = 0; rep < 1 + DUP(1); ++rep) { int tl = tid; asm volatile("" : "+v"(tl)); pg8::gemm_phase(lds, tl, g, S, E); }
        } else if (p == 2) {
            if (P2ON(0)) { LAS float* red = (LAS float*)lds;
              for (int it = vcu; it < 128 * 8; it += G) {
                  const int bh = it >> 3, j = it & 7, b = bh >> 3, h = bh & 7;
                  const bf16_t* kp = QKVA + (size_t)(b * SEQ + j * 256 + wave * 32) * 1536 + 512 + h * 64 + lane;
                  float s = 0.f;
#pragma unroll 8
                  for (int r = 0; r < 32; ++r) s += bf2f(kp[(size_t)r * 1536]);
                  red[wave * 64 + lane] = s;
                  __syncthreads();
                  if (wave == 0) { float t = 0.f;
#pragma unroll
                      for (int w = 0; w < 8; ++w) t += red[w * 64 + lane];
                      KBAR[(size_t)it * 64 + lane] = t * (1.0f / 256.0f); }
                  __syncthreads();
              }
              for (int i = vcu * 512 + tid; i < M * 16; i += G * 512) {
                  const int row = i >> 4, k = i & 15;
                  const float x1 = bf2f(LAT[(size_t)row * 512 + 384 + k]), x2 = bf2f(LAT[(size_t)row * 512 + 400 + k]);
                  const float c = COSB[i], s = SINB[i];
                  KPE[(size_t)row * 32 + k] = f2bf1(x1 * c - x2 * s); KPE[(size_t)row * 32 + 16 + k] = f2bf1(x2 * c + x1 * s);
              }
              __syncthreads(); }
            if (P2ON(1)) { unsigned char* w = ws; int tl = tid; asm volatile("" : "+s"(w), "+v"(tl));
              pg8::Gemm g{(bf16_t*)(w + WS_LAT), (bf16_t*)(w + WS_WUQ), M, 768, 384, 512}; pg8::StaticOrder S; S.init(M, 768, G, bx);
              EpiUq E{(float*)(w + WS_LSSQ), (bf16_t*)(w + WS_XB), (float*)(w + WS_COSB), (float*)(w + WS_SINB)}; pg8::gemm_phase(lds, tl, g, S, E); }
            if (P2ON(2)) { unsigned char* w = ws; int tl = tid; asm volatile("" : "+s"(w), "+v"(tl));
              pg8::Gemm g{(bf16_t*)(w + WS_KVLAT), (bf16_t*)(w + WS_WUKV), M, 1024, 256, 256}; pg8::StaticOrder S; S.init(M, 1024, G, G - 1 - bx);
              EpiRowScale<0> E{(float*)(w + WS_LSSQ), (bf16_t*)(w + WS_KVB), 1024, 1.f}; pg8::gemm_phase(lds, tl, g, S, E); }
            if (P2ON(3)) { unsigned char* w = ws; int tl = tid; asm volatile("" : "+s"(w), "+v"(tl));
              pg8::Gemm g{(bf16_t*)(w + WS_MEMB), (bf16_t*)(w + WS_WXKV), MM, 1024, 1024, 1024}; pg8::StaticOrder S; S.init(MM, 1024, G, (bx + 128) % G);
              EpiRowScale<1> E{(float*)(w + WS_RSTDM), (bf16_t*)(w + WS_KVX), 1024, 1.f}; pg8::gemm_phase(lds, tl, g, S, E); }
        } else if (p == 3) {
            for (int v = vcu; v < 256; v += G) {
                const int bh = v >> 1, b = bh >> 3, h = bh & 7;
                for (int rep = DUP(3) ? 0 : 1; rep < 2; ++rep)
#pragma unroll 1
                for (int i = 0; i < 4; ++i) {
                    const int cur = (v & 1) ? ((i == 0) ? 2 : (i == 1) ? 5 : (i == 2) ? 3 : 4) : ((i == 0) ? 0 : (i == 1) ? 7 : (i == 2) ? 1 : 6);
                    const size_t rowb = (size_t)b * SEQ, rowq = rowb + cur * 256;
                    attn_unit<64, 64, 0>(lds, tid, QKVA + rowq * 1536 + h * 64, 1536, QKVA + rowb * 1536 + 512 + h * 64, 1536, nullptr,
                                         QKVA + rowb * 1536 + 1024 + h * 64, 1536, rep ? QKVA + rowq * 1536 + h * 64 : (bf16_t*)(ws + 473 * MiB) + rowq * 512 + h * 64, rep ? 1536 : 512, cur * 256, 4 * (cur + 1), KBAR + (size_t)bh * 512, cur);
                }
                for (int rep = 0; rep < 1 + DUP(4); ++rep)
#pragma unroll 1
                for (int i = 0; i < 4; ++i) {
                    const int cur = (v & 1) ? ((i == 0) ? 2 : (i == 1) ? 5 : (i == 2) ? 3 : 4) : ((i == 0) ? 0 : (i == 1) ? 7 : (i == 2) ? 1 : 6);
                    const size_t rowb = (size_t)b * SEQ, rowq = rowb + cur * 256;
                    attn_unit<96, 64, 1>(lds, tid, QB + rowq * 768 + h * 96, 768, KVB + rowb * 1024 + h * 128, 1024, KPE + rowb * 32,
                                         KVB + rowb * 1024 + h * 128 + 64, 1024, OB + rowq * 512 + h * 64, 512, cur * 256, 4 * (cur + 1), nullptr, cur);
                }
            }
        } else if (p == 4) {
            { unsigned char* w = ws; int tl = tid; asm volatile("" : "+s"(w), "+v"(tl));
              pg8::Gemm g{(bf16_t*)(w + WS_QKVA), (bf16_t*)(w + WS_WBA), M, 1024, 512, 1536}; pg8::StaticOrder S; S.init(M, 1024, G, bx); EpiBranch<0> E{(bf16_t*)(w + WS_GATES)}; pg8::gemm_phase(lds, tl, g, S, E); }
            { unsigned char* w = ws; int tl = tid; asm volatile("" : "+s"(w), "+v"(tl));
              pg8::Gemm g{(bf16_t*)(w + WS_LAT), (bf16_t*)(w + WS_WBB), M, 1024, 512, 512}; pg8::StaticOrder S; S.init(M, 1024, G, bx); EpiBranch<1> E{(bf16_t*)(w + WS_GATES)}; pg8::gemm_phase(lds, tl, g, S, E); }
        } else if (p == 5) {
            pg8::Gemm g{GATES, Wout_t, M, 1024, 1024, 2048}; pg8::StaticOrder S; S.init(M, 1024, G, bx);
            EpiRes E{xin, aout, XB, SSQ}; pg8::gemm_phase(lds, tid, g, S, E);
        } else if (p == 6) {
            pg8::Gemm g{XB, Wxq_t, M, 512, 1024, 1024}; pg8::StaticOrder S; S.init(M, 512, G, bx);
            EpiRowScale<2> E{SSQ, QX, 512, C2X}; pg8::gemm_phase(lds, tid, g, S, E);
        } else if (p == 7) {
            for (int un = vcu * 2; un < 512; un += 2 * G)
                for (int rep = DUP(7) ? 0 : 1; rep < 2; ++rep)
#pragma unroll 1
                for (int i = 0; i < 2; ++i) {
                    const int unit = un + i, bh = unit >> 3, qb = unit & 7, b = bh >> 2, h = bh & 3;
                    const size_t rowq = (size_t)b * SEQ + qb * 256, rowm = (size_t)b * MEMLEN;
                    attn_unit<128, 128, 2>(lds, tid, QX + rowq * 512 + h * 128, 512, KVX + rowm * 1024 + h * 128, 1024, nullptr,
                                           KVX + rowm * 1024 + 512 + h * 128, 1024, (rep ? QX : (bf16_t*)(ws + 473 * MiB)) + rowq * 512 + h * 128, 512, 0, 4, nullptr, 0);
                }
        } else if (p == 8) {
            pg8::Gemm g{QX, Wxo_t, M, 1024, 512, 512}; pg8::StaticOrder S; S.init(M, 1024, G, bx);
            EpiRes E{aout, aout, XB, SSQ}; pg8::gemm_phase(lds, tid, g, S, E);
        } else if (p == 9) {
            pg8::Gemm g{XB, Wgu_t, M, 2 * DFF, 1024, 1024}; pg8::StaticOrder S; S.init(M, 2 * DFF, G, bx);
            EpiGU E{SSQ, ACT}; for (int rep = 0; rep < 1 + DUP(9); ++rep) { int tl = tid; asm volatile("" : "+v"(tl)); pg8::gemm_phase(lds, tl, g, S, E); }
            if (DUP(12)) { int tl = tid; asm volatile("" : "+v"(tl)); EpiNull EN; pg8::gemm_phase(lds, tl, g, S, EN); }
        } else {
            pg8::Gemm g{ACT, Wdn_t, M, 1024, DFF, DFF}; pg8::StaticOrder S; S.init(M, 1024, G, bx);
            EpiRes E{aout, aout, XB, SSQ}; pg8::gemm_phase(lds, tid, g, S, E);
        }
    }
}

extern "C" void kernel_launch(void* const* d_in, const int* in_sizes, int n_in, void* d_out, int out_size, void* d_ws, size_t ws_size, hipStream_t stream) {
    static int grid = 0;
    if (grid == 0) {
        if (n_in != 21 || in_sizes[0] != M * DM || out_size != M * DM || ws_size < WS_END) {
            fprintf(stderr, "kernel_launch: unexpected shapes (n_in %d, in0 %d, out %d, ws %zu); nothing launched\n", n_in, n_in > 0 ? in_sizes[0] : -1, out_size, ws_size); grid = -1; return; }
        int dev = 0, cus = 0, per_cu = 0;
        hipGetDevice(&dev); hipDeviceGetAttribute(&cus, hipDeviceAttributeMultiprocessorCount, dev);
        if (hipOccupancyMaxActiveBlocksPerMultiprocessor(&per_cu, (const void*)fwd_kernel, 512, 0) != hipSuccess || per_cu < 1) per_cu = 1;
        (void)hipGetLastError();
        grid = cus * 1;
        if (grid <= 0) grid = 256;
    }
    if (grid < 0) return;
    Args a{};
    a.x = (const float*)d_in[0]; a.mem = (const float*)d_in[1]; a.pos = (const int*)d_in[2];
    a.norm_mix = (const float*)d_in[3]; a.w_in = (const float*)d_in[4]; a.q_lat_norm = (const float*)d_in[5]; a.w_uq = (const float*)d_in[6];
    a.kv_lat_norm = (const float*)d_in[7]; a.w_ukv = (const float*)d_in[8]; a.w_ba = (const float*)d_in[9]; a.w_bb = (const float*)d_in[10]; a.w_out = (const float*)d_in[11];
    a.norm_x = (const float*)d_in[12]; a.norm_mem = (const float*)d_in[13]; a.w_xq = (const float*)d_in[14]; a.w_xkv = (const float*)d_in[15]; a.w_xo = (const float*)d_in[16];
    a.norm_ffn = (const float*)d_in[17]; a.w_gu = (const float*)d_in[18]; a.w_dn = (const float*)d_in[19]; a.norm_final = (const float*)d_in[20];
    a.out = (float*)d_out; a.ws = (unsigned char*)d_ws;
#if ONE_LAUNCH
    if (hipMemsetAsync((char*)d_ws + WS_CTL, 0, 65536, stream) != hipSuccess) { fprintf(stderr, "kernel_launch: memset of the barrier words failed\n"); return; }
    a.ph_lo = 0; a.ph_hi = N_PHASES;
    void* args[] = {&a};
    hipError_t e = hipLaunchCooperativeKernel((const void*)fwd_kernel, dim3(grid), dim3(512), args, 0, stream);
    if (e != hipSuccess) fprintf(stderr, "cooperative launch failed: %s (grid %d)\n", hipGetErrorString(e), grid);
#else
    for (int ph = 0; ph < N_PHASES; ++ph) {
        a.ph_lo = ph; a.ph_hi = ph + 1;
        hipLaunchKernelGGL(fwd_kernel, dim3(grid), dim3(512), 0, stream, a);
    }
#endif
}
```

```cpp
#include <hip/hip_runtime.h>
#include <hip/hip_cooperative_groups.h>
#include <cstdio>
#include <cstdint>
namespace cg = cooperative_groups;

#ifndef ONE_LAUNCH
#define ONE_LAUNCH 1
#endif

#ifndef PHMASK
#define PHMASK 0xFFFF
#endif
#ifndef P2MASK
#define P2MASK 0xF
#endif
#define P2ON(k) (((P2MASK) >> (k)) & 1)
#ifndef DUPMASK
#define DUPMASK 0
#endif
#ifndef XSYNC
#define XSYNC 0
#endif
#define DUP(k) (((DUPMASK) >> (k)) & 1)
#ifndef STAG
#define STAG 0
#endif
#ifndef NDUP
#define NDUP 0
#endif
#define ND(k) (((NDUP) >> (k)) & 1)
#ifndef TPROBE
#define TPROBE -1
#endif
#define TAMP 4
#define PHON(k) (((PHMASK) >> (k)) & 1)
#define LAS __attribute__((address_space(3)))
#define GAS __attribute__((address_space(1)))
#define GAS_U32X2_PTR __attribute__((address_space(1))) u32x2*
typedef unsigned short bf16_t;
typedef short bf16x8 __attribute__((ext_vector_type(8)));
typedef float f32x4 __attribute__((ext_vector_type(4)));
typedef float f32x16 __attribute__((ext_vector_type(16)));
typedef unsigned u32x4 __attribute__((ext_vector_type(4)));
typedef unsigned u32x2 __attribute__((ext_vector_type(2)));

constexpr int NBATCH = 16, SEQ = 2048, DM = 1024, DEPTH = 4, MEMLEN = 256;
constexpr int M = NBATCH * SEQ;
constexpr int MM = NBATCH * MEMLEN;
constexpr int IN_W = 4256, IN_WP = 4352;
constexpr int DFF = 2816;
constexpr float EPS = 1e-6f;
constexpr float LOG2E = 1.4426950408889634f;
constexpr float C2A = 0.125f * LOG2E;
constexpr float C2B = 0.10206207261596575f * LOG2E;
constexpr float C2X = 0.08838834764831845f * LOG2E;

constexpr size_t MiB = 1u << 20;
constexpr size_t WS_WIN = 0 * MiB, WS_WUQ = 9 * MiB, WS_WUKV = 10 * MiB, WS_WBA = 11 * MiB, WS_WBB = 12 * MiB, WS_WOUT = 13 * MiB,
                 WS_WXQ = 15 * MiB, WS_WXKV = 16 * MiB, WS_WXO = 18 * MiB, WS_WGU = 19 * MiB, WS_WDN = 30 * MiB;
constexpr size_t WS_XB = 36 * MiB;
constexpr size_t WS_QKVA = 100 * MiB;
constexpr size_t WS_LAT = 196 * MiB;
constexpr size_t WS_KVLAT = 228 * MiB;
constexpr size_t WS_GATES = 244 * MiB;
constexpr size_t WS_ACT = 100 * MiB;
constexpr size_t WS_KVB = 372 * MiB;
constexpr size_t WS_KVX = 436 * MiB;
constexpr size_t WS_MEMB = 444 * MiB;
constexpr size_t WS_KPE = 452 * MiB;
constexpr size_t WS_COSA = 454 * MiB, WS_SINA = 458 * MiB;
constexpr size_t WS_COSB = 462 * MiB, WS_SINB = 464 * MiB;
constexpr size_t WS_SSQ = 466 * MiB;
constexpr size_t WS_LSSQ = 468 * MiB;
constexpr size_t WS_RSTDM = 470 * MiB;
constexpr size_t WS_KBAR = 470 * MiB + 65536;
constexpr size_t WS_XQ = 473 * MiB;
constexpr size_t WS_CTL = 471 * MiB;
constexpr size_t WS_END = 505 * MiB;

typedef float f32x2_t __attribute__((ext_vector_type(2))); typedef __bf16 bf16x2_t __attribute__((ext_vector_type(2)));
__device__ __forceinline__ unsigned cvt_pk_bf16(float lo, float hi) { f32x2_t v = {lo, hi}; bf16x2_t b = __builtin_convertvector(v, bf16x2_t); return __builtin_bit_cast(unsigned, b); }
__device__ __forceinline__ float bf2f(unsigned short b) { return __uint_as_float(((unsigned)b) << 16); }
__device__ __forceinline__ float bflo(unsigned w) { return __uint_as_float(w << 16); }
__device__ __forceinline__ float bfhi(unsigned w) { return __uint_as_float(w & 0xffff0000u); }
__device__ __forceinline__ unsigned short f2bf1(float f) { return (unsigned short)(cvt_pk_bf16(f, 0.f) & 0xffffu); }


__device__ __forceinline__ float xdeq(unsigned hbits, float hf, int q) { unsigned e = (hbits >> 7) & 0xffu; e = e < 16u ? 16u : e; return __builtin_fmaf((float)q, __uint_as_float((e - 15u) << 23), hf); }
__device__ __forceinline__ unsigned xquant(float x, unsigned hbits, float hf) { unsigned e = (hbits >> 7) & 0xffu; e = e < 16u ? 16u : e;
    float qf = __builtin_rintf((x - hf) * __uint_as_float((269u - e) << 23)); qf = fminf(fmaxf(qf, -127.f), 127.f); return ((unsigned)(int)qf) & 0xffu; }
__device__ __forceinline__ void xdeq8(const u32x4 h, const u32x2 q, f32x4& a, f32x4& b) {
    a.x = xdeq(h.x & 0xffffu, bflo(h.x), (int)(q.x << 24) >> 24); a.y = xdeq(h.x >> 16, bfhi(h.x), (int)(q.x << 16) >> 24);
    a.z = xdeq(h.y & 0xffffu, bflo(h.y), (int)(q.x << 8) >> 24);  a.w = xdeq(h.y >> 16, bfhi(h.y), (int)q.x >> 24);
    b.x = xdeq(h.z & 0xffffu, bflo(h.z), (int)(q.y << 24) >> 24); b.y = xdeq(h.z >> 16, bfhi(h.z), (int)(q.y << 16) >> 24);
    b.z = xdeq(h.w & 0xffffu, bflo(h.w), (int)(q.y << 8) >> 24);  b.w = xdeq(h.w >> 16, bfhi(h.w), (int)q.y >> 24);
}
__device__ __forceinline__ unsigned xquant4(const f32x4 v, unsigned w0, unsigned w1) {
    return xquant(v.x, w0 & 0xffffu, bflo(w0)) | (xquant(v.y, w0 >> 16, bfhi(w0)) << 8) | (xquant(v.z, w1 & 0xffffu, bflo(w1)) << 16) | (xquant(v.w, w1 >> 16, bfhi(w1)) << 24);
}

namespace pg8 {
constexpr int BM = 256, BK = 64, HALF = 128, HTB = HALF * BK * 2, STAGE_BYTES = 8 * HTB, NXCD = 8, WGM = 8;
__host__ __device__ __forceinline__ int lds_byte(int r, int c) { const int st = (r >> 4) * 2 + (c >> 5), rr = r & 15, cc = c & 31, ob = rr * 64 + cc * 2; return st * 1024 + (ob ^ (((ob >> 9) & 1) << 5)); }
__host__ __device__ __forceinline__ void stage_rc(int b, int& R, int& C) { const int st = b / 1024, sb = b % 1024, swz = sb ^ (((sb >> 9) & 1) << 5); R = (st >> 1) * 16 + swz / 64; C = (st & 1) * 32 + (swz % 64) / 2; }
__host__ __device__ __forceinline__ int perm32(int rho) { const int n = rho >> 4, i = rho & 15; return 8 * (i >> 2) + 4 * n + (i & 3); }

struct Unit { int pm, pn; };
struct Gemm { const bf16_t* A; const bf16_t* Bt; int M, N, K, lda; };

struct StaticOrder {
    int nM, nN, nwg, G, c;
    __device__ void init(int M_, int N_, int G_, int c_) { nM = M_ / BM; nN = N_ / BM; nwg = nM * nN; G = G_; c = c_; }
    __device__ bool next(int i, Unit& u) const {
        const long L = (long)i * G + c; if (L >= nwg) return false;
        int wgid = (int)L; { const int q = nwg / NXCD, r = nwg % NXCD, xcd = wgid % NXCD, off = wgid / NXCD; wgid = (xcd < r ? xcd * (q + 1) : r * (q + 1) + (xcd - r) * q) + off; }
        const int nig = WGM * nN, gid = wgid / nig, fm = gid * WGM, gsz = (nM - fm) < WGM ? (nM - fm) : WGM;
        u.pm = fm + ((wgid % nig) % gsz); u.pn = (wgid % nig) / gsz; return true;
    }
};

template <class Epi>
__device__ __forceinline__ void gemm_phase(LAS unsigned char* lds, const int tid, const Gemm g, const StaticOrder& S, const Epi& E) {
    const int wid = __builtin_amdgcn_readfirstlane(tid >> 6), lane = tid & 63, wr = wid >> 2, wc = wid & 3, fr = lane & 15, fq = lane >> 4;
    const int K = g.K, nt = K / BK;
    unsigned voffA[2], voffB[2];
#pragma unroll
    for (int i = 0; i < 2; ++i) { int R, C; stage_rc(tid * 16 + i * 8192, R, C); const int Rb = Epi::PERM ? ((R & ~31) + perm32(R & 31)) : R;
        voffA[i] = (unsigned)(R * g.lda + C) * 2u; voffB[i] = (unsigned)(Rb * K + C) * 2u; }
    const size_t kstep = (size_t)(BK * 2);
    const size_t hstepA = (size_t)HALF * g.lda * 2, hstepB = (size_t)HALF * K * 2;
    const size_t tstepA = 2 * hstepA, tstepB = 2 * hstepB;
    const unsigned ldsw = (unsigned)wid * 1024u;
    const int aoff = lds_byte(wr * 64 + fr, fq * 8), boff = lds_byte(wc * 32 + fr, fq * 8);
#define PG8_SA(b, h) (((b) * 2 + (h)) * HTB)
#define PG8_SB(b, h) ((4 + (b) * 2 + (h)) * HTB)
#define PG8_STAGE(bufoff, gbase, voff) do { _Pragma("unroll") for (int _i = 0; _i < 2; ++_i) \
        __builtin_amdgcn_global_load_lds((const unsigned*)((const char*)(gbase) + (voff)[_i]), (LAS unsigned*)(lds + (bufoff) + ldsw + _i * 8192), 16, 0, 0); } while (0)
#define PG8_LDA(dst, b, h) do { _Pragma("unroll") for (int m = 0; m < 4; ++m) _Pragma("unroll") for (int k = 0; k < 2; ++k) dst[m][k] = *(const LAS bf16x8*)(lds + PG8_SA(b, h) + aoff + m * 2048 + k * 1024); } while (0)
#define PG8_LDB(dst, b, h) do { _Pragma("unroll") for (int n = 0; n < 2; ++n) _Pragma("unroll") for (int k = 0; k < 2; ++k) dst[n][k] = *(const LAS bf16x8*)(lds + PG8_SB(b, h) + boff + n * 2048 + k * 1024); } while (0)
#define PG8_MMA(ai, bj, At, Bt) do { __builtin_amdgcn_s_setprio(1); _Pragma("unroll") for (int m = 0; m < 4; ++m) _Pragma("unroll") for (int n = 0; n < 2; ++n) _Pragma("unroll") for (int k = 0; k < 2; ++k) \
        acc[ai][bj][m][n] = __builtin_amdgcn_mfma_f32_16x16x32_bf16(Bt[n][k], At[m][k], acc[ai][bj][m][n], 0, 0, 0); __builtin_amdgcn_s_setprio(0); } while (0)
#define PG8_WAIT_V(n) asm volatile("s_waitcnt vmcnt(" #n ")" ::: "memory")
#define PG8_WAIT_L(n) asm volatile("s_waitcnt lgkmcnt(" #n ")" ::: "memory")
#define PG8_BAR __builtin_amdgcn_s_barrier()
#define PG8_SCHED __builtin_amdgcn_sched_barrier(0)
    Unit cur, nxt; int ui = 0;
    if (!S.next(0, cur)) return;
    f32x4 acc[2][2][4][2];
    if constexpr (Epi::ACC_INIT) E.init(acc, cur, wr, wc, fr, fq);
    else {
#pragma unroll
    for (int a = 0; a < 2; ++a)
#pragma unroll
        for (int b = 0; b < 2; ++b)
#pragma unroll
            for (int m = 0; m < 4; ++m)
#pragma unroll
                for (int n = 0; n < 2; ++n) acc[a][b][m][n] = (f32x4){0.f, 0.f, 0.f, 0.f};
    }
    bf16x8 At[4][2], B0[2][2], B1[2][2];
    const char* cA = (const char*)g.A + (size_t)cur.pm * tstepA; const char* cB = (const char*)g.Bt + (size_t)cur.pn * tstepB;
    PG8_STAGE(PG8_SB(0, 0), cB, voffB); PG8_STAGE(PG8_SB(0, 1), cB + hstepB, voffB); PG8_STAGE(PG8_SA(0, 0), cA, voffA); PG8_STAGE(PG8_SA(0, 1), cA + hstepA, voffA);
    if (wr == 1) PG8_BAR;
    PG8_WAIT_V(2); PG8_BAR;
    PG8_STAGE(PG8_SB(1, 0), cB + kstep, voffB); PG8_STAGE(PG8_SA(1, 0), cA + kstep, voffA); PG8_STAGE(PG8_SB(1, 1), cB + hstepB + kstep, voffB);
    PG8_WAIT_V(6); PG8_BAR;
    for (;;) {
        const bool has_next = S.next(ui + 1, nxt);
        const char* nA = has_next ? (const char*)g.A + (size_t)nxt.pm * tstepA : cA; const char* nB = has_next ? (const char*)g.Bt + (size_t)nxt.pn * tstepB : cB;
#pragma unroll 1
        for (int t = 0; t < nt; t += 2) {
            const bool last = (t == nt - 2);
            const char* a1 = cA + (size_t)(t + 1) * kstep;
            const char* a2 = last ? nA : cA + (size_t)(t + 2) * kstep; const char* b2 = last ? nB : cB + (size_t)(t + 2) * kstep;
            const char* a3 = a2 + kstep; const char* b3 = b2 + kstep;
            PG8_LDB(B0, 0, 0); PG8_LDB(B1, 0, 1); PG8_SCHED; PG8_LDA(At, 0, 0); PG8_STAGE(PG8_SA(1, 1), a1 + hstepA, voffA);
            PG8_WAIT_V(8); PG8_WAIT_L(0); PG8_BAR; PG8_MMA(0, 0, At, B0); PG8_MMA(0, 1, At, B1); PG8_BAR; PG8_SCHED;
            PG8_LDA(At, 0, 1); PG8_STAGE(PG8_SB(0, 0), b2, voffB); PG8_STAGE(PG8_SB(0, 1), b2 + hstepB, voffB); PG8_STAGE(PG8_SA(0, 0), a2, voffA);
            PG8_WAIT_V(8); PG8_WAIT_L(0); PG8_BAR; PG8_MMA(1, 0, At, B0); PG8_MMA(1, 1, At, B1); PG8_BAR; PG8_SCHED;
            PG8_LDB(B0, 1, 0); PG8_LDB(B1, 1, 1); PG8_SCHED; PG8_LDA(At, 1, 0); PG8_STAGE(PG8_SA(0, 1), a2 + hstepA, voffA);
            PG8_WAIT_V(8); PG8_WAIT_L(0); PG8_BAR; PG8_MMA(0, 0, At, B0); PG8_MMA(0, 1, At, B1); PG8_BAR; PG8_SCHED;
            PG8_LDA(At, 1, 1); PG8_STAGE(PG8_SB(1, 0), b3, voffB); PG8_STAGE(PG8_SB(1, 1), b3 + hstepB, voffB); PG8_STAGE(PG8_SA(1, 0), a3, voffA);
            PG8_WAIT_V(8); PG8_WAIT_L(0); PG8_BAR; PG8_MMA(1, 0, At, B0); PG8_MMA(1, 1, At, B1); PG8_BAR; PG8_SCHED;
        }
        if (wr == 0) PG8_BAR;
        E(acc, cur, wr, wc, fr, fq);
        if (!has_next) break;
        if constexpr (Epi::ACC_INIT) E.init(acc, nxt, wr, wc, fr, fq);
        else {
#pragma unroll
        for (int a = 0; a < 2; ++a)
#pragma unroll
            for (int b = 0; b < 2; ++b)
#pragma unroll
                for (int m = 0; m < 4; ++m)
#pragma unroll
                    for (int n = 0; n < 2; ++n) acc[a][b][m][n] = (f32x4){0.f, 0.f, 0.f, 0.f};
        }
        cur = nxt; cA = nA; cB = nB; ++ui;
        if (wr == 1) PG8_BAR;
    }
    PG8_WAIT_V(0);
    PG8_BAR;
#undef PG8_SA
#undef PG8_SB
#undef PG8_STAGE
#undef PG8_LDA
#undef PG8_LDB
#undef PG8_MMA
#undef PG8_WAIT_V
#undef PG8_WAIT_L
#undef PG8_BAR
#undef PG8_SCHED
}
}

typedef f32x4 (&AccRef)[2][2][4][2];

__device__ __forceinline__ float quad_sum(float s) { s += __shfl_xor(s, 16); s += __shfl_xor(s, 32); return s; }
__device__ __forceinline__ float sq4(f32x4 v) { return (v.x * v.x + v.y * v.y) + (v.z * v.z + v.w * v.w); }
__device__ __forceinline__ float sum4(f32x4 v) { return (v.x + v.y) + (v.z + v.w); }
__device__ __forceinline__ u32x4 pack8(f32x4 a, f32x4 b) { u32x4 w; w.x = cvt_pk_bf16(a.x, a.y); w.y = cvt_pk_bf16(a.z, a.w); w.z = cvt_pk_bf16(b.x, b.y); w.w = cvt_pk_bf16(b.z, b.w); return w; }
__device__ __forceinline__ float sigmoidf_(float v) { return __builtin_amdgcn_rcpf(1.0f + __builtin_amdgcn_exp2f(v * (-LOG2E))); }
__device__ __forceinline__ f32x4 sig4(f32x4 v) { return (f32x4){sigmoidf_(v.x), sigmoidf_(v.y), sigmoidf_(v.z), sigmoidf_(v.w)}; }
#define ROWSTAT8(rs, base, inv_n, mul) do { f32x4 pv_[2][4]; \
    _Pragma("unroll") for (int ai = 0; ai < 2; ++ai) _Pragma("unroll") for (int m = 0; m < 4; ++m) pv_[ai][m] = *(const GAS f32x4*)((base) + (size_t)(u.pm * 256 + ai * 128 + wr * 64 + m * 16 + fr) * 16 + 4 * fq); \
    _Pragma("unroll") for (int ai = 0; ai < 2; ++ai) _Pragma("unroll") for (int m = 0; m < 4; ++m) rs[ai][m] = rsqrtf(quad_sum(sum4(pv_[ai][m])) * (inv_n) + EPS) * (mul); } while (0)

struct EpiIn {
    static constexpr bool PERM = true, ACC_INIT = false;
    const float* ssq; bf16_t* qkva; bf16_t* lat; bf16_t* kvlat; bf16_t* gates; float* lssq; const float* cosA; const float* sinA;
    __device__ __forceinline__ void operator()(AccRef acc, const pg8::Unit& u, int wr, int wc, int fr, int fq) const {
        const int pn = u.pn;
        float rs[2][4];
        ROWSTAT8(rs, ssq, 1.0f / 1024.0f, 1.0f);
        if (pn < 4) {
            const float sc = (pn < 2) ? C2A : 1.0f;
            f32x4 cs[2][4];
#define ROPE_LOAD(ai, m0) _Pragma("unroll") for (int mm = 0; mm < 2; ++mm) { const size_t ro = (size_t)(u.pm * 256 + (ai) * 128 + wr * 64 + ((m0) + mm) * 16 + fr) * 32 + 8 * fq; \
            cs[mm][0] = *(const GAS f32x4*)(cosA + ro); cs[mm][1] = *(const GAS f32x4*)(cosA + ro + 4); cs[mm][2] = *(const GAS f32x4*)(sinA + ro); cs[mm][3] = *(const GAS f32x4*)(sinA + ro + 4); }
#define ROPE_COMP(ai, m0) _Pragma("unroll") for (int mm = 0; mm < 2; ++mm) { const int m = (m0) + mm; const float r_ = rs[ai][m] * sc; \
            const f32x4 v00 = acc[ai][0][m][0] * r_, v01 = acc[ai][0][m][1] * r_, v10 = acc[ai][1][m][0] * r_, v11 = acc[ai][1][m][1] * r_; \
            acc[ai][0][m][0] = v00 * cs[mm][0] - v10 * cs[mm][2]; acc[ai][0][m][1] = v01 * cs[mm][1] - v11 * cs[mm][3]; acc[ai][1][m][0] = v10 * cs[mm][0] + v00 * cs[mm][2]; acc[ai][1][m][1] = v11 * cs[mm][1] + v01 * cs[mm][3]; }
#define ROPE_STORE(ai, m0) _Pragma("unroll") for (int mm = 0; mm < 2; ++mm) { const int m = (m0) + mm; const int row = u.pm * 256 + (ai) * 128 + wr * 64 + m * 16 + fr; \
            bf16_t* d = qkva + (size_t)row * 1536 + (pn >> 1) * 512 + ((pn & 1) * 4 + wc) * 64 + 8 * fq; \
            *(GAS u32x4*)d = pack8(acc[ai][0][m][0], acc[ai][0][m][1]); *(GAS u32x4*)(d + 32) = pack8(acc[ai][1][m][0], acc[ai][1][m][1]); }
            ROPE_LOAD(0, 0); ROPE_COMP(0, 0); ROPE_LOAD(0, 2); ROPE_STORE(0, 0); ROPE_COMP(0, 2); ROPE_LOAD(1, 0); ROPE_STORE(0, 2); ROPE_COMP(1, 0); ROPE_LOAD(1, 2); ROPE_STORE(1, 0); ROPE_COMP(1, 2); ROPE_STORE(1, 2);
#undef ROPE_LOAD
#undef ROPE_COMP
#undef ROPE_STORE
            return;
        }
#pragma unroll
        for (int ai = 0; ai < 2; ++ai)
#pragma unroll
            for (int m = 0; m < 4; ++m) {
                const int row = u.pm * 256 + ai * 128 + wr * 64 + m * 16 + fr;
                const float r_ = rs[ai][m];
                const f32x4 v00 = acc[ai][0][m][0] * r_, v01 = acc[ai][0][m][1] * r_, v10 = acc[ai][1][m][0] * r_, v11 = acc[ai][1][m][1] * r_;
                if (pn < 6) {
                    bf16_t* d = qkva + (size_t)row * 1536 + pn * 256 + wc * 32 + 8 * fq;
                    *(GAS u32x4*)d = pack8(v00, v01); *(GAS u32x4*)(d + 128) = pack8(v10, v11);
                } else if (pn < 8) {
                    bf16_t* d = lat + (size_t)row * 512 + (pn - 6) * 256 + wc * 32 + 8 * fq;
                    *(GAS u32x4*)d = pack8(v00, v01); *(GAS u32x4*)(d + 128) = pack8(v10, v11);
                    float s = sq4(v00) + sq4(v01); if (pn == 6) s += sq4(v10) + sq4(v11);
                    s = quad_sum(s);
                    if (fq == 0) ((GAS float*)lssq)[(size_t)row * 16 + (pn - 6) * 4 + wc] = s;
                } else if (pn == 8) {
                    bf16_t* d = kvlat + (size_t)row * 256 + wc * 32 + 8 * fq;
                    *(GAS u32x4*)d = pack8(v00, v01); *(GAS u32x4*)(d + 128) = pack8(v10, v11);
                    float s = quad_sum(sq4(v00) + sq4(v01) + sq4(v10) + sq4(v11));
                    if (fq == 0) ((GAS float*)lssq)[(size_t)row * 16 + 8 + wc] = s;
                } else {
                    bf16_t* d = gates + (size_t)row * 2048 + (pn - 9) * 256 + wc * 32 + 8 * fq;
                    *(GAS u32x4*)d = pack8(sig4(v00), sig4(v01)); *(GAS u32x4*)(d + 128) = pack8(sig4(v10), sig4(v11));
                }
            }
    }
};

struct EpiUq {
    static constexpr bool PERM = true, ACC_INIT = false;
    const float* lssq; bf16_t* qb; const float* cosB; const float* sinB;
    __device__ __forceinline__ void operator()(AccRef acc, const pg8::Unit& u, int wr, int wc, int fr, int fq) const {
        const int pn = u.pn;
        float rs[2][4];
        { f32x4 pv_[2][4];
#pragma unroll
          for (int ai = 0; ai < 2; ++ai)
#pragma unroll
              for (int m = 0; m < 4; ++m) pv_[ai][m] = *(const GAS f32x4*)(lssq + (size_t)(u.pm * 256 + ai * 128 + wr * 64 + m * 16 + fr) * 16 + 4 * (fq & 1));
#pragma unroll
          for (int ai = 0; ai < 2; ++ai)
#pragma unroll
              for (int m = 0; m < 4; ++m) rs[ai][m] = rsqrtf(quad_sum((fq < 2) ? sum4(pv_[ai][m]) : 0.f) * (1.0f / 384.0f) + EPS) * C2B; }
        if (pn == 2) {
            const int head = 2 * wc + (fq >> 1), i0 = 8 * (fq & 1);
            f32x4 cs[2][4];
#define ROPE_LOAD(ai, m0) _Pragma("unroll") for (int mm = 0; mm < 2; ++mm) { const size_t ro = (size_t)(u.pm * 256 + (ai) * 128 + wr * 64 + ((m0) + mm) * 16 + fr) * 16 + i0; \
            cs[mm][0] = *(const GAS f32x4*)(cosB + ro); cs[mm][1] = *(const GAS f32x4*)(cosB + ro + 4); cs[mm][2] = *(const GAS f32x4*)(sinB + ro); cs[mm][3] = *(const GAS f32x4*)(sinB + ro + 4); }
#define ROPE_COMP(ai, m0) _Pragma("unroll") for (int mm = 0; mm < 2; ++mm) { const int m = (m0) + mm; const float r_ = rs[ai][m]; \
            const f32x4 v00 = acc[ai][0][m][0] * r_, v01 = acc[ai][0][m][1] * r_, v10 = acc[ai][1][m][0] * r_, v11 = acc[ai][1][m][1] * r_; \
            acc[ai][0][m][0] = v00 * cs[mm][0] - v10 * cs[mm][2]; acc[ai][0][m][1] = v01 * cs[mm][1] - v11 * cs[mm][3]; acc[ai][1][m][0] = v10 * cs[mm][0] + v00 * cs[mm][2]; acc[ai][1][m][1] = v11 * cs[mm][1] + v01 * cs[mm][3]; }
#define ROPE_STORE(ai, m0) _Pragma("unroll") for (int mm = 0; mm < 2; ++mm) { const int m = (m0) + mm; const int row = u.pm * 256 + (ai) * 128 + wr * 64 + m * 16 + fr; \
            bf16_t* d = qb + (size_t)row * 768 + head * 96 + 64 + i0; \
            *(GAS u32x4*)d = pack8(acc[ai][0][m][0], acc[ai][0][m][1]); *(GAS u32x4*)(d + 16) = pack8(acc[ai][1][m][0], acc[ai][1][m][1]); }
            ROPE_LOAD(0, 0); ROPE_COMP(0, 0); ROPE_LOAD(0, 2); ROPE_STORE(0, 0); ROPE_COMP(0, 2); ROPE_LOAD(1, 0); ROPE_STORE(0, 2); ROPE_COMP(1, 0); ROPE_LOAD(1, 2); ROPE_STORE(1, 0); ROPE_COMP(1, 2); ROPE_STORE(1, 2);
#undef ROPE_LOAD
#undef ROPE_COMP
#undef ROPE_STORE
            return;
        }
#pragma unroll
        for (int ai = 0; ai < 2; ++ai)
#pragma unroll
            for (int m = 0; m < 4; ++m) {
                const int row = u.pm * 256 + ai * 128 + wr * 64 + m * 16 + fr;
                const float r_ = rs[ai][m];
                const int c0 = pn * 256 + wc * 32 + 8 * fq, c1 = c0 + 128;
                *(GAS u32x4*)(qb + (size_t)row * 768 + (c0 >> 6) * 96 + (c0 & 63)) = pack8(acc[ai][0][m][0] * r_, acc[ai][0][m][1] * r_);
                *(GAS u32x4*)(qb + (size_t)row * 768 + (c1 >> 6) * 96 + (c1 & 63)) = pack8(acc[ai][1][m][0] * r_, acc[ai][1][m][1] * r_);
            }
    }
};

template <int MODE> struct EpiRowScale {
    static constexpr bool PERM = true, ACC_INIT = false;
    const float* stat; bf16_t* O; int ldc; float cs;
    __device__ __forceinline__ void operator()(AccRef acc, const pg8::Unit& u, int wr, int wc, int fr, int fq) const {
        float rs[2][4];
        if (MODE == 0) { f32x4 pv_[2][4];
#pragma unroll
            for (int ai = 0; ai < 2; ++ai)
#pragma unroll
                for (int m = 0; m < 4; ++m) pv_[ai][m] = *(const GAS f32x4*)(stat + (size_t)(u.pm * 256 + ai * 128 + wr * 64 + m * 16 + fr) * 16 + 8);
#pragma unroll
            for (int ai = 0; ai < 2; ++ai)
#pragma unroll
                for (int m = 0; m < 4; ++m) rs[ai][m] = rsqrtf(sum4(pv_[ai][m]) * (1.0f / 256.0f) + EPS);
        } else if (MODE == 1) {
#pragma unroll
            for (int ai = 0; ai < 2; ++ai)
#pragma unroll
                for (int m = 0; m < 4; ++m) rs[ai][m] = ((const GAS float*)stat)[u.pm * 256 + ai * 128 + wr * 64 + m * 16 + fr];
        } else { ROWSTAT8(rs, stat, 1.0f / 1024.0f, cs); }
#pragma unroll
        for (int ai = 0; ai < 2; ++ai)
#pragma unroll
            for (int m = 0; m < 4; ++m) {
                const int row = u.pm * 256 + ai * 128 + wr * 64 + m * 16 + fr;
                const float r_ = rs[ai][m];
                bf16_t* d = O + (size_t)row * ldc + u.pn * 256 + wc * 32 + 8 * fq;
                *(GAS u32x4*)d = pack8(acc[ai][0][m][0] * r_, acc[ai][0][m][1] * r_);
                *(GAS u32x4*)(d + 128) = pack8(acc[ai][1][m][0] * r_, acc[ai][1][m][1] * r_);
            }
    }
};

template <int Z> struct EpiBranch {
    static constexpr bool PERM = true, ACC_INIT = false;
    bf16_t* gates;
    __device__ __forceinline__ void operator()(AccRef acc, const pg8::Unit& u, int wr, int wc, int fr, int fq) const {
        u32x4 gt[4][2], tt[4][2];
#define BR_LOAD(ai) _Pragma("unroll") for (int m = 0; m < 4; ++m) _Pragma("unroll") for (int bj = 0; bj < 2; ++bj) { \
            const bf16_t* d = gates + (size_t)(u.pm * 256 + (ai) * 128 + wr * 64 + m * 16 + fr) * 2048 + u.pn * 256 + bj * 128 + wc * 32 + 8 * fq; \
            if (Z == 0) gt[m][bj] = *(const GAS u32x4*)d; else { tt[m][bj] = *(const GAS u32x4*)d; gt[m][bj] = *(const GAS u32x4*)(d + 1024); } }
#define BR_COMP(ai) _Pragma("unroll") for (int m = 0; m < 4; ++m) _Pragma("unroll") for (int bj = 0; bj < 2; ++bj) { const u32x4 g = gt[m][bj]; const f32x4 a0 = acc[ai][bj][m][0], a1 = acc[ai][bj][m][1]; \
            f32x4 r0 = {bflo(g.x) * a0.x, bfhi(g.x) * a0.y, bflo(g.y) * a0.z, bfhi(g.y) * a0.w}, r1 = {bflo(g.z) * a1.x, bfhi(g.z) * a1.y, bflo(g.w) * a1.z, bfhi(g.w) * a1.w}; \
            if (Z == 1) { const u32x4 t = tt[m][bj]; r0 = r0 + (f32x4){bflo(t.x), bfhi(t.x), bflo(t.y), bfhi(t.y)}; r1 = r1 + (f32x4){bflo(t.z), bfhi(t.z), bflo(t.w), bfhi(t.w)}; } \
            acc[ai][bj][m][0] = r0; acc[ai][bj][m][1] = r1; }
#define BR_STORE(ai) _Pragma("unroll") for (int m = 0; m < 4; ++m) _Pragma("unroll") for (int bj = 0; bj < 2; ++bj) { \
            bf16_t* d = gates + (size_t)(u.pm * 256 + (ai) * 128 + wr * 64 + m * 16 + fr) * 2048 + u.pn * 256 + bj * 128 + wc * 32 + 8 * fq; \
            *(GAS u32x4*)d = pack8(acc[ai][bj][m][0], acc[ai][bj][m][1]); }
        BR_LOAD(0); BR_COMP(0); BR_LOAD(1); BR_STORE(0); BR_COMP(1); BR_STORE(1);
#undef BR_LOAD
#undef BR_COMP
#undef BR_STORE
    }
};

struct EpiRes {
    static constexpr bool PERM = true, ACC_INIT = true;
    bf16_t* xb; unsigned char* xq; float* ssq;
    __device__ __forceinline__ void init(AccRef acc, const pg8::Unit& u, int wr, int wc, int fr, int fq) const {
        const size_t ubase = (size_t)(u.pm * 256 + wr * 64) * 1024 + u.pn * 256 + wc * 32;
        unsigned loff = (unsigned)(fr * 1024 + 8 * fq);
        asm volatile("" : "+v"(loff));
        const GAS bf16_t* hb = (const GAS bf16_t*)(xb + ubase); const GAS unsigned char* qb_ = (const GAS unsigned char*)(xq + ubase);
#pragma unroll
        for (int ai = 0; ai < 2; ++ai)
#pragma unroll
            for (int m = 0; m < 4; ++m)
#pragma unroll
                for (int bj = 0; bj < 2; ++bj) { const unsigned o = (unsigned)((ai * 128 + m * 16) * 1024 + bj * 128) + loff;
                    const u32x4 h = *(const GAS u32x4*)(hb + o); const u32x2 q = *(const GAS u32x2*)(qb_ + o);
                    xdeq8(h, q, acc[ai][bj][m][0], acc[ai][bj][m][1]); }
    }
    __device__ __forceinline__ void operator()(AccRef acc, const pg8::Unit& u, int wr, int wc, int fr, int fq) const {
        const size_t ubase = (size_t)(u.pm * 256 + wr * 64) * 1024 + u.pn * 256 + wc * 32;
        unsigned loff = (unsigned)(fr * 1024 + 8 * fq);
        asm volatile("" : "+v"(loff));
        GAS bf16_t* hb = (GAS bf16_t*)(xb + ubase); GAS unsigned char* qb_ = (GAS unsigned char*)(xq + ubase);
#pragma unroll
        for (int ai = 0; ai < 2; ++ai)
#pragma unroll
            for (int m = 0; m < 4; ++m) { float s = 0.f;
#pragma unroll
                for (int bj = 0; bj < 2; ++bj) { const unsigned o = (unsigned)((ai * 128 + m * 16) * 1024 + bj * 128) + loff;
                    const f32x4 v0 = acc[ai][bj][m][0], v1 = acc[ai][bj][m][1];
                    const u32x4 h = pack8(v0, v1); u32x2 q; q.x = xquant4(v0, h.x, h.y); q.y = xquant4(v1, h.z, h.w);
                    *(GAS u32x4*)(hb + o) = h; *(GAS u32x2*)(qb_ + o) = q; s += sq4(v0) + sq4(v1); }
                s = quad_sum(s); if (fq == 0) ((GAS float*)ssq)[(size_t)(u.pm * 256 + ai * 128 + wr * 64 + m * 16 + fr) * 16 + u.pn * 4 + wc] = s; }
    }
};

struct EpiNull {
    static constexpr bool PERM = true, ACC_INIT = false;
    __device__ __forceinline__ void operator()(AccRef acc, const pg8::Unit& u, int wr, int wc, int fr, int fq) const {
#pragma unroll
        for (int ai = 0; ai < 2; ++ai)
#pragma unroll
            for (int bj = 0; bj < 2; ++bj)
#pragma unroll
                for (int m = 0; m < 4; ++m)
#pragma unroll
                    for (int n = 0; n < 2; ++n) asm volatile("" :: "v"(acc[ai][bj][m][n]));
    }
};
struct EpiGU {
    static constexpr bool PERM = true, ACC_INIT = false;
    const float* ssq; bf16_t* act;
    __device__ __forceinline__ void operator()(AccRef acc, const pg8::Unit& u, int wr, int wc, int fr, int fq) const {
        float rs[2][4];
        ROWSTAT8(rs, ssq, 1.0f / 1024.0f, 1.0f);
#pragma unroll
        for (int ai = 0; ai < 2; ++ai)
#pragma unroll
            for (int m = 0; m < 4; ++m) {
                const int row = u.pm * 256 + ai * 128 + wr * 64 + m * 16 + fr;
                const float r_ = rs[ai][m];
                const f32x4 g0 = acc[ai][0][m][0] * r_, g1 = acc[ai][0][m][1] * r_, u0 = acc[ai][1][m][0] * r_, u1 = acc[ai][1][m][1] * r_;
                const f32x4 a0 = g0 * sig4(g0) * u0, a1 = g1 * sig4(g1) * u1;
                *(GAS u32x4*)(act + (size_t)row * DFF + u.pn * 128 + wc * 32 + 8 * fq) = pack8(a0, a1);
            }
    }
};

typedef short v4i16_t __attribute__((ext_vector_type(4)));
__device__ __forceinline__ v4i16_t vtr(const LAS unsigned char* p) { return __builtin_amdgcn_ds_read_tr16_b64_v4i16((LAS v4i16_t*)p); }
template <int DQK, int DV, int MODE>
__device__ __forceinline__ void attn_unit(LAS unsigned char* lds, const int tid, const bf16_t* Qg, int ldq, const bf16_t* Kg, int ldk, const bf16_t* K2g,
                                          const bf16_t* Vg, int ldv, bf16_t* Og, int ldo, int qbase, int NT, const float* kbar, int cur) {
    constexpr int KS = DQK + 8;
    constexpr int KBUF = 64 * KS * 2, VBUF = (DV / 32) * 4096;
    constexpr int KMAIN = (MODE == 1) ? 64 : DQK;
    constexpr int KCH = KMAIN / 8, NK = (64 * KCH) / 512, VCH = DV / 8, NV = (64 * VCH) / 512;
    constexpr int NJ = DQK / 16, ND = DV / 32;
    constexpr float THR = 8.0f;
    const int lane = tid & 63, wid = __builtin_amdgcn_readfirstlane(tid >> 6), r32 = lane & 31, hi = lane >> 5;
    bf16x8 qf[NJ];
    { const bf16_t* qrow = Qg + (size_t)(wid * 32 + r32) * ldq + 8 * hi;
#pragma unroll
      for (int j = 0; j < NJ; ++j) qf[j] = *(const GAS bf16x8*)(qrow + 16 * j); }
    unsigned selmask = 0xffu;
    if (MODE == 0 && cur > 3) {
        float g[7];
#pragma unroll
        for (int j = 0; j < 7; ++j) {
            float a = 0.f;
            if (j < cur) {
#pragma unroll
                for (int jj = 0; jj < 4; ++jj) {
                    const f32x4 k0 = *(const GAS f32x4*)(kbar + j * 64 + 16 * jj + 8 * hi), k1 = *(const GAS f32x4*)(kbar + j * 64 + 16 * jj + 8 * hi + 4);
                    a += bf2f((unsigned short)qf[jj][0]) * k0.x + bf2f((unsigned short)qf[jj][1]) * k0.y + bf2f((unsigned short)qf[jj][2]) * k0.z + bf2f((unsigned short)qf[jj][3]) * k0.w
                       + bf2f((unsigned short)qf[jj][4]) * k1.x + bf2f((unsigned short)qf[jj][5]) * k1.y + bf2f((unsigned short)qf[jj][6]) * k1.z + bf2f((unsigned short)qf[jj][7]) * k1.w;
                }
                a += __shfl_xor(a, 32);
            }
            g[j] = a;
        }
        unsigned sm = 0u;
#pragma unroll
        for (int j = 0; j < 7; ++j) {
            int rank = 0;
#pragma unroll
            for (int i = 0; i < 7; ++i) if (i != j) rank += (i < cur && (g[i] > g[j] || (g[i] == g[j] && i < j))) ? 1 : 0;
            if (j < cur && rank < 3) sm |= (1u << j);
        }
        selmask = sm | (1u << cur);
    }
    u32x4 kreg[NK], vreg[NV], k2reg = {0u, 0u, 0u, 0u};
#define ATT_LOAD(t) do { \
    _Pragma("unroll") for (int i = 0; i < NK; ++i) { const int idx = tid + 512 * i, kv = idx / KCH, c = idx % KCH; kreg[i] = *(const GAS u32x4*)(Kg + (size_t)(64 * (t) + kv) * ldk + 8 * c); } \
    if (MODE == 1) { if (tid < 256) k2reg = *(const GAS u32x4*)(K2g + (size_t)(64 * (t) + (tid >> 2)) * 32 + 8 * (tid & 3)); } \
    _Pragma("unroll") for (int i = 0; i < NV; ++i) { const int idx = tid + 512 * i, kv = idx / VCH, c = idx % VCH; vreg[i] = *(const GAS u32x4*)(Vg + (size_t)(64 * (t) + kv) * ldv + 8 * c); } } while (0)
#define ATT_STORE(buf) do { LAS unsigned char* kb_ = lds + (buf) * KBUF; LAS unsigned char* vb_ = lds + 2 * KBUF + (buf) * VBUF; \
    _Pragma("unroll") for (int i = 0; i < NK; ++i) { const int idx = tid + 512 * i, kv = idx / KCH, c = idx % KCH; *(LAS u32x4*)(kb_ + (kv * KS + 8 * c) * 2) = kreg[i]; } \
    if (MODE == 1) { if (tid < 256) *(LAS u32x4*)(kb_ + ((tid >> 2) * KS + 64 + 8 * (tid & 3)) * 2) = k2reg; } \
    _Pragma("unroll") for (int i = 0; i < NV; ++i) { const int idx = tid + 512 * i, kv = idx / VCH, c = idx % VCH; *(LAS u32x4*)(vb_ + (c >> 2) * 4096 + kv * 64 + (c & 3) * 16) = vreg[i]; } } while (0)
    ATT_LOAD(0); ATT_STORE(0);
    __syncthreads();
    f32x16 o[ND];
#pragma unroll
    for (int d0 = 0; d0 < ND; ++d0)
#pragma unroll
        for (int r = 0; r < 16; ++r) o[d0][r] = 0.f;
    f32x16 negm;
#pragma unroll
    for (int r = 0; r < 16; ++r) negm[r] = 0.f;
    float mref = 0.f, lrun = 0.f;
    const int qabs = qbase + wid * 32 + r32;
    const int qwmax = qbase + wid * 32 + 31;
    const int vlane = (4 * hi + ((lane & 15) >> 2)) * 64 + ((lane >> 4) & 1) * 32 + (lane & 3) * 8;
    for (int t = 0; t < NT; ++t) {
        const int buf = t & 1;
        if (t + 1 < NT) ATT_LOAD(t + 1);
        bool lane_ok = true, causal = false, active = true;
        if (MODE == 0) { const int blk = t >> 2; if (blk < cur) lane_ok = ((selmask >> blk) & 1u) != 0u; else causal = (64 * t + 63 > qbase + wid * 32); active = (__any(lane_ok ? 1 : 0) != 0) && (64 * t <= qwmax); }
        if (MODE == 1) { causal = (64 * t + 63 > qbase + wid * 32); active = (64 * t <= qwmax); }
        if (active) {
            const LAS unsigned char* kb = lds + buf * KBUF + (r32 * KS + 8 * hi) * 2;
            f32x16 s0 = negm, s1 = negm;
#pragma unroll
            for (int j = 0; j < NJ; ++j) {
                const bf16x8 k0 = *(const LAS bf16x8*)(kb + j * 32), k1 = *(const LAS bf16x8*)(kb + 32 * KS * 2 + j * 32);
                s0 = __builtin_amdgcn_mfma_f32_32x32x16_bf16(k0, qf[j], s0, 0, 0, 0);
                s1 = __builtin_amdgcn_mfma_f32_32x32x16_bf16(k1, qf[j], s1, 0, 0, 0);
            }
            if (MODE != 2) {
                if (!lane_ok) {
#pragma unroll
                    for (int r = 0; r < 16; ++r) { s0[r] = -INFINITY; s1[r] = -INFINITY; }
                } else if (causal) {
                    const int kb0 = 64 * t + 4 * hi;
#pragma unroll
                    for (int r = 0; r < 16; ++r) { const int kv = kb0 + (r & 3) + 8 * (r >> 2); if (kv > qabs) s0[r] = -INFINITY; if (kv + 32 > qabs) s1[r] = -INFINITY; }
                }
            }
            float mxa = fmaxf(fmaxf(s0[0], s0[1]), s1[0]), mxb = fmaxf(fmaxf(s0[2], s0[3]), s1[1]);
            mxa = fmaxf(fmaxf(mxa, s1[2]), s1[3]);
#pragma unroll
            for (int r = 4; r < 16; r += 4) { mxa = fmaxf(fmaxf(mxa, s0[r]), s0[r + 1]); mxb = fmaxf(fmaxf(mxb, s0[r + 2]), s0[r + 3]); mxa = fmaxf(fmaxf(mxa, s1[r]), s1[r + 1]); mxb = fmaxf(fmaxf(mxb, s1[r + 2]), s1[r + 3]); }
            float mx = fmaxf(mxa, mxb);
            mx = fmaxf(mx, __shfl_xor(mx, 32));
            if (__any(mx > THR ? 1 : 0)) {
                const float dl = (mx > THR) ? mx : 0.f;
                mref += dl;
#pragma unroll
                for (int r = 0; r < 16; ++r) { s0[r] -= dl; s1[r] -= dl; negm[r] = -mref; }
                const float alpha = __builtin_amdgcn_exp2f(-dl);
                lrun *= alpha;
#pragma unroll
                for (int d0 = 0; d0 < ND; ++d0)
#pragma unroll
                    for (int r = 0; r < 16; ++r) o[d0][r] *= alpha;
            }
            float psa = 0.f, psb = 0.f;
#pragma unroll
            for (int r = 0; r < 16; ++r) { s0[r] = __builtin_amdgcn_exp2f(s0[r]); s1[r] = __builtin_amdgcn_exp2f(s1[r]); psa += s0[r]; psb += s1[r]; }
            lrun += psa + psb;
            bf16x8 pb[4];
            { u32x4 w;
              w.x = cvt_pk_bf16(s0[0], s0[1]); w.y = cvt_pk_bf16(s0[2], s0[3]); w.z = cvt_pk_bf16(s0[4], s0[5]); w.w = cvt_pk_bf16(s0[6], s0[7]); pb[0] = __builtin_bit_cast(bf16x8, w);
              w.x = cvt_pk_bf16(s0[8], s0[9]); w.y = cvt_pk_bf16(s0[10], s0[11]); w.z = cvt_pk_bf16(s0[12], s0[13]); w.w = cvt_pk_bf16(s0[14], s0[15]); pb[1] = __builtin_bit_cast(bf16x8, w);
              w.x = cvt_pk_bf16(s1[0], s1[1]); w.y = cvt_pk_bf16(s1[2], s1[3]); w.z = cvt_pk_bf16(s1[4], s1[5]); w.w = cvt_pk_bf16(s1[6], s1[7]); pb[2] = __builtin_bit_cast(bf16x8, w);
              w.x = cvt_pk_bf16(s1[8], s1[9]); w.y = cvt_pk_bf16(s1[10], s1[11]); w.z = cvt_pk_bf16(s1[12], s1[13]); w.w = cvt_pk_bf16(s1[14], s1[15]); pb[3] = __builtin_bit_cast(bf16x8, w); }
            const LAS unsigned char* vb = lds + 2 * KBUF + buf * VBUF + vlane;
#pragma unroll
            for (int d0 = 0; d0 < ND; ++d0)
#pragma unroll
                for (int kk = 0; kk < 4; ++kk) {
                    const v4i16_t a = vtr(vb + d0 * 4096 + kk * 1024), b = vtr(vb + d0 * 4096 + kk * 1024 + 512);
                    const bf16x8 vf = {a[0], a[1], a[2], a[3], b[0], b[1], b[2], b[3]};
                    o[d0] = __builtin_amdgcn_mfma_f32_32x32x16_bf16(vf, pb[kk], o[d0], 0, 0, 0);
                }
        }
        if (t + 1 < NT) ATT_STORE(buf ^ 1);
        __syncthreads();
    }
#undef ATT_LOAD
#undef ATT_STORE
    lrun += __shfl_xor(lrun, 32);
    const float inv = 1.0f / lrun;
    bf16_t* orow = Og + (size_t)(wid * 32 + r32) * ldo + 4 * hi;
#pragma unroll
    for (int d0 = 0; d0 < ND; ++d0)
#pragma unroll
        for (int rg = 0; rg < 4; ++rg) {
            u32x2 w; w.x = cvt_pk_bf16(o[d0][4 * rg] * inv, o[d0][4 * rg + 1] * inv); w.y = cvt_pk_bf16(o[d0][4 * rg + 2] * inv, o[d0][4 * rg + 3] * inv);
            *(GAS u32x2*)(orow + 32 * d0 + 8 * rg) = w;
        }
}

__device__ __forceinline__ float wave_sum(float v) {
#pragma unroll
    for (int o = 1; o < 64; o <<= 1) v += __shfl_xor(v, o);
    return v;
}
template <class MapFn>
__device__ __forceinline__ void transpose_item(const float* W, int K, int N, bf16_t* WT, const float* gain, LAS float* scr, int item, int lane, MapFn map) {
    const int nblk = N / 32, kb = item / nblk, nb = item % nblk, k0 = 64 * kb, n0 = 32 * nb;
    f32x4 w[8]; float gv[8];
#pragma unroll
    for (int i = 0; i < 8; ++i) { const int kk = 8 * i + (lane >> 3); w[i] = *(const GAS f32x4*)(W + (size_t)(k0 + kk) * N + n0 + 4 * (lane & 7)); gv[i] = gain ? ((const GAS float*)gain)[k0 + kk] : 1.0f; }
#pragma unroll
    for (int i = 0; i < 8; ++i) { const int kk = 8 * i + (lane >> 3); LAS float* d = scr + kk * 33 + 4 * (lane & 7); const f32x4 v = w[i] * gv[i]; d[0] = v.x; d[1] = v.y; d[2] = v.z; d[3] = v.w; }
    asm volatile("s_waitcnt lgkmcnt(0)" ::: "memory");
    const int c = lane & 7;
#pragma unroll
    for (int j = 0; j < 4; ++j) { const int n = (lane >> 3) + 8 * j; const LAS float* s = scr + (8 * c) * 33 + n;
        u32x4 o; o.x = cvt_pk_bf16(s[0 * 33], s[1 * 33]); o.y = cvt_pk_bf16(s[2 * 33], s[3 * 33]); o.z = cvt_pk_bf16(s[4 * 33], s[5 * 33]); o.w = cvt_pk_bf16(s[6 * 33], s[7 * 33]);
        *(GAS u32x4*)(WT + (size_t)map(n0 + n) * K + k0 + 8 * c) = o; }
    asm volatile("s_waitcnt lgkmcnt(0)" ::: "memory");
}
__device__ __forceinline__ int map_in(int n) {
    if (n < 1024) { const int base = n & 512, mm = n & 511, head = mm >> 6, e = mm & 63; return base + 256 * (head >> 2) + 128 * (e >> 5) + 32 * (head & 3) + (e & 31); }
    if (n < 1920) return n;
    if (n < 2176) return 2048 + (n - 1920);
    if (n < 2208) return 1920 + (n - 2176);
    return 2304 + (n - 2208);
}
__device__ __forceinline__ int map_uq(int n) { const int head = n / 96, e = n % 96; if (e < 64) return 64 * head + e; const int r = e - 64; return 512 + 128 * (r >> 4) + 16 * head + (r & 15); }
__device__ __forceinline__ int map_gu(int n) { if (n < DFF) return 256 * (n >> 7) + (n & 127); const int a = n - DFF; return 256 * (a >> 7) + 128 + (a & 127); }
__device__ __forceinline__ int map_id(int n) { return n; }

#define XB_TMO      128
#define XB_XCNT(j)  (256  + 64 * (j))
#define XB_XSUB(j)  (1280 + 64 * (j))
#define XB_XGEN(j)  (2304 + 64 * (j))
#define XB_TOP      3328
#define XB_TOPGEN   3392
#define XCD_BAR_WORDS 3456
#define XB_SPIN_CAP (1u << 18)
__device__ __forceinline__ unsigned xb_ld(unsigned* p)              { return __hip_atomic_load(p, __ATOMIC_RELAXED, __HIP_MEMORY_SCOPE_AGENT); }
__device__ __forceinline__ unsigned xb_add(unsigned* p, unsigned v) { return __hip_atomic_fetch_add(p, v, __ATOMIC_RELAXED, __HIP_MEMORY_SCOPE_AGENT); }
__device__ __forceinline__ unsigned xb_xcc_id() { return (unsigned)__builtin_amdgcn_s_getreg((3 << 11) | 20) & 0xFu; }
#define XB_SPIN(cond, bar) do { unsigned _sp = 0; while (cond) { __builtin_amdgcn_s_sleep(1); \
    if ((++_sp & 255u) == 0u) { if (xb_ld(&(bar)[XB_TMO])) break; if (_sp > XB_SPIN_CAP) { atomicAdd(&(bar)[XB_TMO], 1u); break; } } } } while (0)
struct XcdBarrier { unsigned* bar; unsigned x; volatile LAS unsigned* st; };
__device__ __forceinline__ XcdBarrier xcd_barrier_post(unsigned* bar, volatile LAS unsigned* st) {
    XcdBarrier b; b.bar = bar; b.x = xb_xcc_id(); b.st = st;
    if (threadIdx.x == 0) (void)xb_add(&bar[XB_XCNT(b.x)], 1u);
    return b;
}
__device__ __forceinline__ void xcd_barrier_complete(unsigned* bar, unsigned x, unsigned& nloc, unsigned& nx) {
    const unsigned G = gridDim.x * gridDim.y * gridDim.z;
    unsigned sum, cnt, mine, sp = 0u;
    for (;;) {
        sum = 0u; cnt = 0u; mine = 0u;
#pragma unroll
        for (unsigned j = 0; j < 16; ++j) { const unsigned c = xb_ld(&bar[XB_XCNT(j)]); sum += c; cnt += (c > 0u) ? 1u : 0u; mine = (j == x) ? c : mine; }
        if (sum == G) break;
        __builtin_amdgcn_s_sleep(1);
        if ((++sp & 255u) == 0u) { if (xb_ld(&bar[XB_TMO])) break; if (sp > XB_SPIN_CAP) { atomicAdd(&bar[XB_TMO], 1u); break; } }
    }
    nloc = mine > 0u ? mine : 1u; nx = cnt > 0u ? cnt : 1u;
}
__device__ __forceinline__ void xcd_barrier(const XcdBarrier& b) {
    asm volatile("s_waitcnt vmcnt(0)" ::: "memory");
    __syncthreads();
    if (threadIdx.x == 0) {
        unsigned* bar = b.bar;
        __builtin_amdgcn_s_waitcnt(0);
        unsigned nloc = b.st[0], nx = b.st[1];
        if (nloc == 0u) { xcd_barrier_complete(bar, b.x, nloc, nx); b.st[0] = nloc; b.st[1] = nx; }
        const unsigned old = xb_add(&bar[XB_XSUB(b.x)], 1u);
        const unsigned gen = old / nloc;
        if (old + 1u == (gen + 1u) * nloc) {
            __builtin_amdgcn_fence(__ATOMIC_RELEASE, "agent");
            asm volatile("s_waitcnt vmcnt(0)" ::: "memory");
            const unsigned og = xb_add(&bar[XB_TOP], 1u);
            const unsigned tg = og / nx;
            if (og + 1u == (tg + 1u) * nx) xb_add(&bar[XB_TOPGEN], 1u);
            else XB_SPIN(xb_ld(&bar[XB_TOPGEN]) == tg, bar);
            __builtin_amdgcn_fence(__ATOMIC_ACQUIRE, "agent");
            xb_add(&bar[XB_XGEN(b.x)], 1u);
            asm volatile("s_waitcnt vmcnt(0)" ::: "memory");
        } else {
            XB_SPIN(xb_ld(&bar[XB_XGEN(b.x)]) == gen, bar);
            __builtin_amdgcn_fence(__ATOMIC_ACQUIRE, "agent");
            asm volatile("s_waitcnt vmcnt(0)" ::: "memory");
        }
    }
    __syncthreads();
}

struct Args {
    const float* x; const float* mem; const int* pos;
    const float* norm_mix; const float* w_in; const float* q_lat_norm; const float* w_uq; const float* kv_lat_norm; const float* w_ukv;
    const float* w_ba; const float* w_bb; const float* w_out; const float* norm_x; const float* norm_mem; const float* w_xq; const float* w_xkv; const float* w_xo;
    const float* norm_ffn; const float* w_gu; const float* w_dn; const float* norm_final;
    float* out; unsigned char* ws; int ph_lo, ph_hi;
};

constexpr int PH_PER_LAYER = 11, N_PHASES = DEPTH * PH_PER_LAYER + 1;
constexpr int LDS_TOTAL = pg8::STAGE_BYTES;

__global__ void __launch_bounds__(512, 2) fwd_kernel(Args a_in) {
    __shared__ __attribute__((aligned(16))) unsigned char lds_raw[LDS_TOTAL];
    LAS unsigned char* lds = (LAS unsigned char*)lds_raw;
    const int ph_lo = a_in.ph_lo, ph_hi = a_in.ph_hi;
    __shared__ __attribute__((aligned(16))) unsigned bar_st[4];
    __shared__ unsigned long long tacc[2];
    if (threadIdx.x == 0) { tacc[0] = 0ull; tacc[1] = 0ull; }
    if (threadIdx.x < 4) bar_st[threadIdx.x] = 0u;
    __syncthreads();
    XcdBarrier bar; bar.bar = (unsigned*)(a_in.ws + WS_CTL); bar.x = 0; bar.st = (volatile LAS unsigned*)bar_st;
    if (ph_hi - ph_lo > 1) bar = xcd_barrier_post((unsigned*)(a_in.ws + WS_CTL), (volatile LAS unsigned*)bar_st);
    for (int ph = ph_lo; ph < ph_hi; ++ph) {
        if (ph > ph_lo) { if (ph == ph_lo + 1) cg::this_grid().sync(); else xcd_barrier(bar); if (XSYNC) { xcd_barrier(bar); xcd_barrier(bar); } }
        if (TPROBE >= 0 && blockIdx.x == 0 && threadIdx.x == 0) {
            const unsigned long long now = __builtin_amdgcn_s_memrealtime();
            const int pprev = (ph - 1 < 0) ? -1 : ((ph - 1 == N_PHASES - 1) ? 11 : (ph - 1) % PH_PER_LAYER), pcur = (ph == N_PHASES - 1) ? 11 : ph % PH_PER_LAYER;
            if (pprev == TPROBE) tacc[0] += now - tacc[1];
            if (pcur == TPROBE) tacc[1] = now;
        }
        int tid = threadIdx.x; asm volatile("" : "+v"(tid));
        int G = gridDim.x, bx = blockIdx.x; asm volatile("" : "+s"(G), "+s"(bx));
        const int lane = tid & 63, wave = __builtin_amdgcn_readfirstlane(tid >> 6);
        const int vcu = (G % 8 == 0) ? (bx % 8) * (G / 8) + bx / 8 : bx;
        const int gw = vcu * 8 + wave, NGW = G * 8;
        const __attribute__((address_space(4))) Args* ap = (const __attribute__((address_space(4))) Args*)__builtin_amdgcn_kernarg_segment_ptr(); asm volatile("" : "+s"(ap));
        const __attribute__((address_space(4))) Args& a = *ap;
        unsigned char* ws = a.ws; float* aout = a.out; const float* ax = a.x;
        asm volatile("" : "+s"(ws), "+s"(aout), "+s"(ax));
        bf16_t* Win_t = (bf16_t*)(ws + WS_WIN); bf16_t* Wuq_t = (bf16_t*)(ws + WS_WUQ); bf16_t* Wukv_t = (bf16_t*)(ws + WS_WUKV);
        bf16_t* Wba_t = (bf16_t*)(ws + WS_WBA); bf16_t* Wbb_t = (bf16_t*)(ws + WS_WBB); bf16_t* Wout_t = (bf16_t*)(ws + WS_WOUT);
        bf16_t* Wxq_t = (bf16_t*)(ws + WS_WXQ); bf16_t* Wxkv_t = (bf16_t*)(ws + WS_WXKV); bf16_t* Wxo_t = (bf16_t*)(ws + WS_WXO);
        bf16_t* Wgu_t = (bf16_t*)(ws + WS_WGU); bf16_t* Wdn_t = (bf16_t*)(ws + WS_WDN);
        bf16_t* XB = (bf16_t*)(ws + WS_XB); bf16_t* QB = (bf16_t*)aout;
        bf16_t* QKVA = (bf16_t*)(ws + WS_QKVA); bf16_t* QX = (bf16_t*)(ws + WS_QKVA);
        bf16_t* LAT = (bf16_t*)(ws + WS_LAT); bf16_t* OB = (bf16_t*)(ws + WS_LAT);
        bf16_t* KVLAT = (bf16_t*)(ws + WS_KVLAT); bf16_t* GATES = (bf16_t*)(ws + WS_GATES); bf16_t* ACT = (bf16_t*)(ws + WS_ACT);
        bf16_t* KVB = (bf16_t*)(ws + WS_KVB); bf16_t* KVX = (bf16_t*)(ws + WS_KVX); bf16_t* MEMB = (bf16_t*)(ws + WS_MEMB); bf16_t* KPE = (bf16_t*)(ws + WS_KPE);
        float* COSA = (float*)(ws + WS_COSA); float* SINA = (float*)(ws + WS_SINA); float* COSB = (float*)(ws + WS_COSB); float* SINB = (float*)(ws + WS_SINB);
        unsigned char* XQ = ws + WS_XQ; float* SSQ = (float*)(ws + WS_SSQ); float* LSSQ = (float*)(ws + WS_LSSQ); float* RSTDM = (float*)(ws + WS_RSTDM); float* KBAR = (float*)(ws + WS_KBAR);

        if (ph == N_PHASES - 1) {
            if (!PHON(11)) continue;
            for (int row = gw; row < M; row += NGW) {
                const f32x4* sp = (const f32x4*)(SSQ + (size_t)row * 16);
                const f32x4 p0 = sp[0], p1 = sp[1], p2 = sp[2], p3 = sp[3];
                const float s = ((p0.x + p0.y) + (p0.z + p0.w)) + ((p1.x + p1.y) + (p1.z + p1.w)) + ((p2.x + p2.y) + (p2.z + p2.w)) + ((p3.x + p3.y) + (p3.z + p3.w));
                const float rs = rsqrtf(s * (1.0f / 1024.0f) + EPS);
                GAS f32x4* xr = (GAS f32x4*)(aout + (size_t)row * DM) + lane; const GAS f32x4* gr = (const GAS f32x4*)a.norm_final + lane;
                const GAS u32x2* hr = (const GAS u32x2*)(XB + (size_t)row * DM) + lane; const GAS unsigned* qr = (const GAS unsigned*)(XQ + (size_t)row * DM) + lane;
#pragma unroll
                for (int j = 0; j < 4; ++j) { const u32x2 h = hr[64 * j]; const unsigned q = qr[64 * j]; const f32x4 g = gr[64 * j]; f32x4 v;
                    v.x = xdeq(h.x & 0xffffu, bflo(h.x), (int)(q << 24) >> 24); v.y = xdeq(h.x >> 16, bfhi(h.x), (int)(q << 16) >> 24);
                    v.z = xdeq(h.y & 0xffffu, bflo(h.y), (int)(q << 8) >> 24); v.w = xdeq(h.y >> 16, bfhi(h.y), (int)q >> 24);
                    xr[64 * j] = v * rs * g; }
            }
            continue;
        }
        const int l = ph / PH_PER_LAYER, p = ph % PH_PER_LAYER;
        if (STAG > 0 && (p == 5 || p == 8 || p == 10)) {
            const unsigned long long t0 = __builtin_amdgcn_s_memrealtime(); const unsigned long long dl = (unsigned long long)((vcu & 3) * STAG);
            while (__builtin_amdgcn_s_memrealtime() - t0 < dl) __builtin_amdgcn_s_sleep(8);
        }
        const float* xin = (l == 0 && p == 5) ? ax : aout;
        if (!PHON(p)) continue;
        if (p == 0) {
            LAS float* scr = (LAS float*)(lds + wave * 16384);
            constexpr int I_IN = 16 * (IN_W / 32), I_UQ = 6 * 24, I_UKV = 4 * 32, I_BA = 8 * 32, I_OUT = 16 * 32, I_XQ = 16 * 16, I_XKV = 16 * 32, I_XO = 8 * 32, I_GU = 16 * (2 * DFF / 32), I_DN = (DFF / 64) * 32;
            constexpr int NIT = I_IN + I_UQ + I_UKV + 2 * I_BA + I_OUT + I_XQ + I_XKV + I_XO + I_GU + I_DN;
            for (int rep = 0; rep < 1 + DUP(0); ++rep)
            for (int it = gw; it < NIT; it += NGW) {
                int r = it;
                if (r < I_IN) { transpose_item(a.w_in + (size_t)l * DM * IN_W, DM, IN_W, Win_t, a.norm_mix + l * DM, scr, r, lane, map_in); continue; } r -= I_IN;
                if (r < I_UQ) { transpose_item(a.w_uq + (size_t)l * 384 * 768, 384, 768, Wuq_t, a.q_lat_norm + l * 384, scr, r, lane, map_uq); continue; } r -= I_UQ;
                if (r < I_UKV) { transpose_item(a.w_ukv + (size_t)l * 256 * 1024, 256, 1024, Wukv_t, a.kv_lat_norm + l * 256, scr, r, lane, map_id); continue; } r -= I_UKV;
                if (r < I_BA) { transpose_item(a.w_ba + (size_t)l * 512 * 1024, 512, 1024, Wba_t, nullptr, scr, r, lane, map_id); continue; } r -= I_BA;
                if (r < I_BA) { transpose_item(a.w_bb + (size_t)l * 512 * 1024, 512, 1024, Wbb_t, nullptr, scr, r, lane, map_id); continue; } r -= I_BA;
                if (r < I_OUT) { transpose_item(a.w_out + (size_t)l * 1024 * 1024, 1024, 1024, Wout_t, nullptr, scr, r, lane, map_id); continue; } r -= I_OUT;
                if (r < I_XQ) { transpose_item(a.w_xq + (size_t)l * 1024 * 512, 1024, 512, Wxq_t, a.norm_x + l * DM, scr, r, lane, map_id); continue; } r -= I_XQ;
                if (r < I_XKV) { transpose_item(a.w_xkv + (size_t)l * 1024 * 1024, 1024, 1024, Wxkv_t, a.norm_mem + l * DM, scr, r, lane, map_id); continue; } r -= I_XKV;
                if (r < I_XO) { transpose_item(a.w_xo + (size_t)l * 512 * 1024, 512, 1024, Wxo_t, nullptr, scr, r, lane, map_id); continue; } r -= I_XO;
                if (r < I_GU) { transpose_item(a.w_gu + (size_t)l * 1024 * 2 * DFF, 1024, 2 * DFF, Wgu_t, a.norm_ffn + l * DM, scr, r, lane, map_gu); continue; } r -= I_GU;
                transpose_item(a.w_dn + (size_t)l * DFF * 1024, DFF, 1024, Wdn_t, nullptr, scr, r, lane, map_id);
            }
            for (int i = vcu * 512 + tid; i < 96 * 1024 / 8; i += G * 512) *(GAS u32x4*)(Win_t + (size_t)1952 * 1024 + (size_t)i * 8) = (u32x4){0u, 0u, 0u, 0u};
            if (l == 0) {
                for (int row = gw; row < M + MM; row += NGW) {
                    const bool ism = row >= M; const int r = ism ? row - M : row;
                    const f32x4* xr = (const f32x4*)((ism ? a.mem : ax) + (size_t)r * DM) + lane;
                    f32x4 v[4]; float s = 0.f;
#pragma unroll
                    for (int j = 0; j < 4; ++j) { v[j] = xr[64 * j]; s += sq4(v[j]); }
                    s = wave_sum(s);
                    GAS_U32X2_PTR o8 = (GAS_U32X2_PTR)((ism ? MEMB : XB) + (size_t)r * DM) + lane;
#pragma unroll
                    for (int j = 0; j < 4; ++j) { u32x2 w; w.x = cvt_pk_bf16(v[j].x, v[j].y); w.y = cvt_pk_bf16(v[j].z, v[j].w); o8[64 * j] = w;
                        if (!ism) ((GAS unsigned*)(XQ + (size_t)r * DM))[64 * j + lane] = xquant4(v[j], w.x, w.y); }
                    if (ism) { if (lane == 0) RSTDM[r] = rsqrtf(s * (1.0f / 1024.0f) + EPS); }
                    else if (lane < 16) SSQ[(size_t)r * 16 + lane] = (lane == 0) ? s : 0.f;
                }
                for (int i = vcu * 512 + tid; i < M * 32; i += G * 512) {
                    const int row = i >> 5, k = i & 31; const float posf = (float)a.pos[row];
                    const float inv = expf(-9.210340371976184f * (2.0f / 64.0f) * (float)k);
                    float sn, cs; sincosf(posf * inv, &sn, &cs); COSA[i] = cs; SINA[i] = sn;
                    if (k < 16) { const float invb = expf(-9.210340371976184f * (2.0f / 32.0f) * (float)k); float sb, cb; sincosf(posf * invb, &sb, &cb); COSB[row * 16 + k] = cb; SINB[row * 16 + k] = sb; }
                }
            }
            __syncthreads();
        } else if (p == 1) {
            pg8::Gemm g{XB, Win_t, M, IN_WP, DM, DM}; pg8::StaticOrder S; S.init(M, IN_WP, G, bx);
            EpiIn E{SSQ, QKVA, LAT, KVLAT, GATES, LSSQ, COSA, SINA};
            for (int rep = 0; rep < 1 + DUP(1); ++rep) { int tl = tid; asm volatile("" : "+v"(tl)); pg8::gemm_phase(lds, tl, g, S, E); }
        } else if (p == 2) {
            if (P2ON(0)) { LAS float* red = (LAS float*)lds;
              for (int it = vcu; it < 128 * 8; it += G) {
                  const int bh = it >> 3, j = it & 7, b = bh >> 3, h = bh & 7;
                  const bf16_t* kp = QKVA + (size_t)(b * SEQ + j * 256 + wave * 32) * 1536 + 512 + h * 64 + lane;
                  float s = 0.f; unsigned short kvv[32];
#pragma unroll
                  for (int r = 0; r < 32; ++r) kvv[r] = ((const GAS bf16_t*)kp)[(size_t)r * 1536];
#pragma unroll
                  for (int r = 0; r < 32; ++r) s += bf2f(kvv[r]);
                  red[wave * 64 + lane] = s;
                  __syncthreads();
                  if (wave == 0) { float t = 0.f;
#pragma unroll
                      for (int w = 0; w < 8; ++w) t += red[w * 64 + lane];
                      KBAR[(size_t)it * 64 + lane] = t * (1.0f / 256.0f); }
                  __syncthreads();
              }
              for (int i = vcu * 512 + tid; i < M * 16; i += G * 512) {
                  const int row = i >> 4, k = i & 15;
                  const float x1 = bf2f(LAT[(size_t)row * 512 + 384 + k]), x2 = bf2f(LAT[(size_t)row * 512 + 400 + k]);
                  const float c = COSB[i], s = SINB[i];
                  KPE[(size_t)row * 32 + k] = f2bf1(x1 * c - x2 * s); KPE[(size_t)row * 32 + 16 + k] = f2bf1(x2 * c + x1 * s);
              }
              __syncthreads(); }
            if (P2ON(1)) { unsigned char* w = ws; int tl = tid; asm volatile("" : "+s"(w), "+v"(tl));
              pg8::Gemm g{(bf16_t*)(w + WS_LAT), (bf16_t*)(w + WS_WUQ), M, 768, 384, 512}; pg8::StaticOrder S; S.init(M, 768, G, bx);
              EpiUq E{(float*)(w + WS_LSSQ), QB, (float*)(w + WS_COSB), (float*)(w + WS_SINB)}; pg8::gemm_phase(lds, tl, g, S, E); }
            if (P2ON(2)) { unsigned char* w = ws; int tl = tid; asm volatile("" : "+s"(w), "+v"(tl));
              pg8::Gemm g{(bf16_t*)(w + WS_KVLAT), (bf16_t*)(w + WS_WUKV), M, 1024, 256, 256}; pg8::StaticOrder S; S.init(M, 1024, G, G - 1 - bx);
              EpiRowScale<0> E{(float*)(w + WS_LSSQ), (bf16_t*)(w + WS_KVB), 1024, 1.f}; pg8::gemm_phase(lds, tl, g, S, E); }
            if (P2ON(3)) { unsigned char* w = ws; int tl = tid; asm volatile("" : "+s"(w), "+v"(tl));
              pg8::Gemm g{(bf16_t*)(w + WS_MEMB), (bf16_t*)(w + WS_WXKV), MM, 1024, 1024, 1024}; pg8::StaticOrder S; S.init(MM, 1024, G, (bx + 128) % G);
              EpiRowScale<1> E{(float*)(w + WS_RSTDM), (bf16_t*)(w + WS_KVX), 1024, 1.f}; pg8::gemm_phase(lds, tl, g, S, E); }
        } else if (p == 3) {
            for (int v = vcu; v < 256; v += G) {
                const int bh = v >> 1, b = bh >> 3, h = bh & 7;
                for (int rep = DUP(3) ? 0 : 1; rep < 2; ++rep)
#pragma unroll 1
                for (int i = 0; i < 4; ++i) {
                    const int cur = (v & 1) ? ((i == 0) ? 2 : (i == 1) ? 5 : (i == 2) ? 3 : 4) : ((i == 0) ? 0 : (i == 1) ? 7 : (i == 2) ? 1 : 6);
                    const size_t rowb = (size_t)b * SEQ, rowq = rowb + cur * 256;
                    attn_unit<64, 64, 0>(lds, tid, QKVA + rowq * 1536 + h * 64, 1536, QKVA + rowb * 1536 + 512 + h * 64, 1536, nullptr,
                                         QKVA + rowb * 1536 + 1024 + h * 64, 1536, rep ? QKVA + rowq * 1536 + h * 64 : (bf16_t*)(ws + 473 * MiB) + rowq * 512 + h * 64, rep ? 1536 : 512, cur * 256, 4 * (cur + 1), KBAR + (size_t)bh * 512, cur);
                }
                for (int rep = 0; rep < 1 + DUP(4); ++rep)
#pragma unroll 1
                for (int i = 0; i < 4; ++i) {
                    const int cur = (v & 1) ? ((i == 0) ? 2 : (i == 1) ? 5 : (i == 2) ? 3 : 4) : ((i == 0) ? 0 : (i == 1) ? 7 : (i == 2) ? 1 : 6);
                    const size_t rowb = (size_t)b * SEQ, rowq = rowb + cur * 256;
                    attn_unit<96, 64, 1>(lds, tid, QB + rowq * 768 + h * 96, 768, KVB + rowb * 1024 + h * 128, 1024, KPE + rowb * 32,
                                         KVB + rowb * 1024 + h * 128 + 64, 1024, OB + rowq * 512 + h * 64, 512, cur * 256, 4 * (cur + 1), nullptr, cur);
                }
            }
        } else if (p == 4) {
            { unsigned char* w = ws; int tl = tid; asm volatile("" : "+s"(w), "+v"(tl));
              pg8::Gemm g{(bf16_t*)(w + WS_QKVA), (bf16_t*)(w + WS_WBA), M, 1024, 512, 1536}; pg8::StaticOrder S; S.init(M, 1024, G, bx); EpiBranch<0> E{(bf16_t*)(w + WS_GATES)}; pg8::gemm_phase(lds, tl, g, S, E); }
            { unsigned char* w = ws; int tl = tid; asm volatile("" : "+s"(w), "+v"(tl));
              pg8::Gemm g{(bf16_t*)(w + WS_LAT), (bf16_t*)(w + WS_WBB), M, 1024, 512, 512}; pg8::StaticOrder S; S.init(M, 1024, G, bx); EpiBranch<1> E{(bf16_t*)(w + WS_GATES)}; pg8::gemm_phase(lds, tl, g, S, E); }
        } else if (p == 5) {
            pg8::Gemm g{GATES, Wout_t, M, 1024, 1024, 2048}; pg8::StaticOrder S; S.init(M, 1024, G, bx);
            if (ND(5)) { int tl = tid; asm volatile("" : "+v"(tl)); EpiNull EN; pg8::gemm_phase(lds, tl, g, S, EN); }
            EpiRes E{XB, XQ, SSQ}; pg8::gemm_phase(lds, tid, g, S, E);
        } else if (p == 6) {
            pg8::Gemm g{XB, Wxq_t, M, 512, 1024, 1024}; pg8::StaticOrder S; S.init(M, 512, G, bx);
            EpiRowScale<2> E{SSQ, QX, 512, C2X}; for (int rep = 0; rep < 1 + DUP(6); ++rep) { int tl = tid; asm volatile("" : "+v"(tl)); pg8::gemm_phase(lds, tl, g, S, E); }
        } else if (p == 7) {
            for (int un = vcu * 2; un < 512; un += 2 * G)
                for (int rep = DUP(7) ? 0 : 1; rep < 2; ++rep)
#pragma unroll 1
                for (int i = 0; i < 2; ++i) {
                    const int unit = un + i, bh = unit >> 3, qb = unit & 7, b = bh >> 2, h = bh & 3;
                    const size_t rowq = (size_t)b * SEQ + qb * 256, rowm = (size_t)b * MEMLEN;
                    attn_unit<128, 128, 2>(lds, tid, QX + rowq * 512 + h * 128, 512, KVX + rowm * 1024 + h * 128, 1024, nullptr,
                                           KVX + rowm * 1024 + 512 + h * 128, 1024, (rep ? QX : (bf16_t*)(ws + 473 * MiB)) + rowq * 512 + h * 128, 512, 0, 4, nullptr, 0);
                }
        } else if (p == 8) {
            pg8::Gemm g{QX, Wxo_t, M, 1024, 512, 512}; pg8::StaticOrder S; S.init(M, 1024, G, bx);
            if (ND(8)) { int tl = tid; asm volatile("" : "+v"(tl)); EpiNull EN; pg8::gemm_phase(lds, tl, g, S, EN); }
            EpiRes E{XB, XQ, SSQ}; pg8::gemm_phase(lds, tid, g, S, E);
        } else if (p == 9) {
            pg8::Gemm g{XB, Wgu_t, M, 2 * DFF, 1024, 1024}; pg8::StaticOrder S; S.init(M, 2 * DFF, G, bx);
            EpiGU E{SSQ, ACT}; for (int rep = 0; rep < 1 + DUP(9); ++rep) { int tl = tid; asm volatile("" : "+v"(tl)); pg8::gemm_phase(lds, tl, g, S, E); }
            if (DUP(12)) { int tl = tid; asm volatile("" : "+v"(tl)); EpiNull EN; pg8::gemm_phase(lds, tl, g, S, EN); }
        } else {
            pg8::Gemm g{ACT, Wdn_t, M, 1024, DFF, DFF}; pg8::StaticOrder S; S.init(M, 1024, G, bx);
            if (ND(10)) { int tl = tid; asm volatile("" : "+v"(tl)); EpiNull EN; pg8::gemm_phase(lds, tl, g, S, EN); }
            if (ND(13)) { int tl = tid; asm volatile("" : "+v"(tl)); EpiRes ED{(bf16_t*)(ws + 276 * MiB), (unsigned char*)(ws + 340 * MiB), LSSQ}; pg8::gemm_phase(lds, tl, g, S, ED); }
            EpiRes E{XB, XQ, SSQ}; pg8::gemm_phase(lds, tid, g, S, E);
        }
    }
    if (TPROBE >= 0 && blockIdx.x == 0) {
        __syncthreads();
        const unsigned long long t0 = __builtin_amdgcn_s_memrealtime(); const unsigned long long dl = (unsigned long long)TAMP * tacc[0];
        while (__builtin_amdgcn_s_memrealtime() - t0 < dl) __builtin_amdgcn_s_sleep(16);
    }
}

extern "C" void kernel_launch(void* const* d_in, const int* in_sizes, int n_in, void* d_out, int out_size, void* d_ws, size_t ws_size, hipStream_t stream) {
    static int grid = 0;
    if (grid == 0) {
        if (n_in != 21 || in_sizes[0] != M * DM || out_size != M * DM || ws_size < WS_END) {
            fprintf(stderr, "kernel_launch: unexpected shapes (n_in %d, in0 %d, out %d, ws %zu); nothing launched\n", n_in, n_in > 0 ? in_sizes[0] : -1, out_size, ws_size); grid = -1; return; }
        int dev = 0, cus = 0, per_cu = 0;
        hipGetDevice(&dev); hipDeviceGetAttribute(&cus, hipDeviceAttributeMultiprocessorCount, dev);
        if (hipOccupancyMaxActiveBlocksPerMultiprocessor(&per_cu, (const void*)fwd_kernel, 512, 0) != hipSuccess || per_cu < 1) per_cu = 1;
        (void)hipGetLastError();
        grid = cus * 1;
        if (grid <= 0) grid = 256;
    }
    if (grid < 0) return;
    Args a{};
    a.x = (const float*)d_in[0]; a.mem = (const float*)d_in[1]; a.pos = (const int*)d_in[2];
    a.norm_mix = (const float*)d_in[3]; a.w_in = (const float*)d_in[4]; a.q_lat_norm = (const float*)d_in[5]; a.w_uq = (const float*)d_in[6];
    a.kv_lat_norm = (const float*)d_in[7]; a.w_ukv = (const float*)d_in[8]; a.w_ba = (const float*)d_in[9]; a.w_bb = (const float*)d_in[10]; a.w_out = (const float*)d_in[11];
    a.norm_x = (const float*)d_in[12]; a.norm_mem = (const float*)d_in[13]; a.w_xq = (const float*)d_in[14]; a.w_xkv = (const float*)d_in[15]; a.w_xo = (const float*)d_in[16];
    a.norm_ffn = (const float*)d_in[17]; a.w_gu = (const float*)d_in[18]; a.w_dn = (const float*)d_in[19]; a.norm_final = (const float*)d_in[20];
    a.out = (float*)d_out; a.ws = (unsigned char*)d_ws;
#if ONE_LAUNCH
    if (hipMemsetAsync((char*)d_ws + WS_CTL, 0, 65536, stream) != hipSuccess) { fprintf(stderr, "kernel_launch: memset of the barrier words failed\n"); return; }
    a.ph_lo = 0; a.ph_hi = N_PHASES;
    void* args[] = {&a};
    hipError_t e = hipLaunchCooperativeKernel((const void*)fwd_kernel, dim3(grid), dim3(512), args, 0, stream);
    if (e != hipSuccess) fprintf(stderr, "cooperative launch failed: %s (grid %d)\n", hipGetErrorString(e), grid);
#else
    for (int ph = 0; ph < N_PHASES; ++ph) {
        a.ph_lo = ph; a.ph_hi = ph + 1;
        hipLaunchKernelGGL(fwd_kernel, dim3(grid), dim3(512), 0, stream, a);
    }
#endif
}
```

```cpp
#include <hip/hip_runtime.h>
#include <hip/hip_cooperative_groups.h>
#include <cstdio>
#include <cstdint>
namespace cg = cooperative_groups;

#ifndef ONE_LAUNCH
#define ONE_LAUNCH 1
#endif

#ifndef PHMASK
#define PHMASK 0xFFFF
#endif
#ifndef P2MASK
#define P2MASK 0xF
#endif
#define P2ON(k) (((P2MASK) >> (k)) & 1)
#ifndef DUPMASK
#define DUPMASK 0
#endif
#ifndef XSYNC
#define XSYNC 0
#endif
#define DUP(k) (((DUPMASK) >> (k)) & 1)
#ifndef STAG
#define STAG 0
#endif
#ifndef NDUP
#define NDUP 0
#endif
#define ND(k) (((NDUP) >> (k)) & 1)
#ifndef TPROBE
#define TPROBE -1
#endif
#define TAMP 4
#define PHON(k) (((PHMASK) >> (k)) & 1)
#define LAS __attribute__((address_space(3)))
#define GAS __attribute__((address_space(1)))
#define GAS_U32X2_PTR __attribute__((address_space(1))) u32x2*
typedef unsigned short bf16_t;
typedef short bf16x8 __attribute__((ext_vector_type(8)));
typedef float f32x4 __attribute__((ext_vector_type(4)));
typedef float f32x16 __attribute__((ext_vector_type(16)));
typedef unsigned u32x4 __attribute__((ext_vector_type(4)));
typedef unsigned u32x2 __attribute__((ext_vector_type(2)));

constexpr int NBATCH = 16, SEQ = 2048, DM = 1024, DEPTH = 4, MEMLEN = 256;
constexpr int M = NBATCH * SEQ;
constexpr int MM = NBATCH * MEMLEN;
constexpr int IN_W = 4256, IN_WP = 4352;
constexpr int DFF = 2816;
constexpr float EPS = 1e-6f;
constexpr float LOG2E = 1.4426950408889634f;
constexpr float C2A = 0.125f * LOG2E;
constexpr float C2B = 0.10206207261596575f * LOG2E;
constexpr float C2X = 0.08838834764831845f * LOG2E;

constexpr size_t MiB = 1u << 20;
constexpr size_t WS_WIN = 0 * MiB, WS_WUQ = 9 * MiB, WS_WUKV = 10 * MiB, WS_WBA = 11 * MiB, WS_WBB = 12 * MiB, WS_WOUT = 13 * MiB,
                 WS_WXQ = 15 * MiB, WS_WXKV = 16 * MiB, WS_WXO = 18 * MiB, WS_WGU = 19 * MiB, WS_WDN = 30 * MiB;
constexpr size_t WS_XB = 36 * MiB;
constexpr size_t WS_QKVA = 100 * MiB;
constexpr size_t WS_LAT = 196 * MiB;
constexpr size_t WS_KVLAT = 228 * MiB;
constexpr size_t WS_GATES = 244 * MiB;
constexpr size_t WS_ACT = 100 * MiB;
constexpr size_t WS_KVB = 372 * MiB;
constexpr size_t WS_KVX = 436 * MiB;
constexpr size_t WS_MEMB = 444 * MiB;
constexpr size_t WS_KPE = 452 * MiB;
constexpr size_t WS_COSA = 454 * MiB, WS_SINA = 458 * MiB;
constexpr size_t WS_COSB = 462 * MiB, WS_SINB = 464 * MiB;
constexpr size_t WS_SSQ = 466 * MiB;
constexpr size_t WS_LSSQ = 468 * MiB;
constexpr size_t WS_RSTDM = 470 * MiB;
constexpr size_t WS_KBAR = 470 * MiB + 65536;
constexpr size_t WS_XQ = 473 * MiB;
constexpr size_t WS_CTL = 471 * MiB;
constexpr size_t WS_END = 505 * MiB;

typedef float f32x2_t __attribute__((ext_vector_type(2))); typedef __bf16 bf16x2_t __attribute__((ext_vector_type(2)));
__device__ __forceinline__ unsigned cvt_pk_bf16(float lo, float hi) { f32x2_t v = {lo, hi}; bf16x2_t b = __builtin_convertvector(v, bf16x2_t); return __builtin_bit_cast(unsigned, b); }
__device__ __forceinline__ float bf2f(unsigned short b) { return __uint_as_float(((unsigned)b) << 16); }
__device__ __forceinline__ float bflo(unsigned w) { return __uint_as_float(w << 16); }
__device__ __forceinline__ float bfhi(unsigned w) { return __uint_as_float(w & 0xffff0000u); }
__device__ __forceinline__ unsigned short f2bf1(float f) { return (unsigned short)(cvt_pk_bf16(f, 0.f) & 0xffffu); }


__device__ __forceinline__ float xdeq(unsigned hbits, float hf, int q) { unsigned e = (hbits >> 7) & 0xffu; e = e < 16u ? 16u : e; return __builtin_fmaf((float)q, __uint_as_float((e - 15u) << 23), hf); }
__device__ __forceinline__ unsigned xquant(float x, unsigned hbits, float hf) { unsigned e = (hbits >> 7) & 0xffu; e = e < 16u ? 16u : e;
    float qf = __builtin_rintf((x - hf) * __uint_as_float((269u - e) << 23)); qf = fminf(fmaxf(qf, -127.f), 127.f); return ((unsigned)(int)qf) & 0xffu; }
__device__ __forceinline__ void xdeq8(const u32x4 h, const u32x2 q, f32x4& a, f32x4& b) {
    a.x = xdeq(h.x & 0xffffu, bflo(h.x), (int)(q.x << 24) >> 24); a.y = xdeq(h.x >> 16, bfhi(h.x), (int)(q.x << 16) >> 24);
    a.z = xdeq(h.y & 0xffffu, bflo(h.y), (int)(q.x << 8) >> 24);  a.w = xdeq(h.y >> 16, bfhi(h.y), (int)q.x >> 24);
    b.x = xdeq(h.z & 0xffffu, bflo(h.z), (int)(q.y << 24) >> 24); b.y = xdeq(h.z >> 16, bfhi(h.z), (int)(q.y << 16) >> 24);
    b.z = xdeq(h.w & 0xffffu, bflo(h.w), (int)(q.y << 8) >> 24);  b.w = xdeq(h.w >> 16, bfhi(h.w), (int)q.y >> 24);
}
__device__ __forceinline__ unsigned xquant4(const f32x4 v, unsigned w0, unsigned w1) {
    return xquant(v.x, w0 & 0xffffu, bflo(w0)) | (xquant(v.y, w0 >> 16, bfhi(w0)) << 8) | (xquant(v.z, w1 & 0xffffu, bflo(w1)) << 16) | (xquant(v.w, w1 >> 16, bfhi(w1)) << 24);
}

namespace pg8 {
constexpr int BM = 256, BK = 64, HALF = 128, HTB = HALF * BK * 2, STAGE_BYTES = 8 * HTB, NXCD = 8, WGM = 8;
__host__ __device__ __forceinline__ int lds_byte(int r, int c) { const int st = (r >> 4) * 2 + (c >> 5), rr = r & 15, cc = c & 31, ob = rr * 64 + cc * 2; return st * 1024 + (ob ^ (((ob >> 9) & 1) << 5)); }
__host__ __device__ __forceinline__ void stage_rc(int b, int& R, int& C) { const int st = b / 1024, sb = b % 1024, swz = sb ^ (((sb >> 9) & 1) << 5); R = (st >> 1) * 16 + swz / 64; C = (st & 1) * 32 + (swz % 64) / 2; }
__host__ __device__ __forceinline__ int perm32(int rho) { const int n = rho >> 4, i = rho & 15; return 8 * (i >> 2) + 4 * n + (i & 3); }

struct Unit { int pm, pn, z; };
struct Gemm { const bf16_t* A; const bf16_t* Bt; int M, N, K, lda; size_t zA = 0, zB = 0; };

struct StaticOrder {
    int nM, nN, nwg, G, c, dual = 0;
    __device__ void init(int M_, int N_, int G_, int c_) { nM = M_ / BM; nN = N_ / BM; nwg = nM * nN; G = G_; c = c_; }
    __device__ bool next(int i, Unit& u) const {
        u.z = dual ? (i & 1) : 0; if (dual) i >>= 1;
        const long L = (long)i * G + c; if (L >= nwg) return false;
        int wgid = (int)L; { const int q = nwg / NXCD, r = nwg % NXCD, xcd = wgid % NXCD, off = wgid / NXCD; wgid = (xcd < r ? xcd * (q + 1) : r * (q + 1) + (xcd - r) * q) + off; }
        const int nig = WGM * nN, gid = wgid / nig, fm = gid * WGM, gsz = (nM - fm) < WGM ? (nM - fm) : WGM;
        u.pm = fm + ((wgid % nig) % gsz); u.pn = (wgid % nig) / gsz; return true;
    }
};

template <class Epi>
__device__ __forceinline__ void gemm_phase(LAS unsigned char* lds, const int tid, const Gemm g, const StaticOrder& S, const Epi& E) {
    LAS unsigned char* const sl = lds + STAGE_BYTES;
    const int wid = __builtin_amdgcn_readfirstlane(tid >> 6), lane = tid & 63, wr = wid >> 2, wc = wid & 3, fr = lane & 15, fq = lane >> 4;
    const int K = g.K, nt = K / BK;
    unsigned voffA[2], voffB[2];
#pragma unroll
    for (int i = 0; i < 2; ++i) { int R, C; stage_rc(tid * 16 + i * 8192, R, C); const int Rb = Epi::PERM ? ((R & ~31) + perm32(R & 31)) : R;
        voffA[i] = (unsigned)(R * g.lda + C) * 2u; voffB[i] = (unsigned)(Rb * K + C) * 2u; }
    const size_t kstep = (size_t)(BK * 2);
    const size_t hstepA = (size_t)HALF * g.lda * 2, hstepB = (size_t)HALF * K * 2;
    const size_t tstepA = 2 * hstepA, tstepB = 2 * hstepB;
    const unsigned ldsw = (unsigned)wid * 1024u;
    const int aoff = lds_byte(wr * 64 + fr, fq * 8), boff = lds_byte(wc * 32 + fr, fq * 8);
#define PG8_SA(b, h) (((b) * 2 + (h)) * HTB)
#define PG8_SB(b, h) ((4 + (b) * 2 + (h)) * HTB)
#define PG8_STAGE(bufoff, gbase, voff) do { _Pragma("unroll") for (int _i = 0; _i < 2; ++_i) \
        __builtin_amdgcn_global_load_lds((const unsigned*)((const char*)(gbase) + (voff)[_i]), (LAS unsigned*)(lds + (bufoff) + ldsw + _i * 8192), 16, 0, 0); } while (0)
#define PG8_LDA(dst, b, h) do { _Pragma("unroll") for (int m = 0; m < 4; ++m) _Pragma("unroll") for (int k = 0; k < 2; ++k) dst[m][k] = *(const LAS bf16x8*)(lds + PG8_SA(b, h) + aoff + m * 2048 + k * 1024); } while (0)
#define PG8_LDB(dst, b, h) do { _Pragma("unroll") for (int n = 0; n < 2; ++n) _Pragma("unroll") for (int k = 0; k < 2; ++k) dst[n][k] = *(const LAS bf16x8*)(lds + PG8_SB(b, h) + boff + n * 2048 + k * 1024); } while (0)
#define PG8_MMA(ai, bj, At, Bt) do { __builtin_amdgcn_s_setprio(1); _Pragma("unroll") for (int m = 0; m < 4; ++m) _Pragma("unroll") for (int n = 0; n < 2; ++n) _Pragma("unroll") for (int k = 0; k < 2; ++k) \
        acc[ai][bj][m][n] = __builtin_amdgcn_mfma_f32_16x16x32_bf16(Bt[n][k], At[m][k], acc[ai][bj][m][n], 0, 0, 0); __builtin_amdgcn_s_setprio(0); } while (0)
#define PG8_WAIT_V(n) asm volatile("s_waitcnt vmcnt(" #n ")" ::: "memory")
#define PG8_WAIT_L(n) asm volatile("s_waitcnt lgkmcnt(" #n ")" ::: "memory")
#define PG8_BAR __builtin_amdgcn_s_barrier()
#define PG8_SCHED __builtin_amdgcn_sched_barrier(0)
    Unit cur, nxt; int ui = 0;
    if (!S.next(0, cur)) return;
    f32x4 acc[2][2][4][2];
    if constexpr (Epi::ACC_INIT) E.init(acc, cur, wr, wc, fr, fq);
    else { float z0_ = 0.f; asm volatile("" : "+v"(z0_));
#pragma unroll
    for (int a = 0; a < 2; ++a)
#pragma unroll
        for (int b = 0; b < 2; ++b)
#pragma unroll
            for (int m = 0; m < 4; ++m)
#pragma unroll
                for (int n = 0; n < 2; ++n) acc[a][b][m][n] = (f32x4){z0_, z0_, z0_, z0_};
    }
    bf16x8 At[4][2], B0[2][2], B1[2][2];
    const char* cA = (const char*)g.A + (size_t)cur.z * g.zA + (size_t)cur.pm * tstepA; const char* cB = (const char*)g.Bt + (size_t)cur.z * g.zB + (size_t)cur.pn * tstepB;
    PG8_STAGE(PG8_SB(0, 0), cB, voffB); PG8_STAGE(PG8_SB(0, 1), cB + hstepB, voffB); PG8_STAGE(PG8_SA(0, 0), cA, voffA); PG8_STAGE(PG8_SA(0, 1), cA + hstepA, voffA);
    if (wr == 1) PG8_BAR;
    PG8_WAIT_V(2); PG8_BAR;
    PG8_STAGE(PG8_SB(1, 0), cB + kstep, voffB); PG8_STAGE(PG8_SA(1, 0), cA + kstep, voffA); PG8_STAGE(PG8_SB(1, 1), cB + hstepB + kstep, voffB);
    PG8_WAIT_V(6); PG8_BAR;
    for (;;) {
        const bool has_next = S.next(ui + 1, nxt);
        const char* nA = has_next ? (const char*)g.A + (size_t)nxt.z * g.zA + (size_t)nxt.pm * tstepA : cA; const char* nB = has_next ? (const char*)g.Bt + (size_t)nxt.z * g.zB + (size_t)nxt.pn * tstepB : cB;
#pragma unroll 1
        for (int t = 0; t < nt; t += 2) {
            const bool last = (t == nt - 2);
            const char* a1 = cA + (size_t)(t + 1) * kstep;
            const char* a2 = last ? nA : cA + (size_t)(t + 2) * kstep; const char* b2 = last ? nB : cB + (size_t)(t + 2) * kstep;
            const char* a3 = a2 + kstep; const char* b3 = b2 + kstep;
            PG8_LDB(B0, 0, 0); PG8_LDB(B1, 0, 1); PG8_SCHED; PG8_LDA(At, 0, 0); PG8_STAGE(PG8_SA(1, 1), a1 + hstepA, voffA);
            PG8_WAIT_V(8); PG8_WAIT_L(0); PG8_BAR;
            if constexpr (Epi::PREF) { if (t == 0) {
                const char* sp_ = (const char*)E.stat_base() + (size_t)cur.pm * 16384 + (size_t)(wid * 2048 + lane * 16);
                __builtin_amdgcn_global_load_lds((const unsigned*)sp_, (LAS unsigned*)(sl + wid * 2048), 16, 0, 0);
                __builtin_amdgcn_global_load_lds((const unsigned*)(sp_ + 1024), (LAS unsigned*)(sl + wid * 2048 + 1024), 16, 0, 0); } }
            PG8_MMA(0, 0, At, B0); PG8_MMA(0, 1, At, B1); PG8_BAR; PG8_SCHED;
            PG8_LDA(At, 0, 1); PG8_STAGE(PG8_SB(0, 0), b2, voffB); PG8_STAGE(PG8_SB(0, 1), b2 + hstepB, voffB); PG8_STAGE(PG8_SA(0, 0), a2, voffA);
            PG8_WAIT_V(8); PG8_WAIT_L(0); PG8_BAR; PG8_MMA(1, 0, At, B0); PG8_MMA(1, 1, At, B1); PG8_BAR; PG8_SCHED;
            PG8_LDB(B0, 1, 0); PG8_LDB(B1, 1, 1); PG8_SCHED; PG8_LDA(At, 1, 0); PG8_STAGE(PG8_SA(0, 1), a2 + hstepA, voffA);
            PG8_WAIT_V(8); PG8_WAIT_L(0); PG8_BAR; PG8_MMA(0, 0, At, B0); PG8_MMA(0, 1, At, B1); PG8_BAR; PG8_SCHED;
            PG8_LDA(At, 1, 1); PG8_STAGE(PG8_SB(1, 0), b3, voffB); PG8_STAGE(PG8_SB(1, 1), b3 + hstepB, voffB); PG8_STAGE(PG8_SA(1, 0), a3, voffA);
            PG8_WAIT_V(8); PG8_WAIT_L(0); PG8_BAR; PG8_MMA(1, 0, At, B0); PG8_MMA(1, 1, At, B1); PG8_BAR; PG8_SCHED;
        }
        if (wr == 0) PG8_BAR;
        E(acc, cur, wr, wc, fr, fq, sl);
        if (!has_next) break;
        if constexpr (Epi::ACC_INIT) E.init(acc, nxt, wr, wc, fr, fq);
        else if (!(Epi::KEEP && nxt.z == 1)) { float z0_ = 0.f; asm volatile("" : "+v"(z0_));
#pragma unroll
        for (int a = 0; a < 2; ++a)
#pragma unroll
            for (int b = 0; b < 2; ++b)
#pragma unroll
                for (int m = 0; m < 4; ++m)
#pragma unroll
                    for (int n = 0; n < 2; ++n) acc[a][b][m][n] = (f32x4){z0_, z0_, z0_, z0_};
        }
        cur = nxt; cA = nA; cB = nB; ++ui;
        if (wr == 1) PG8_BAR;
    }
    PG8_WAIT_V(0);
    PG8_BAR;
#undef PG8_SA
#undef PG8_SB
#undef PG8_STAGE
#undef PG8_LDA
#undef PG8_LDB
#undef PG8_MMA
#undef PG8_WAIT_V
#undef PG8_WAIT_L
#undef PG8_BAR
#undef PG8_SCHED
}
}

typedef f32x4 (&AccRef)[2][2][4][2];

__device__ __forceinline__ float quad_sum(float s) { s += __shfl_xor(s, 16); s += __shfl_xor(s, 32); return s; }
__device__ __forceinline__ float sq4(f32x4 v) { return (v.x * v.x + v.y * v.y) + (v.z * v.z + v.w * v.w); }
__device__ __forceinline__ float sum4(f32x4 v) { return (v.x + v.y) + (v.z + v.w); }
__device__ __forceinline__ u32x4 pack8(f32x4 a, f32x4 b) { u32x4 w; w.x = cvt_pk_bf16(a.x, a.y); w.y = cvt_pk_bf16(a.z, a.w); w.z = cvt_pk_bf16(b.x, b.y); w.w = cvt_pk_bf16(b.z, b.w); return w; }
__device__ __forceinline__ float sigmoidf_(float v) { return __builtin_amdgcn_rcpf(1.0f + __builtin_amdgcn_exp2f(v * (-LOG2E))); }
__device__ __forceinline__ f32x4 sig4(f32x4 v) { return (f32x4){sigmoidf_(v.x), sigmoidf_(v.y), sigmoidf_(v.z), sigmoidf_(v.w)}; }
#define ROWSTAT8(rs, base, inv_n, mul) do { f32x4 pv_[2][4]; \
    _Pragma("unroll") for (int ai = 0; ai < 2; ++ai) _Pragma("unroll") for (int m = 0; m < 4; ++m) pv_[ai][m] = *(const LAS f32x4*)(sl + (ai * 128 + wr * 64 + m * 16 + fr) * 64 + 16 * fq); \
    _Pragma("unroll") for (int ai = 0; ai < 2; ++ai) _Pragma("unroll") for (int m = 0; m < 4; ++m) rs[ai][m] = rsqrtf(quad_sum(sum4(pv_[ai][m])) * (inv_n) + EPS) * (mul); } while (0)

struct EpiIn {
    static constexpr bool PERM = true, ACC_INIT = false, PREF = true, KEEP = false;
    __device__ __forceinline__ const float* stat_base() const { return ssq; }
    const float* ssq; bf16_t* qkva; bf16_t* lat; bf16_t* kvlat; bf16_t* gates; float* lssq; const float* cosA; const float* sinA; float* kbar;
    __device__ __forceinline__ void operator()(AccRef acc, const pg8::Unit& u, int wr, int wc, int fr, int fq, const LAS unsigned char* sl) const {
        const int pn = u.pn;
        float rs[2][4];
        ROWSTAT8(rs, ssq, 1.0f / 1024.0f, 1.0f);
        if (pn < 4) {
            const float sc = (pn < 2) ? C2A : 1.0f;
            f32x4 cs[2][4];
#define ROPE_LOAD(ai, m0) _Pragma("unroll") for (int mm = 0; mm < 2; ++mm) { const size_t ro = (size_t)(u.pm * 256 + (ai) * 128 + wr * 64 + ((m0) + mm) * 16 + fr) * 32 + 8 * fq; \
            cs[mm][0] = *(const GAS f32x4*)(cosA + ro); cs[mm][1] = *(const GAS f32x4*)(cosA + ro + 4); cs[mm][2] = *(const GAS f32x4*)(sinA + ro); cs[mm][3] = *(const GAS f32x4*)(sinA + ro + 4); }
#define ROPE_COMP(ai, m0) _Pragma("unroll") for (int mm = 0; mm < 2; ++mm) { const int m = (m0) + mm; const float r_ = rs[ai][m] * sc; \
            const f32x4 v00 = acc[ai][0][m][0] * r_, v01 = acc[ai][0][m][1] * r_, v10 = acc[ai][1][m][0] * r_, v11 = acc[ai][1][m][1] * r_; \
            acc[ai][0][m][0] = v00 * cs[mm][0] - v10 * cs[mm][2]; acc[ai][0][m][1] = v01 * cs[mm][1] - v11 * cs[mm][3]; acc[ai][1][m][0] = v10 * cs[mm][0] + v00 * cs[mm][2]; acc[ai][1][m][1] = v11 * cs[mm][1] + v01 * cs[mm][3]; }
#define ROPE_STORE(ai, m0) _Pragma("unroll") for (int mm = 0; mm < 2; ++mm) { const int m = (m0) + mm; const int row = u.pm * 256 + (ai) * 128 + wr * 64 + m * 16 + fr; \
            bf16_t* d = qkva + (size_t)row * 1536 + (pn >> 1) * 512 + ((pn & 1) * 4 + wc) * 64 + 8 * fq; \
            *(GAS u32x4*)d = pack8(acc[ai][0][m][0], acc[ai][0][m][1]); *(GAS u32x4*)(d + 32) = pack8(acc[ai][1][m][0], acc[ai][1][m][1]); }
            ROPE_LOAD(0, 0); ROPE_COMP(0, 0); ROPE_LOAD(0, 2); ROPE_STORE(0, 0); ROPE_COMP(0, 2); ROPE_LOAD(1, 0); ROPE_STORE(0, 2); ROPE_COMP(1, 0); ROPE_LOAD(1, 2); ROPE_STORE(1, 0); ROPE_COMP(1, 2); ROPE_STORE(1, 2);
#undef ROPE_LOAD
#undef ROPE_COMP
#undef ROPE_STORE
            if (pn >= 2) {
                f32x4 cs_[2][2];
#pragma unroll
                for (int bj = 0; bj < 2; ++bj)
#pragma unroll
                    for (int n = 0; n < 2; ++n) { f32x4 t = acc[0][bj][0][n];
#pragma unroll
                        for (int m = 1; m < 4; ++m) t = t + acc[0][bj][m][n];
#pragma unroll
                        for (int m = 0; m < 4; ++m) t = t + acc[1][bj][m][n];
#pragma unroll
                        for (int off = 1; off < 16; off <<= 1) { t.x += __shfl_xor(t.x, off); t.y += __shfl_xor(t.y, off); t.z += __shfl_xor(t.z, off); t.w += __shfl_xor(t.w, off); }
                        cs_[bj][n] = t * (1.0f / 256.0f); }
                if (fr == 0) { GAS float* kb_ = (GAS float*)kbar + (size_t)((u.pm >> 3) * 8 + (pn & 1) * 4 + wc) * 512 + (u.pm & 7) * 64 + 8 * fq;
#pragma unroll
                    for (int bj = 0; bj < 2; ++bj)
#pragma unroll
                        for (int n = 0; n < 2; ++n) { GAS float* p_ = kb_ + 32 * bj + 4 * n;
                            __hip_atomic_fetch_add(p_ + 0, cs_[bj][n].x, __ATOMIC_RELAXED, __HIP_MEMORY_SCOPE_AGENT); __hip_atomic_fetch_add(p_ + 1, cs_[bj][n].y, __ATOMIC_RELAXED, __HIP_MEMORY_SCOPE_AGENT);
                            __hip_atomic_fetch_add(p_ + 2, cs_[bj][n].z, __ATOMIC_RELAXED, __HIP_MEMORY_SCOPE_AGENT); __hip_atomic_fetch_add(p_ + 3, cs_[bj][n].w, __ATOMIC_RELAXED, __HIP_MEMORY_SCOPE_AGENT); } }
            }
            return;
        }
#pragma unroll
        for (int ai = 0; ai < 2; ++ai)
#pragma unroll
            for (int m = 0; m < 4; ++m) {
                const int row = u.pm * 256 + ai * 128 + wr * 64 + m * 16 + fr;
                const float r_ = rs[ai][m];
                const f32x4 v00 = acc[ai][0][m][0] * r_, v01 = acc[ai][0][m][1] * r_, v10 = acc[ai][1][m][0] * r_, v11 = acc[ai][1][m][1] * r_;
                if (pn < 6) {
                    bf16_t* d = qkva + (size_t)row * 1536 + pn * 256 + wc * 32 + 8 * fq;
                    *(GAS u32x4*)d = pack8(v00, v01); *(GAS u32x4*)(d + 128) = pack8(v10, v11);
                } else if (pn < 8) {
                    bf16_t* d = lat + (size_t)row * 512 + (pn - 6) * 256 + wc * 32 + 8 * fq;
                    *(GAS u32x4*)d = pack8(v00, v01); *(GAS u32x4*)(d + 128) = pack8(v10, v11);
                    float s = sq4(v00) + sq4(v01); if (pn == 6) s += sq4(v10) + sq4(v11);
                    s = quad_sum(s);
                    if (fq == 0) ((GAS float*)lssq)[(size_t)row * 16 + (pn - 6) * 4 + wc] = s;
                } else if (pn == 8) {
                    bf16_t* d = kvlat + (size_t)row * 256 + wc * 32 + 8 * fq;
                    *(GAS u32x4*)d = pack8(v00, v01); *(GAS u32x4*)(d + 128) = pack8(v10, v11);
                    float s = quad_sum(sq4(v00) + sq4(v01) + sq4(v10) + sq4(v11));
                    if (fq == 0) ((GAS float*)lssq)[(size_t)row * 16 + 8 + wc] = s;
                } else {
                    bf16_t* d = gates + (size_t)row * 2048 + (pn - 9) * 128 + wc * 32 + 8 * fq;
                    const f32x4 sb0 = sig4(v10), sb1 = sig4(v11), sa0 = sig4(v00), sa1 = sig4(v01);
                    const f32x4 r0 = {sa0.x * __builtin_amdgcn_rcpf(sb0.x), sa0.y * __builtin_amdgcn_rcpf(sb0.y), sa0.z * __builtin_amdgcn_rcpf(sb0.z), sa0.w * __builtin_amdgcn_rcpf(sb0.w)};
                    const f32x4 r1 = {sa1.x * __builtin_amdgcn_rcpf(sb1.x), sa1.y * __builtin_amdgcn_rcpf(sb1.y), sa1.z * __builtin_amdgcn_rcpf(sb1.z), sa1.w * __builtin_amdgcn_rcpf(sb1.w)};
                    *(GAS u32x4*)d = pack8(r0, r1); *(GAS u32x4*)(d + 1024) = pack8(sb0, sb1);
                }
            }
    }
};

struct EpiUq {
    static constexpr bool PERM = true, ACC_INIT = false, PREF = true, KEEP = false;
    __device__ __forceinline__ const float* stat_base() const { return lssq; }
    const float* lssq; bf16_t* qb; const float* cosB; const float* sinB;
    __device__ __forceinline__ void operator()(AccRef acc, const pg8::Unit& u, int wr, int wc, int fr, int fq, const LAS unsigned char* sl) const {
        const int pn = u.pn;
        float rs[2][4];
        { f32x4 pv_[2][4];
#pragma unroll
          for (int ai = 0; ai < 2; ++ai)
#pragma unroll
              for (int m = 0; m < 4; ++m) pv_[ai][m] = *(const LAS f32x4*)(sl + (ai * 128 + wr * 64 + m * 16 + fr) * 64 + 16 * (fq & 1));
#pragma unroll
          for (int ai = 0; ai < 2; ++ai)
#pragma unroll
              for (int m = 0; m < 4; ++m) rs[ai][m] = rsqrtf(quad_sum((fq < 2) ? sum4(pv_[ai][m]) : 0.f) * (1.0f / 384.0f) + EPS) * C2B; }
        if (pn == 2) {
            const int head = 2 * wc + (fq >> 1), i0 = 8 * (fq & 1);
            f32x4 cs[2][4];
#define ROPE_LOAD(ai, m0) _Pragma("unroll") for (int mm = 0; mm < 2; ++mm) { const size_t ro = (size_t)(u.pm * 256 + (ai) * 128 + wr * 64 + ((m0) + mm) * 16 + fr) * 16 + i0; \
            cs[mm][0] = *(const GAS f32x4*)(cosB + ro); cs[mm][1] = *(const GAS f32x4*)(cosB + ro + 4); cs[mm][2] = *(const GAS f32x4*)(sinB + ro); cs[mm][3] = *(const GAS f32x4*)(sinB + ro + 4); }
#define ROPE_COMP(ai, m0) _Pragma("unroll") for (int mm = 0; mm < 2; ++mm) { const int m = (m0) + mm; const float r_ = rs[ai][m]; \
            const f32x4 v00 = acc[ai][0][m][0] * r_, v01 = acc[ai][0][m][1] * r_, v10 = acc[ai][1][m][0] * r_, v11 = acc[ai][1][m][1] * r_; \
            acc[ai][0][m][0] = v00 * cs[mm][0] - v10 * cs[mm][2]; acc[ai][0][m][1] = v01 * cs[mm][1] - v11 * cs[mm][3]; acc[ai][1][m][0] = v10 * cs[mm][0] + v00 * cs[mm][2]; acc[ai][1][m][1] = v11 * cs[mm][1] + v01 * cs[mm][3]; }
#define ROPE_STORE(ai, m0) _Pragma("unroll") for (int mm = 0; mm < 2; ++mm) { const int m = (m0) + mm; const int row = u.pm * 256 + (ai) * 128 + wr * 64 + m * 16 + fr; \
            bf16_t* d = qb + (size_t)row * 768 + head * 96 + 64 + i0; \
            *(GAS u32x4*)d = pack8(acc[ai][0][m][0], acc[ai][0][m][1]); *(GAS u32x4*)(d + 16) = pack8(acc[ai][1][m][0], acc[ai][1][m][1]); }
            ROPE_LOAD(0, 0); ROPE_COMP(0, 0); ROPE_LOAD(0, 2); ROPE_STORE(0, 0); ROPE_COMP(0, 2); ROPE_LOAD(1, 0); ROPE_STORE(0, 2); ROPE_COMP(1, 0); ROPE_LOAD(1, 2); ROPE_STORE(1, 0); ROPE_COMP(1, 2); ROPE_STORE(1, 2);
#undef ROPE_LOAD
#undef ROPE_COMP
#undef ROPE_STORE
            return;
        }
#pragma unroll
        for (int ai = 0; ai < 2; ++ai)
#pragma unroll
            for (int m = 0; m < 4; ++m) {
                const int row = u.pm * 256 + ai * 128 + wr * 64 + m * 16 + fr;
                const float r_ = rs[ai][m];
                const int c0 = pn * 256 + wc * 32 + 8 * fq, c1 = c0 + 128;
                *(GAS u32x4*)(qb + (size_t)row * 768 + (c0 >> 6) * 96 + (c0 & 63)) = pack8(acc[ai][0][m][0] * r_, acc[ai][0][m][1] * r_);
                *(GAS u32x4*)(qb + (size_t)row * 768 + (c1 >> 6) * 96 + (c1 & 63)) = pack8(acc[ai][1][m][0] * r_, acc[ai][1][m][1] * r_);
            }
    }
};

template <int MODE> struct EpiRowScale {
    static constexpr bool PERM = true, ACC_INIT = false, PREF = (MODE != 1), KEEP = false;
    __device__ __forceinline__ const float* stat_base() const { return stat; }
    const float* stat; bf16_t* O; int ldc; float cs;
    __device__ __forceinline__ void operator()(AccRef acc, const pg8::Unit& u, int wr, int wc, int fr, int fq, const LAS unsigned char* sl) const {
        float rs[2][4];
        if (MODE == 0) { f32x4 pv_[2][4];
#pragma unroll
            for (int ai = 0; ai < 2; ++ai)
#pragma unroll
                for (int m = 0; m < 4; ++m) pv_[ai][m] = *(const LAS f32x4*)(sl + (ai * 128 + wr * 64 + m * 16 + fr) * 64 + 32);
#pragma unroll
            for (int ai = 0; ai < 2; ++ai)
#pragma unroll
                for (int m = 0; m < 4; ++m) rs[ai][m] = rsqrtf(sum4(pv_[ai][m]) * (1.0f / 256.0f) + EPS);
        } else if (MODE == 1) {
#pragma unroll
            for (int ai = 0; ai < 2; ++ai)
#pragma unroll
                for (int m = 0; m < 4; ++m) rs[ai][m] = ((const GAS float*)stat)[u.pm * 256 + ai * 128 + wr * 64 + m * 16 + fr];
        } else { ROWSTAT8(rs, stat, 1.0f / 1024.0f, cs); }
#pragma unroll
        for (int ai = 0; ai < 2; ++ai)
#pragma unroll
            for (int m = 0; m < 4; ++m) {
                const int row = u.pm * 256 + ai * 128 + wr * 64 + m * 16 + fr;
                const float r_ = rs[ai][m];
                bf16_t* d = O + (size_t)row * ldc + u.pn * 256 + wc * 32 + 8 * fq;
                *(GAS u32x4*)d = pack8(acc[ai][0][m][0] * r_, acc[ai][0][m][1] * r_);
                *(GAS u32x4*)(d + 128) = pack8(acc[ai][1][m][0] * r_, acc[ai][1][m][1] * r_);
            }
    }
};

struct EpiBranchF {
    static constexpr bool PERM = true, ACC_INIT = false, PREF = false, KEEP = true;
    bf16_t* gates;
    __device__ __forceinline__ void operator()(AccRef acc, const pg8::Unit& u, int wr, int wc, int fr, int fq, const LAS unsigned char* sl) const {
        const int zoff = u.z ? 1024 : 0;
        u32x4 gt[4][2];
#define BR_LOAD(ai) _Pragma("unroll") for (int m = 0; m < 4; ++m) _Pragma("unroll") for (int bj = 0; bj < 2; ++bj) \
            gt[m][bj] = *(const GAS u32x4*)(gates + (size_t)(u.pm * 256 + (ai) * 128 + wr * 64 + m * 16 + fr) * 2048 + zoff + u.pn * 256 + bj * 128 + wc * 32 + 8 * fq);
#define BR_COMP(ai) _Pragma("unroll") for (int m = 0; m < 4; ++m) _Pragma("unroll") for (int bj = 0; bj < 2; ++bj) { const u32x4 g = gt[m][bj]; const f32x4 a0 = acc[ai][bj][m][0], a1 = acc[ai][bj][m][1]; \
            acc[ai][bj][m][0] = (f32x4){bflo(g.x) * a0.x, bfhi(g.x) * a0.y, bflo(g.y) * a0.z, bfhi(g.y) * a0.w}; acc[ai][bj][m][1] = (f32x4){bflo(g.z) * a1.x, bfhi(g.z) * a1.y, bflo(g.w) * a1.z, bfhi(g.w) * a1.w}; }
#define BR_STORE(ai) _Pragma("unroll") for (int m = 0; m < 4; ++m) _Pragma("unroll") for (int bj = 0; bj < 2; ++bj) \
            *(GAS u32x4*)(gates + (size_t)(u.pm * 256 + (ai) * 128 + wr * 64 + m * 16 + fr) * 2048 + u.pn * 256 + bj * 128 + wc * 32 + 8 * fq) = pack8(acc[ai][bj][m][0], acc[ai][bj][m][1]);
        BR_LOAD(0); BR_COMP(0); BR_LOAD(1); if (u.z) { BR_STORE(0); } BR_COMP(1); if (u.z) { BR_STORE(1); }
#undef BR_LOAD
#undef BR_COMP
#undef BR_STORE
    }
};

struct EpiRes {
    static constexpr bool PERM = true, ACC_INIT = true, PREF = false, KEEP = false;
    bf16_t* xb; unsigned char* xq; float* ssq;
    __device__ __forceinline__ void init(AccRef acc, const pg8::Unit& u, int wr, int wc, int fr, int fq) const {
        const size_t ubase = (size_t)(u.pm * 256 + wr * 64) * 1024 + u.pn * 256 + wc * 32;
        unsigned loff = (unsigned)(fr * 1024 + 8 * fq);
        asm volatile("" : "+v"(loff));
        const GAS bf16_t* hb = (const GAS bf16_t*)(xb + ubase); const GAS unsigned char* qb_ = (const GAS unsigned char*)(xq + ubase);
#pragma unroll
        for (int ai = 0; ai < 2; ++ai)
#pragma unroll
            for (int m = 0; m < 4; ++m)
#pragma unroll
                for (int bj = 0; bj < 2; ++bj) { const unsigned o = (unsigned)((ai * 128 + m * 16) * 1024 + bj * 128) + loff;
                    const u32x4 h = *(const GAS u32x4*)(hb + o); const u32x2 q = *(const GAS u32x2*)(qb_ + o);
                    xdeq8(h, q, acc[ai][bj][m][0], acc[ai][bj][m][1]); }
    }
    __device__ __forceinline__ void operator()(AccRef acc, const pg8::Unit& u, int wr, int wc, int fr, int fq, const LAS unsigned char* sl) const {
        const size_t ubase = (size_t)(u.pm * 256 + wr * 64) * 1024 + u.pn * 256 + wc * 32;
        unsigned loff = (unsigned)(fr * 1024 + 8 * fq);
        asm volatile("" : "+v"(loff));
        GAS bf16_t* hb = (GAS bf16_t*)(xb + ubase); GAS unsigned char* qb_ = (GAS unsigned char*)(xq + ubase);
#pragma unroll
        for (int ai = 0; ai < 2; ++ai)
#pragma unroll
            for (int m = 0; m < 4; ++m) { float s = 0.f;
#pragma unroll
                for (int bj = 0; bj < 2; ++bj) { const unsigned o = (unsigned)((ai * 128 + m * 16) * 1024 + bj * 128) + loff;
                    const f32x4 v0 = acc[ai][bj][m][0], v1 = acc[ai][bj][m][1];
                    const u32x4 h = pack8(v0, v1); u32x2 q; q.x = xquant4(v0, h.x, h.y); q.y = xquant4(v1, h.z, h.w);
                    *(GAS u32x4*)(hb + o) = h; *(GAS u32x2*)(qb_ + o) = q; s += sq4(v0) + sq4(v1); }
                s = quad_sum(s); if (fq == 0) ((GAS float*)ssq)[(size_t)(u.pm * 256 + ai * 128 + wr * 64 + m * 16 + fr) * 16 + u.pn * 4 + wc] = s; }
    }
};

struct EpiNull {
    static constexpr bool PERM = true, ACC_INIT = false, PREF = false, KEEP = false;
    __device__ __forceinline__ void operator()(AccRef acc, const pg8::Unit& u, int wr, int wc, int fr, int fq, const LAS unsigned char* sl) const {
#pragma unroll
        for (int ai = 0; ai < 2; ++ai)
#pragma unroll
            for (int bj = 0; bj < 2; ++bj)
#pragma unroll
                for (int m = 0; m < 4; ++m)
#pragma unroll
                    for (int n = 0; n < 2; ++n) asm volatile("" :: "v"(acc[ai][bj][m][n]));
    }
};
struct EpiGU {
    static constexpr bool PERM = true, ACC_INIT = false, PREF = true, KEEP = false;
    __device__ __forceinline__ const float* stat_base() const { return ssq; }
    const float* ssq; bf16_t* act;
    __device__ __forceinline__ void operator()(AccRef acc, const pg8::Unit& u, int wr, int wc, int fr, int fq, const LAS unsigned char* sl) const {
        float rs[2][4];
        ROWSTAT8(rs, ssq, 1.0f / 1024.0f, 1.0f);
#pragma unroll
        for (int ai = 0; ai < 2; ++ai)
#pragma unroll
            for (int m = 0; m < 4; ++m) {
                const int row = u.pm * 256 + ai * 128 + wr * 64 + m * 16 + fr;
                const float r_ = rs[ai][m];
                const f32x4 g0 = acc[ai][0][m][0] * r_, g1 = acc[ai][0][m][1] * r_, u0 = acc[ai][1][m][0] * r_, u1 = acc[ai][1][m][1] * r_;
                const f32x4 a0 = g0 * sig4(g0) * u0, a1 = g1 * sig4(g1) * u1;
                *(GAS u32x4*)(act + (size_t)row * DFF + u.pn * 128 + wc * 32 + 8 * fq) = pack8(a0, a1);
            }
    }
};

typedef short v4i16_t __attribute__((ext_vector_type(4)));
__device__ __forceinline__ v4i16_t vtr(const LAS unsigned char* p) { return __builtin_amdgcn_ds_read_tr16_b64_v4i16((LAS v4i16_t*)p); }
template <int DQK, int DV, int MODE>
__device__ __forceinline__ void attn_unit(LAS unsigned char* lds, const int tid, const bf16_t* Qg, int ldq, const bf16_t* Kg, int ldk, const bf16_t* K2g,
                                          const bf16_t* Vg, int ldv, bf16_t* Og, int ldo, int qbase, int NT, const float* kbar, int cur) {
    constexpr int KS = DQK + 8;
    constexpr int KBUF = 64 * KS * 2, VBUF = (DV / 32) * 4096;
    constexpr int KMAIN = (MODE == 1) ? 64 : DQK;
    constexpr int KCH = KMAIN / 8, NK = (64 * KCH) / 512, VCH = DV / 8, NV = (64 * VCH) / 512;
    constexpr int NJ = DQK / 16, ND = DV / 32;
    constexpr float THR = 8.0f;
    const int lane = tid & 63, wid = __builtin_amdgcn_readfirstlane(tid >> 6), r32 = lane & 31, hi = lane >> 5;
    bf16x8 qf[NJ];
    { const bf16_t* qrow = Qg + (size_t)(wid * 32 + r32) * ldq + 8 * hi;
#pragma unroll
      for (int j = 0; j < NJ; ++j) qf[j] = *(const GAS bf16x8*)(qrow + 16 * j); }
    unsigned selmask = 0xffu;
    if (MODE == 0 && cur > 3) {
        float g[7];
#pragma unroll
        for (int j = 0; j < 7; ++j) {
            float a = 0.f;
            if (j < cur) {
#pragma unroll
                for (int jj = 0; jj < 4; ++jj) {
                    const f32x4 k0 = *(const GAS f32x4*)(kbar + j * 64 + 16 * jj + 8 * hi), k1 = *(const GAS f32x4*)(kbar + j * 64 + 16 * jj + 8 * hi + 4);
                    a += bf2f((unsigned short)qf[jj][0]) * k0.x + bf2f((unsigned short)qf[jj][1]) * k0.y + bf2f((unsigned short)qf[jj][2]) * k0.z + bf2f((unsigned short)qf[jj][3]) * k0.w
                       + bf2f((unsigned short)qf[jj][4]) * k1.x + bf2f((unsigned short)qf[jj][5]) * k1.y + bf2f((unsigned short)qf[jj][6]) * k1.z + bf2f((unsigned short)qf[jj][7]) * k1.w;
                }
                a += __shfl_xor(a, 32);
            }
            g[j] = a;
        }
        unsigned sm = 0u;
#pragma unroll
        for (int j = 0; j < 7; ++j) {
            int rank = 0;
#pragma unroll
            for (int i = 0; i < 7; ++i) if (i != j) rank += (i < cur && (g[i] > g[j] || (g[i] == g[j] && i < j))) ? 1 : 0;
            if (j < cur && rank < 3) sm |= (1u << j);
        }
        selmask = sm | (1u << cur);
    }
    u32x4 kreg[NK], vreg[NV], k2reg = {0u, 0u, 0u, 0u};
#define ATT_LOAD(t) do { \
    _Pragma("unroll") for (int i = 0; i < NK; ++i) { const int idx = tid + 512 * i, kv = idx / KCH, c = idx % KCH; kreg[i] = *(const GAS u32x4*)(Kg + (size_t)(64 * (t) + kv) * ldk + 8 * c); } \
    if (MODE == 1) { if (tid < 256) k2reg = *(const GAS u32x4*)(K2g + (size_t)(64 * (t) + (tid >> 2)) * 32 + 8 * (tid & 3)); } \
    _Pragma("unroll") for (int i = 0; i < NV; ++i) { const int idx = tid + 512 * i, kv = idx / VCH, c = idx % VCH; vreg[i] = *(const GAS u32x4*)(Vg + (size_t)(64 * (t) + kv) * ldv + 8 * c); } } while (0)
#define ATT_STORE(buf) do { LAS unsigned char* kb_ = lds + (buf) * KBUF; LAS unsigned char* vb_ = lds + 2 * KBUF + (buf) * VBUF; \
    _Pragma("unroll") for (int i = 0; i < NK; ++i) { const int idx = tid + 512 * i, kv = idx / KCH, c = idx % KCH; *(LAS u32x4*)(kb_ + (kv * KS + 8 * c) * 2) = kreg[i]; } \
    if (MODE == 1) { if (tid < 256) *(LAS u32x4*)(kb_ + ((tid >> 2) * KS + 64 + 8 * (tid & 3)) * 2) = k2reg; } \
    _Pragma("unroll") for (int i = 0; i < NV; ++i) { const int idx = tid + 512 * i, kv = idx / VCH, c = idx % VCH; *(LAS u32x4*)(vb_ + (c >> 2) * 4096 + kv * 64 + (c & 3) * 16) = vreg[i]; } } while (0)
    ATT_LOAD(0); ATT_STORE(0);
    __syncthreads();
    f32x16 o[ND];
#pragma unroll
    for (int d0 = 0; d0 < ND; ++d0)
#pragma unroll
        for (int r = 0; r < 16; ++r) o[d0][r] = 0.f;
    f32x16 negm;
#pragma unroll
    for (int r = 0; r < 16; ++r) negm[r] = 0.f;
    float mref = 0.f, lrun = 0.f;
    const int qabs = qbase + wid * 32 + r32;
    const int qwmax = qbase + wid * 32 + 31;
    const int vlane = (4 * hi + ((lane & 15) >> 2)) * 64 + ((lane >> 4) & 1) * 32 + (lane & 3) * 8;
    for (int t = 0; t < NT; ++t) {
        const int buf = t & 1;
        if (t + 1 < NT) ATT_LOAD(t + 1);
        bool lane_ok = true, causal = false, active = true;
        if (MODE == 0) { const int blk = t >> 2; if (blk < cur) lane_ok = ((selmask >> blk) & 1u) != 0u; else causal = (64 * t + 63 > qbase + wid * 32); active = (__any(lane_ok ? 1 : 0) != 0) && (64 * t <= qwmax); }
        if (MODE == 1) { causal = (64 * t + 63 > qbase + wid * 32); active = (64 * t <= qwmax); }
        if (active) {
            const LAS unsigned char* kb = lds + buf * KBUF + (r32 * KS + 8 * hi) * 2;
            f32x16 s0 = negm, s1 = negm;
#pragma unroll
            for (int j = 0; j < NJ; ++j) {
                const bf16x8 k0 = *(const LAS bf16x8*)(kb + j * 32), k1 = *(const LAS bf16x8*)(kb + 32 * KS * 2 + j * 32);
                s0 = __builtin_amdgcn_mfma_f32_32x32x16_bf16(k0, qf[j], s0, 0, 0, 0);
                s1 = __builtin_amdgcn_mfma_f32_32x32x16_bf16(k1, qf[j], s1, 0, 0, 0);
            }
            if (MODE != 2) {
                if (!lane_ok) {
#pragma unroll
                    for (int r = 0; r < 16; ++r) { s0[r] = -INFINITY; s1[r] = -INFINITY; }
                } else if (causal) {
                    const int kb0 = 64 * t + 4 * hi;
#pragma unroll
                    for (int r = 0; r < 16; ++r) { const int kv = kb0 + (r & 3) + 8 * (r >> 2); if (kv > qabs) s0[r] = -INFINITY; if (kv + 32 > qabs) s1[r] = -INFINITY; }
                }
            }
            float mxa = fmaxf(fmaxf(s0[0], s0[1]), s1[0]), mxb = fmaxf(fmaxf(s0[2], s0[3]), s1[1]);
            mxa = fmaxf(fmaxf(mxa, s1[2]), s1[3]);
#pragma unroll
            for (int r = 4; r < 16; r += 4) { mxa = fmaxf(fmaxf(mxa, s0[r]), s0[r + 1]); mxb = fmaxf(fmaxf(mxb, s0[r + 2]), s0[r + 3]); mxa = fmaxf(fmaxf(mxa, s1[r]), s1[r + 1]); mxb = fmaxf(fmaxf(mxb, s1[r + 2]), s1[r + 3]); }
            float mx = fmaxf(mxa, mxb);
            mx = fmaxf(mx, __shfl_xor(mx, 32));
            if (__any(mx > THR ? 1 : 0)) {
                const float dl = (mx > THR) ? mx : 0.f;
                mref += dl;
#pragma unroll
                for (int r = 0; r < 16; ++r) { s0[r] -= dl; s1[r] -= dl; negm[r] = -mref; }
                const float alpha = __builtin_amdgcn_exp2f(-dl);
                lrun *= alpha;
#pragma unroll
                for (int d0 = 0; d0 < ND; ++d0)
#pragma unroll
                    for (int r = 0; r < 16; ++r) o[d0][r] *= alpha;
            }
            float psa = 0.f, psb = 0.f;
#pragma unroll
            for (int r = 0; r < 16; ++r) { s0[r] = __builtin_amdgcn_exp2f(s0[r]); s1[r] = __builtin_amdgcn_exp2f(s1[r]); psa += s0[r]; psb += s1[r]; }
            lrun += psa + psb;
            bf16x8 pb[4];
            { u32x4 w;
              w.x = cvt_pk_bf16(s0[0], s0[1]); w.y = cvt_pk_bf16(s0[2], s0[3]); w.z = cvt_pk_bf16(s0[4], s0[5]); w.w = cvt_pk_bf16(s0[6], s0[7]); pb[0] = __builtin_bit_cast(bf16x8, w);
              w.x = cvt_pk_bf16(s0[8], s0[9]); w.y = cvt_pk_bf16(s0[10], s0[11]); w.z = cvt_pk_bf16(s0[12], s0[13]); w.w = cvt_pk_bf16(s0[14], s0[15]); pb[1] = __builtin_bit_cast(bf16x8, w);
              w.x = cvt_pk_bf16(s1[0], s1[1]); w.y = cvt_pk_bf16(s1[2], s1[3]); w.z = cvt_pk_bf16(s1[4], s1[5]); w.w = cvt_pk_bf16(s1[6], s1[7]); pb[2] = __builtin_bit_cast(bf16x8, w);
              w.x = cvt_pk_bf16(s1[8], s1[9]); w.y = cvt_pk_bf16(s1[10], s1[11]); w.z = cvt_pk_bf16(s1[12], s1[13]); w.w = cvt_pk_bf16(s1[14], s1[15]); pb[3] = __builtin_bit_cast(bf16x8, w); }
            const LAS unsigned char* vb = lds + 2 * KBUF + buf * VBUF + vlane;
#pragma unroll
            for (int d0 = 0; d0 < ND; ++d0)
#pragma unroll
                for (int kk = 0; kk < 4; ++kk) {
                    const v4i16_t a = vtr(vb + d0 * 4096 + kk * 1024), b = vtr(vb + d0 * 4096 + kk * 1024 + 512);
                    const bf16x8 vf = {a[0], a[1], a[2], a[3], b[0], b[1], b[2], b[3]};
                    o[d0] = __builtin_amdgcn_mfma_f32_32x32x16_bf16(vf, pb[kk], o[d0], 0, 0, 0);
                }
        }
        if (t + 1 < NT) ATT_STORE(buf ^ 1);
        __syncthreads();
    }
#undef ATT_LOAD
#undef ATT_STORE
    lrun += __shfl_xor(lrun, 32);
    const float inv = 1.0f / lrun;
    bf16_t* orow = Og + (size_t)(wid * 32 + r32) * ldo + 4 * hi;
#pragma unroll
    for (int d0 = 0; d0 < ND; ++d0)
#pragma unroll
        for (int rg = 0; rg < 4; ++rg) {
            u32x2 w; w.x = cvt_pk_bf16(o[d0][4 * rg] * inv, o[d0][4 * rg + 1] * inv); w.y = cvt_pk_bf16(o[d0][4 * rg + 2] * inv, o[d0][4 * rg + 3] * inv);
            *(GAS u32x2*)(orow + 32 * d0 + 8 * rg) = w;
        }
}

__device__ __forceinline__ float wave_sum(float v) {
#pragma unroll
    for (int o = 1; o < 64; o <<= 1) v += __shfl_xor(v, o);
    return v;
}
template <class MapFn>
__device__ __forceinline__ void transpose_item(const float* W, int K, int N, bf16_t* WT, const float* gain, LAS float* scr, int item, int lane, MapFn map) {
    const int nblk = N / 32, kb = item / nblk, nb = item % nblk, k0 = 64 * kb, n0 = 32 * nb;
    f32x4 w[8]; float gv[8];
#pragma unroll
    for (int i = 0; i < 8; ++i) { const int kk = 8 * i + (lane >> 3); w[i] = *(const GAS f32x4*)(W + (size_t)(k0 + kk) * N + n0 + 4 * (lane & 7)); gv[i] = gain ? ((const GAS float*)gain)[k0 + kk] : 1.0f; }
#pragma unroll
    for (int i = 0; i < 8; ++i) { const int kk = 8 * i + (lane >> 3); LAS float* d = scr + kk * 33 + 4 * (lane & 7); const f32x4 v = w[i] * gv[i]; d[0] = v.x; d[1] = v.y; d[2] = v.z; d[3] = v.w; }
    asm volatile("s_waitcnt lgkmcnt(0)" ::: "memory");
    const int c = lane & 7;
#pragma unroll
    for (int j = 0; j < 4; ++j) { const int n = (lane >> 3) + 8 * j; const LAS float* s = scr + (8 * c) * 33 + n;
        u32x4 o; o.x = cvt_pk_bf16(s[0 * 33], s[1 * 33]); o.y = cvt_pk_bf16(s[2 * 33], s[3 * 33]); o.z = cvt_pk_bf16(s[4 * 33], s[5 * 33]); o.w = cvt_pk_bf16(s[6 * 33], s[7 * 33]);
        *(GAS u32x4*)(WT + (size_t)map(n0 + n) * K + k0 + 8 * c) = o; }
    asm volatile("s_waitcnt lgkmcnt(0)" ::: "memory");
}
__device__ __forceinline__ int map_in(int n) {
    if (n < 1024) { const int base = n & 512, mm = n & 511, head = mm >> 6, e = mm & 63; return base + 256 * (head >> 2) + 128 * (e >> 5) + 32 * (head & 3) + (e & 31); }
    if (n < 1920) return n;
    if (n < 2176) return 2048 + (n - 1920);
    if (n < 2208) return 1920 + (n - 2176);
    { const int a = (n - 2208) & 1023, gb = (n - 2208) >> 10; return 2304 + 256 * (a >> 7) + 128 * gb + (a & 127); }
}
__device__ __forceinline__ int map_uq(int n) { const int head = n / 96, e = n % 96; if (e < 64) return 64 * head + e; const int r = e - 64; return 512 + 128 * (r >> 4) + 16 * head + (r & 15); }
__device__ __forceinline__ int map_gu(int n) { if (n < DFF) return 256 * (n >> 7) + (n & 127); const int a = n - DFF; return 256 * (a >> 7) + 128 + (a & 127); }
__device__ __forceinline__ int map_id(int n) { return n; }

#define XB_TMO      128
#define XB_XCNT(j)  (256  + 64 * (j))
#define XB_XSUB(j)  (1280 + 64 * (j))
#define XB_XGEN(j)  (2304 + 64 * (j))
#define XB_TOP      3328
#define XB_TOPGEN   3392
#define XCD_BAR_WORDS 3456
#define XB_SPIN_CAP (1u << 18)
__device__ __forceinline__ unsigned xb_ld(unsigned* p)              { return __hip_atomic_load(p, __ATOMIC_RELAXED, __HIP_MEMORY_SCOPE_AGENT); }
__device__ __forceinline__ unsigned xb_add(unsigned* p, unsigned v) { return __hip_atomic_fetch_add(p, v, __ATOMIC_RELAXED, __HIP_MEMORY_SCOPE_AGENT); }
__device__ __forceinline__ unsigned xb_xcc_id() { return (unsigned)__builtin_amdgcn_s_getreg((3 << 11) | 20) & 0xFu; }
#define XB_SPIN(cond, bar) do { unsigned _sp = 0; while (cond) { __builtin_amdgcn_s_sleep(1); \
    if ((++_sp & 255u) == 0u) { if (xb_ld(&(bar)[XB_TMO])) break; if (_sp > XB_SPIN_CAP) { atomicAdd(&(bar)[XB_TMO], 1u); break; } } } } while (0)
struct XcdBarrier { unsigned* bar; unsigned x; volatile LAS unsigned* st; };
__device__ __forceinline__ XcdBarrier xcd_barrier_post(unsigned* bar, volatile LAS unsigned* st) {
    XcdBarrier b; b.bar = bar; b.x = xb_xcc_id(); b.st = st;
    if (threadIdx.x == 0) (void)xb_add(&bar[XB_XCNT(b.x)], 1u);
    return b;
}
__device__ __forceinline__ void xcd_barrier_complete(unsigned* bar, unsigned x, unsigned& nloc, unsigned& nx) {
    const unsigned G = gridDim.x * gridDim.y * gridDim.z;
    unsigned sum, cnt, mine, sp = 0u;
    for (;;) {
        sum = 0u; cnt = 0u; mine = 0u;
#pragma unroll
        for (unsigned j = 0; j < 16; ++j) { const unsigned c = xb_ld(&bar[XB_XCNT(j)]); sum += c; cnt += (c > 0u) ? 1u : 0u; mine = (j == x) ? c : mine; }
        if (sum == G) break;
        __builtin_amdgcn_s_sleep(1);
        if ((++sp & 255u) == 0u) { if (xb_ld(&bar[XB_TMO])) break; if (sp > XB_SPIN_CAP) { atomicAdd(&bar[XB_TMO], 1u); break; } }
    }
    nloc = mine > 0u ? mine : 1u; nx = cnt > 0u ? cnt : 1u;
}
__device__ __forceinline__ void xcd_barrier(const XcdBarrier& b) {
    asm volatile("s_waitcnt vmcnt(0)" ::: "memory");
    __syncthreads();
    if (threadIdx.x == 0) {
        unsigned* bar = b.bar;
        __builtin_amdgcn_s_waitcnt(0);
        unsigned nloc = b.st[0], nx = b.st[1];
        if (nloc == 0u) { xcd_barrier_complete(bar, b.x, nloc, nx); b.st[0] = nloc; b.st[1] = nx; }
        const unsigned old = xb_add(&bar[XB_XSUB(b.x)], 1u);
        const unsigned gen = old / nloc;
        if (old + 1u == (gen + 1u) * nloc) {
            __builtin_amdgcn_fence(__ATOMIC_RELEASE, "agent");
            asm volatile("s_waitcnt vmcnt(0)" ::: "memory");
            const unsigned og = xb_add(&bar[XB_TOP], 1u);
            const unsigned tg = og / nx;
            if (og + 1u == (tg + 1u) * nx) xb_add(&bar[XB_TOPGEN], 1u);
            else XB_SPIN(xb_ld(&bar[XB_TOPGEN]) == tg, bar);
            __builtin_amdgcn_fence(__ATOMIC_ACQUIRE, "agent");
            xb_add(&bar[XB_XGEN(b.x)], 1u);
            asm volatile("s_waitcnt vmcnt(0)" ::: "memory");
        } else {
            XB_SPIN(xb_ld(&bar[XB_XGEN(b.x)]) == gen, bar);
            __builtin_amdgcn_fence(__ATOMIC_ACQUIRE, "agent");
            asm volatile("s_waitcnt vmcnt(0)" ::: "memory");
        }
    }
    __syncthreads();
}

struct Args {
    const float* x; const float* mem; const int* pos;
    const float* norm_mix; const float* w_in; const float* q_lat_norm; const float* w_uq; const float* kv_lat_norm; const float* w_ukv;
    const float* w_ba; const float* w_bb; const float* w_out; const float* norm_x; const float* norm_mem; const float* w_xq; const float* w_xkv; const float* w_xo;
    const float* norm_ffn; const float* w_gu; const float* w_dn; const float* norm_final;
    float* out; unsigned char* ws; int ph_lo, ph_hi;
};

constexpr int PH_PER_LAYER = 11, N_PHASES = DEPTH * PH_PER_LAYER + 1;
constexpr int LDS_TOTAL = pg8::STAGE_BYTES + 16384;

__global__ void __launch_bounds__(512, 2) fwd_kernel(Args a_in) {
    __shared__ __attribute__((aligned(16))) unsigned char lds_raw[LDS_TOTAL];
    LAS unsigned char* lds = (LAS unsigned char*)lds_raw;
    const int ph_lo = a_in.ph_lo, ph_hi = a_in.ph_hi;
    __shared__ __attribute__((aligned(16))) unsigned bar_st[4];
    __shared__ unsigned long long tacc[2];
    if (threadIdx.x == 0) { tacc[0] = 0ull; tacc[1] = 0ull; }
    if (threadIdx.x < 4) bar_st[threadIdx.x] = 0u;
    __syncthreads();
    XcdBarrier bar; bar.bar = (unsigned*)(a_in.ws + WS_CTL); bar.x = 0; bar.st = (volatile LAS unsigned*)bar_st;
    if (ph_hi - ph_lo > 1) bar = xcd_barrier_post((unsigned*)(a_in.ws + WS_CTL), (volatile LAS unsigned*)bar_st);
    for (int ph = ph_lo; ph < ph_hi; ++ph) {
        if (ph > ph_lo) { if (ph == ph_lo + 1) cg::this_grid().sync(); else xcd_barrier(bar); if (XSYNC) { xcd_barrier(bar); xcd_barrier(bar); } }
        if (TPROBE >= 0 && blockIdx.x == 0 && threadIdx.x == 0) {
            const unsigned long long now = __builtin_amdgcn_s_memrealtime();
            const int pprev = (ph - 1 < 0) ? -1 : ((ph - 1 == N_PHASES - 1) ? 11 : (ph - 1) % PH_PER_LAYER), pcur = (ph == N_PHASES - 1) ? 11 : ph % PH_PER_LAYER;
            if (pprev == TPROBE) tacc[0] += now - tacc[1];
            if (pcur == TPROBE) tacc[1] = now;
        }
        int tid = threadIdx.x; asm volatile("" : "+v"(tid));
        int G = gridDim.x, bx = blockIdx.x; asm volatile("" : "+s"(G), "+s"(bx));
        const int lane = tid & 63, wave = __builtin_amdgcn_readfirstlane(tid >> 6);
        const int vcu = (G % 8 == 0) ? (bx % 8) * (G / 8) + bx / 8 : bx;
        const int gw = vcu * 8 + wave, NGW = G * 8;
        const __attribute__((address_space(4))) Args* ap = (const __attribute__((address_space(4))) Args*)__builtin_amdgcn_kernarg_segment_ptr(); asm volatile("" : "+s"(ap));
        const __attribute__((address_space(4))) Args& a = *ap;
        unsigned char* ws = a.ws; float* aout = a.out; const float* ax = a.x;
        asm volatile("" : "+s"(ws), "+s"(aout), "+s"(ax));
        bf16_t* Win_t = (bf16_t*)(ws + WS_WIN); bf16_t* Wuq_t = (bf16_t*)(ws + WS_WUQ); bf16_t* Wukv_t = (bf16_t*)(ws + WS_WUKV);
        bf16_t* Wba_t = (bf16_t*)(ws + WS_WBA); bf16_t* Wbb_t = (bf16_t*)(ws + WS_WBB); bf16_t* Wout_t = (bf16_t*)(ws + WS_WOUT);
        bf16_t* Wxq_t = (bf16_t*)(ws + WS_WXQ); bf16_t* Wxkv_t = (bf16_t*)(ws + WS_WXKV); bf16_t* Wxo_t = (bf16_t*)(ws + WS_WXO);
        bf16_t* Wgu_t = (bf16_t*)(ws + WS_WGU); bf16_t* Wdn_t = (bf16_t*)(ws + WS_WDN);
        bf16_t* XB = (bf16_t*)(ws + WS_XB); bf16_t* QB = (bf16_t*)aout;
        bf16_t* QKVA = (bf16_t*)(ws + WS_QKVA); bf16_t* QX = (bf16_t*)(ws + WS_QKVA);
        bf16_t* LAT = (bf16_t*)(ws + WS_LAT); bf16_t* OAB = (bf16_t*)((unsigned char*)aout + 64 * MiB);
        bf16_t* KVLAT = (bf16_t*)(ws + WS_KVLAT); bf16_t* GATES = (bf16_t*)(ws + WS_GATES); bf16_t* ACT = (bf16_t*)(ws + WS_ACT);
        bf16_t* KVB = (bf16_t*)(ws + WS_KVB); bf16_t* KVX = (bf16_t*)(ws + WS_KVX); bf16_t* MEMB = (bf16_t*)(ws + WS_MEMB); bf16_t* KPE = (bf16_t*)(ws + WS_KPE);
        float* COSA = (float*)(ws + WS_COSA); float* SINA = (float*)(ws + WS_SINA); float* COSB = (float*)(ws + WS_COSB); float* SINB = (float*)(ws + WS_SINB);
        unsigned char* XQ = ws + WS_XQ; float* SSQ = (float*)(ws + WS_SSQ); float* LSSQ = (float*)(ws + WS_LSSQ); float* RSTDM = (float*)(ws + WS_RSTDM); float* KBAR = (float*)(ws + WS_KBAR);

        if (ph == N_PHASES - 1) {
            if (!PHON(11)) continue;
            for (int row = gw; row < M; row += NGW) {
                const f32x4* sp = (const f32x4*)(SSQ + (size_t)row * 16);
                const f32x4 p0 = sp[0], p1 = sp[1], p2 = sp[2], p3 = sp[3];
                const float s = ((p0.x + p0.y) + (p0.z + p0.w)) + ((p1.x + p1.y) + (p1.z + p1.w)) + ((p2.x + p2.y) + (p2.z + p2.w)) + ((p3.x + p3.y) + (p3.z + p3.w));
                const float rs = rsqrtf(s * (1.0f / 1024.0f) + EPS);
                GAS f32x4* xr = (GAS f32x4*)(aout + (size_t)row * DM) + lane; const GAS f32x4* gr = (const GAS f32x4*)a.norm_final + lane;
                const GAS u32x2* hr = (const GAS u32x2*)(XB + (size_t)row * DM) + lane; const GAS unsigned* qr = (const GAS unsigned*)(XQ + (size_t)row * DM) + lane;
#pragma unroll
                for (int j = 0; j < 4; ++j) { const u32x2 h = hr[64 * j]; const unsigned q = qr[64 * j]; const f32x4 g = gr[64 * j]; f32x4 v;
                    v.x = xdeq(h.x & 0xffffu, bflo(h.x), (int)(q << 24) >> 24); v.y = xdeq(h.x >> 16, bfhi(h.x), (int)(q << 16) >> 24);
                    v.z = xdeq(h.y & 0xffffu, bflo(h.y), (int)(q << 8) >> 24); v.w = xdeq(h.y >> 16, bfhi(h.y), (int)q >> 24);
                    xr[64 * j] = v * rs * g; }
            }
            continue;
        }
        const int l = ph / PH_PER_LAYER, p = ph % PH_PER_LAYER;
        if (STAG > 0 && (p == 5 || p == 8 || p == 10)) {
            const unsigned long long t0 = __builtin_amdgcn_s_memrealtime(); const unsigned long long dl = (unsigned long long)((vcu & 3) * STAG);
            while (__builtin_amdgcn_s_memrealtime() - t0 < dl) __builtin_amdgcn_s_sleep(8);
        }
        const float* xin = (l == 0 && p == 5) ? ax : aout;
        if (!PHON(p)) continue;
        if (p == 0) {
            LAS float* scr = (LAS float*)(lds + wave * 16384);
            constexpr int I_IN = 16 * (IN_W / 32), I_UQ = 6 * 24, I_UKV = 4 * 32, I_BA = 8 * 32, I_OUT = 16 * 32, I_XQ = 16 * 16, I_XKV = 16 * 32, I_XO = 8 * 32, I_GU = 16 * (2 * DFF / 32), I_DN = (DFF / 64) * 32;
            constexpr int NIT = I_IN + I_UQ + I_UKV + 2 * I_BA + I_OUT + I_XQ + I_XKV + I_XO + I_GU + I_DN;
            for (int rep = 0; rep < 1 + DUP(0); ++rep)
            for (int it = gw; it < NIT; it += NGW) {
                int r = it;
                if (r < I_IN) { transpose_item(a.w_in + (size_t)l * DM * IN_W, DM, IN_W, Win_t, a.norm_mix + l * DM, scr, r, lane, map_in); continue; } r -= I_IN;
                if (r < I_UQ) { transpose_item(a.w_uq + (size_t)l * 384 * 768, 384, 768, Wuq_t, a.q_lat_norm + l * 384, scr, r, lane, map_uq); continue; } r -= I_UQ;
                if (r < I_UKV) { transpose_item(a.w_ukv + (size_t)l * 256 * 1024, 256, 1024, Wukv_t, a.kv_lat_norm + l * 256, scr, r, lane, map_id); continue; } r -= I_UKV;
                if (r < I_BA) { transpose_item(a.w_ba + (size_t)l * 512 * 1024, 512, 1024, Wba_t, nullptr, scr, r, lane, map_id); continue; } r -= I_BA;
                if (r < I_BA) { transpose_item(a.w_bb + (size_t)l * 512 * 1024, 512, 1024, Wbb_t, nullptr, scr, r, lane, map_id); continue; } r -= I_BA;
                if (r < I_OUT) { transpose_item(a.w_out + (size_t)l * 1024 * 1024, 1024, 1024, Wout_t, nullptr, scr, r, lane, map_id); continue; } r -= I_OUT;
                if (r < I_XQ) { transpose_item(a.w_xq + (size_t)l * 1024 * 512, 1024, 512, Wxq_t, a.norm_x + l * DM, scr, r, lane, map_id); continue; } r -= I_XQ;
                if (r < I_XKV) { transpose_item(a.w_xkv + (size_t)l * 1024 * 1024, 1024, 1024, Wxkv_t, a.norm_mem + l * DM, scr, r, lane, map_id); continue; } r -= I_XKV;
                if (r < I_XO) { transpose_item(a.w_xo + (size_t)l * 512 * 1024, 512, 1024, Wxo_t, nullptr, scr, r, lane, map_id); continue; } r -= I_XO;
                if (r < I_GU) { transpose_item(a.w_gu + (size_t)l * 1024 * 2 * DFF, 1024, 2 * DFF, Wgu_t, a.norm_ffn + l * DM, scr, r, lane, map_gu); continue; } r -= I_GU;
                transpose_item(a.w_dn + (size_t)l * DFF * 1024, DFF, 1024, Wdn_t, nullptr, scr, r, lane, map_id);
            }
            for (int i = vcu * 512 + tid; i < 128 * 8 * 64; i += G * 512) ((GAS float*)KBAR)[i] = 0.f;
            for (int i = vcu * 512 + tid; i < 96 * 1024 / 8; i += G * 512) *(GAS u32x4*)(Win_t + (size_t)1952 * 1024 + (size_t)i * 8) = (u32x4){0u, 0u, 0u, 0u};
            if (l == 0) {
                for (int row = gw; row < M + MM; row += NGW) {
                    const bool ism = row >= M; const int r = ism ? row - M : row;
                    const f32x4* xr = (const f32x4*)((ism ? a.mem : ax) + (size_t)r * DM) + lane;
                    f32x4 v[4]; float s = 0.f;
#pragma unroll
                    for (int j = 0; j < 4; ++j) { v[j] = xr[64 * j]; s += sq4(v[j]); }
                    s = wave_sum(s);
                    GAS_U32X2_PTR o8 = (GAS_U32X2_PTR)((ism ? MEMB : XB) + (size_t)r * DM) + lane;
#pragma unroll
                    for (int j = 0; j < 4; ++j) { u32x2 w; w.x = cvt_pk_bf16(v[j].x, v[j].y); w.y = cvt_pk_bf16(v[j].z, v[j].w); o8[64 * j] = w;
                        if (!ism) ((GAS unsigned*)(XQ + (size_t)r * DM))[64 * j + lane] = xquant4(v[j], w.x, w.y); }
                    if (ism) { if (lane == 0) RSTDM[r] = rsqrtf(s * (1.0f / 1024.0f) + EPS); }
                    else if (lane < 16) SSQ[(size_t)r * 16 + lane] = (lane == 0) ? s : 0.f;
                }
                for (int i = vcu * 512 + tid; i < M * 32; i += G * 512) {
                    const int row = i >> 5, k = i & 31; const float posf = (float)a.pos[row];
                    const float inv = expf(-9.210340371976184f * (2.0f / 64.0f) * (float)k);
                    float sn, cs; sincosf(posf * inv, &sn, &cs); COSA[i] = cs; SINA[i] = sn;
                    if (k < 16) { const float invb = expf(-9.210340371976184f * (2.0f / 32.0f) * (float)k); float sb, cb; sincosf(posf * invb, &sb, &cb); COSB[row * 16 + k] = cb; SINB[row * 16 + k] = sb; }
                }
            }
            __syncthreads();
        } else if (p == 1) {
            pg8::Gemm g{XB, Win_t, M, IN_WP, DM, DM}; pg8::StaticOrder S; S.init(M, IN_WP, G, bx);
            EpiIn E{SSQ, QKVA, LAT, KVLAT, GATES, LSSQ, COSA, SINA, KBAR};
            for (int rep = 0; rep < 1 + DUP(1); ++rep) { int tl = tid; asm volatile("" : "+v"(tl)); pg8::gemm_phase(lds, tl, g, S, E); }
        } else if (p == 2) {
            if (P2ON(0)) { LAS float* red = (LAS float*)lds;
              for (int i = vcu * 512 + tid; i < M * 16; i += G * 512) {
                  const int row = i >> 4, k = i & 15;
                  const float x1 = bf2f(LAT[(size_t)row * 512 + 384 + k]), x2 = bf2f(LAT[(size_t)row * 512 + 400 + k]);
                  const float c = COSB[i], s = SINB[i];
                  KPE[(size_t)row * 32 + k] = f2bf1(x1 * c - x2 * s); KPE[(size_t)row * 32 + 16 + k] = f2bf1(x2 * c + x1 * s);
              }
              __syncthreads(); }
            if (P2ON(1)) { unsigned char* w = ws; int tl = tid; asm volatile("" : "+s"(w), "+v"(tl));
              pg8::Gemm g{(bf16_t*)(w + WS_LAT), (bf16_t*)(w + WS_WUQ), M, 768, 384, 512}; pg8::StaticOrder S; S.init(M, 768, G, bx);
              EpiUq E{(float*)(w + WS_LSSQ), QB, (float*)(w + WS_COSB), (float*)(w + WS_SINB)}; pg8::gemm_phase(lds, tl, g, S, E); }
            if (P2ON(2)) { unsigned char* w = ws; int tl = tid; asm volatile("" : "+s"(w), "+v"(tl));
              pg8::Gemm g{(bf16_t*)(w + WS_KVLAT), (bf16_t*)(w + WS_WUKV), M, 1024, 256, 256}; pg8::StaticOrder S; S.init(M, 1024, G, G - 1 - bx);
              EpiRowScale<0> E{(float*)(w + WS_LSSQ), (bf16_t*)(w + WS_KVB), 1024, 1.f}; pg8::gemm_phase(lds, tl, g, S, E); }
            if (P2ON(3)) { unsigned char* w = ws; int tl = tid; asm volatile("" : "+s"(w), "+v"(tl));
              pg8::Gemm g{(bf16_t*)(w + WS_MEMB), (bf16_t*)(w + WS_WXKV), MM, 1024, 1024, 1024}; pg8::StaticOrder S; S.init(MM, 1024, G, (bx + 128) % G);
              EpiRowScale<1> E{(float*)(w + WS_RSTDM), (bf16_t*)(w + WS_KVX), 1024, 1.f}; pg8::gemm_phase(lds, tl, g, S, E); }
        } else if (p == 3) {
            for (int v = vcu; v < 256; v += G) {
                const int bh = v >> 1, b = bh >> 3, h = bh & 7;
#pragma unroll 1
                for (int i = 0; i < 4; ++i) {
                    const int cur = (v & 1) ? ((i == 0) ? 2 : (i == 1) ? 5 : (i == 2) ? 3 : 4) : ((i == 0) ? 0 : (i == 1) ? 7 : (i == 2) ? 1 : 6);
                    const size_t rowb = (size_t)b * SEQ, rowq = rowb + cur * 256;
                    attn_unit<64, 64, 0>(lds, tid, QKVA + rowq * 1536 + h * 64, 1536, QKVA + rowb * 1536 + 512 + h * 64, 1536, nullptr,
                                         QKVA + rowb * 1536 + 1024 + h * 64, 1536, OAB + rowq * 512 + h * 64, 512, cur * 256, 4 * (cur + 1), KBAR + (size_t)bh * 512, cur);
                }
                for (int rep = 0; rep < 1 + DUP(4); ++rep)
#pragma unroll 1
                for (int i = 0; i < 4; ++i) {
                    const int cur = (v & 1) ? ((i == 0) ? 2 : (i == 1) ? 5 : (i == 2) ? 3 : 4) : ((i == 0) ? 0 : (i == 1) ? 7 : (i == 2) ? 1 : 6);
                    const size_t rowb = (size_t)b * SEQ, rowq = rowb + cur * 256;
                    attn_unit<96, 64, 1>(lds, tid, QB + rowq * 768 + h * 96, 768, KVB + rowb * 1024 + h * 128, 1024, KPE + rowb * 32,
                                         KVB + rowb * 1024 + h * 128 + 64, 1024, OAB + (size_t)M * 512 + rowq * 512 + h * 64, 512, cur * 256, 4 * (cur + 1), nullptr, cur);
                }
            }
        } else if (p == 4) {
            pg8::Gemm g{OAB, Wba_t, M, 1024, 512, 512, (size_t)M * 512 * 2, (size_t)1024 * 512 * 2}; pg8::StaticOrder S; S.init(M, 1024, G, bx); S.dual = 1;
            EpiBranchF E{GATES}; pg8::gemm_phase(lds, tid, g, S, E);
        } else if (p == 5) {
            pg8::Gemm g{GATES, Wout_t, M, 1024, 1024, 2048}; pg8::StaticOrder S; S.init(M, 1024, G, bx);
            if (ND(5)) { int tl = tid; asm volatile("" : "+v"(tl)); EpiNull EN; pg8::gemm_phase(lds, tl, g, S, EN); }
            EpiRes E{XB, XQ, SSQ}; pg8::gemm_phase(lds, tid, g, S, E);
        } else if (p == 6) {
            pg8::Gemm g{XB, Wxq_t, M, 512, 1024, 1024}; pg8::StaticOrder S; S.init(M, 512, G, bx);
            EpiRowScale<2> E{SSQ, QX, 512, C2X}; for (int rep = 0; rep < 1 + DUP(6); ++rep) { int tl = tid; asm volatile("" : "+v"(tl)); pg8::gemm_phase(lds, tl, g, S, E); }
        } else if (p == 7) {
            for (int un = vcu * 2; un < 512; un += 2 * G)
#pragma unroll 1
                for (int i = 0; i < 2; ++i) {
                    const int unit = un + i, bh = unit >> 3, qb = unit & 7, b = bh >> 2, h = bh & 3;
                    const size_t rowq = (size_t)b * SEQ + qb * 256, rowm = (size_t)b * MEMLEN;
                    attn_unit<128, 128, 2>(lds, tid, QX + rowq * 512 + h * 128, 512, KVX + rowm * 1024 + h * 128, 1024, nullptr,
                                           KVX + rowm * 1024 + 512 + h * 128, 1024, QX + rowq * 512 + h * 128, 512, 0, 4, nullptr, 0);
                }
        } else if (p == 8) {
            pg8::Gemm g{QX, Wxo_t, M, 1024, 512, 512}; pg8::StaticOrder S; S.init(M, 1024, G, bx);
            if (ND(8)) { int tl = tid; asm volatile("" : "+v"(tl)); EpiNull EN; pg8::gemm_phase(lds, tl, g, S, EN); }
            EpiRes E{XB, XQ, SSQ}; pg8::gemm_phase(lds, tid, g, S, E);
        } else if (p == 9) {
            pg8::Gemm g{XB, Wgu_t, M, 2 * DFF, 1024, 1024}; pg8::StaticOrder S; S.init(M, 2 * DFF, G, bx);
            EpiGU E{SSQ, ACT}; for (int rep = 0; rep < 1 + DUP(9); ++rep) { int tl = tid; asm volatile("" : "+v"(tl)); pg8::gemm_phase(lds, tl, g, S, E); }
            if (DUP(12)) { int tl = tid; asm volatile("" : "+v"(tl)); EpiNull EN; pg8::gemm_phase(lds, tl, g, S, EN); }
        } else {
            pg8::Gemm g{ACT, Wdn_t, M, 1024, DFF, DFF}; pg8::StaticOrder S; S.init(M, 1024, G, bx);
            if (ND(10)) { int tl = tid; asm volatile("" : "+v"(tl)); EpiNull EN; pg8::gemm_phase(lds, tl, g, S, EN); }
            if (ND(13)) { int tl = tid; asm volatile("" : "+v"(tl)); EpiRes ED{(bf16_t*)(ws + 276 * MiB), (unsigned char*)(ws + 340 * MiB), LSSQ}; pg8::gemm_phase(lds, tl, g, S, ED); }
            EpiRes E{XB, XQ, SSQ}; pg8::gemm_phase(lds, tid, g, S, E);
        }
    }
    if (TPROBE >= 0 && blockIdx.x == 0) {
        __syncthreads();
        const unsigned long long t0 = __builtin_amdgcn_s_memrealtime(); const unsigned long long dl = (unsigned long long)TAMP * tacc[0];
        while (__builtin_amdgcn_s_memrealtime() - t0 < dl) __builtin_amdgcn_s_sleep(16);
    }
}

extern "C" void kernel_launch(void* const* d_in, const int* in_sizes, int n_in, void* d_out, int out_size, void* d_ws, size_t ws_size, hipStream_t stream) {
    static int grid = 0;
    if (grid == 0) {
        if (n_in != 21 || in_sizes[0] != M * DM || out_size != M * DM || ws_size < WS_END) {
            fprintf(stderr, "kernel_launch: unexpected shapes (n_in %d, in0 %d, out %d, ws %zu); nothing launched\n", n_in, n_in > 0 ? in_sizes[0] : -1, out_size, ws_size); grid = -1; return; }
        int dev = 0, cus = 0, per_cu = 0;
        hipGetDevice(&dev); hipDeviceGetAttribute(&cus, hipDeviceAttributeMultiprocessorCount, dev);
        if (hipOccupancyMaxActiveBlocksPerMultiprocessor(&per_cu, (const void*)fwd_kernel, 512, 0) != hipSuccess || per_cu < 1) per_cu = 1;
        (void)hipGetLastError();
        grid = cus * 1;
        if (grid <= 0) grid = 256;
    }
    if (grid < 0) return;
    Args a{};
    a.x = (const float*)d_in[0]; a.mem = (const float*)d_in[1]; a.pos = (const int*)d_in[2];
    a.norm_mix = (const float*)d_in[3]; a.w_in = (const float*)d_in[4]; a.q_lat_norm = (const float*)d_in[5]; a.w_uq = (const float*)d_in[6];
    a.kv_lat_norm = (const float*)d_in[7]; a.w_ukv = (const float*)d_in[8]; a.w_ba = (const float*)d_in[9]; a.w_bb = (const float*)d_in[10]; a.w_out = (const float*)d_in[11];
    a.norm_x = (const float*)d_in[12]; a.norm_mem = (const float*)d_in[13]; a.w_xq = (const float*)d_in[14]; a.w_xkv = (const float*)d_in[15]; a.w_xo = (const float*)d_in[16];
    a.norm_ffn = (const float*)d_in[17]; a.w_gu = (const float*)d_in[18]; a.w_dn = (const float*)d_in[19]; a.norm_final = (const float*)d_in[20];
    a.out = (float*)d_out; a.ws = (unsigned char*)d_ws;
#if ONE_LAUNCH
    if (hipMemsetAsync((char*)d_ws + WS_CTL, 0, 65536, stream) != hipSuccess) { fprintf(stderr, "kernel_launch: memset of the barrier words failed\n"); return; }
    a.ph_lo = 0; a.ph_hi = N_PHASES;
    void* args[] = {&a};
    hipError_t e = hipLaunchCooperativeKernel((const void*)fwd_kernel, dim3(grid), dim3(512), args, 0, stream);
    if (e != hipSuccess) fprintf(stderr, "cooperative launch failed: %s (grid %d)\n", hipGetErrorString(e), grid);
#else
    for (int ph = 0; ph < N_PHASES; ++ph) {
        a.ph_lo = ph; a.ph_hi = ph + 1;
        hipLaunchKernelGGL(fwd_kernel, dim3(grid), dim3(512), 0, stream, a);
    }
#endif
}
```

```cpp
#include <hip/hip_runtime.h>
#include <hip/hip_cooperative_groups.h>
#include <cstdio>
#include <cstdint>
namespace cg = cooperative_groups;

#ifndef ONE_LAUNCH
#define ONE_LAUNCH 1
#endif

#ifndef PHMASK
#define PHMASK 0xFFFF
#endif
#ifndef P2MASK
#define P2MASK 0xF
#endif
#define P2ON(k) (((P2MASK) >> (k)) & 1)
#ifndef DUPMASK
#define DUPMASK 0
#endif
#ifndef XSYNC
#define XSYNC 0
#endif
#define DUP(k) (((DUPMASK) >> (k)) & 1)
#ifndef STAG
#define STAG 0
#endif
#ifndef NDUP
#define NDUP 0
#endif
#define ND(k) (((NDUP) >> (k)) & 1)
#ifndef TPROBE
#define TPROBE -1
#endif
#define TAMP 4
#define PHON(k) (((PHMASK) >> (k)) & 1)
#define LAS __attribute__((address_space(3)))
#define GAS __attribute__((address_space(1)))
#define GAS_U32X2_PTR __attribute__((address_space(1))) u32x2*
typedef unsigned short bf16_t;
typedef short bf16x8 __attribute__((ext_vector_type(8)));
typedef float f32x4 __attribute__((ext_vector_type(4)));
typedef float f32x16 __attribute__((ext_vector_type(16)));
typedef unsigned u32x4 __attribute__((ext_vector_type(4)));
typedef unsigned u32x2 __attribute__((ext_vector_type(2)));

constexpr int NBATCH = 16, SEQ = 2048, DM = 1024, DEPTH = 4, MEMLEN = 256;
constexpr int M = NBATCH * SEQ;
constexpr int MM = NBATCH * MEMLEN;
constexpr int IN_W = 4256, IN_WP = 4352;
constexpr int DFF = 2816;
constexpr float EPS = 1e-6f;
constexpr float LOG2E = 1.4426950408889634f;
constexpr float C2A = 0.125f * LOG2E;
constexpr float C2B = 0.10206207261596575f * LOG2E;
constexpr float C2X = 0.08838834764831845f * LOG2E;

constexpr size_t MiB = 1u << 20;
constexpr size_t WS_WIN = 0 * MiB, WS_WUQ = 9 * MiB, WS_WUKV = 10 * MiB, WS_WBA = 11 * MiB, WS_WBB = 12 * MiB, WS_WOUT = 13 * MiB,
                 WS_WXQ = 15 * MiB, WS_WXKV = 16 * MiB, WS_WXO = 18 * MiB, WS_WGU = 19 * MiB, WS_WDN = 30 * MiB;
constexpr size_t WS_XB = 36 * MiB;
constexpr size_t WS_QKVA = 100 * MiB;
constexpr size_t WS_LAT = 196 * MiB;
constexpr size_t WS_KVLAT = 228 * MiB;
constexpr size_t WS_GATES = 244 * MiB;
constexpr size_t WS_ACT = 100 * MiB;
constexpr size_t WS_KVB = 372 * MiB;
constexpr size_t WS_KVX = 436 * MiB;
constexpr size_t WS_MEMB = 444 * MiB;
constexpr size_t WS_KPE = 452 * MiB;
constexpr size_t WS_COSA = 454 * MiB, WS_SINA = 458 * MiB;
constexpr size_t WS_COSB = 462 * MiB, WS_SINB = 464 * MiB;
constexpr size_t WS_SSQ = 466 * MiB;
constexpr size_t WS_LSSQ = 468 * MiB;
constexpr size_t WS_RSTDM = 470 * MiB;
constexpr size_t WS_KBAR = 470 * MiB + 65536;
constexpr size_t WS_XQ = 473 * MiB;
constexpr size_t WS_CTL = 471 * MiB;
constexpr size_t WS_END = 505 * MiB;

typedef float f32x2_t __attribute__((ext_vector_type(2))); typedef __bf16 bf16x2_t __attribute__((ext_vector_type(2)));
__device__ __forceinline__ unsigned cvt_pk_bf16(float lo, float hi) { f32x2_t v = {lo, hi}; bf16x2_t b = __builtin_convertvector(v, bf16x2_t); return __builtin_bit_cast(unsigned, b); }
__device__ __forceinline__ float bf2f(unsigned short b) { return __uint_as_float(((unsigned)b) << 16); }
__device__ __forceinline__ float bflo(unsigned w) { return __uint_as_float(w << 16); }
__device__ __forceinline__ float bfhi(unsigned w) { return __uint_as_float(w & 0xffff0000u); }
__device__ __forceinline__ unsigned short f2bf1(float f) { return (unsigned short)(cvt_pk_bf16(f, 0.f) & 0xffffu); }


__device__ __forceinline__ float xdeq(unsigned hbits, float hf, int q) { unsigned e = (hbits >> 7) & 0xffu; e = e < 16u ? 16u : e; return __builtin_fmaf((float)q, __uint_as_float((e - 15u) << 23), hf); }
__device__ __forceinline__ unsigned xquant(float x, unsigned hbits, float hf) { unsigned e = (hbits >> 7) & 0xffu; e = e < 16u ? 16u : e;
    float qf = __builtin_rintf((x - hf) * __uint_as_float((269u - e) << 23)); qf = fminf(fmaxf(qf, -127.f), 127.f); return ((unsigned)(int)qf) & 0xffu; }
__device__ __forceinline__ void xdeq8(const u32x4 h, const u32x2 q, f32x4& a, f32x4& b) {
    a.x = xdeq(h.x & 0xffffu, bflo(h.x), (int)(q.x << 24) >> 24); a.y = xdeq(h.x >> 16, bfhi(h.x), (int)(q.x << 16) >> 24);
    a.z = xdeq(h.y & 0xffffu, bflo(h.y), (int)(q.x << 8) >> 24);  a.w = xdeq(h.y >> 16, bfhi(h.y), (int)q.x >> 24);
    b.x = xdeq(h.z & 0xffffu, bflo(h.z), (int)(q.y << 24) >> 24); b.y = xdeq(h.z >> 16, bfhi(h.z), (int)(q.y << 16) >> 24);
    b.z = xdeq(h.w & 0xffffu, bflo(h.w), (int)(q.y << 8) >> 24);  b.w = xdeq(h.w >> 16, bfhi(h.w), (int)q.y >> 24);
}
__device__ __forceinline__ unsigned xquant4(const f32x4 v, unsigned w0, unsigned w1) {
    return xquant(v.x, w0 & 0xffffu, bflo(w0)) | (xquant(v.y, w0 >> 16, bfhi(w0)) << 8) | (xquant(v.z, w1 & 0xffffu, bflo(w1)) << 16) | (xquant(v.w, w1 >> 16, bfhi(w1)) << 24);
}

namespace pg8 {
constexpr int BM = 256, BK = 64, HALF = 128, HTB = HALF * BK * 2, STAGE_BYTES = 8 * HTB, NXCD = 8, WGM = 8;
__host__ __device__ __forceinline__ int lds_byte(int r, int c) { const int st = (r >> 4) * 2 + (c >> 5), rr = r & 15, cc = c & 31, ob = rr * 64 + cc * 2; return st * 1024 + (ob ^ (((ob >> 9) & 1) << 5)); }
__host__ __device__ __forceinline__ void stage_rc(int b, int& R, int& C) { const int st = b / 1024, sb = b % 1024, swz = sb ^ (((sb >> 9) & 1) << 5); R = (st >> 1) * 16 + swz / 64; C = (st & 1) * 32 + (swz % 64) / 2; }
__host__ __device__ __forceinline__ int perm32(int rho) { const int n = rho >> 4, i = rho & 15; return 8 * (i >> 2) + 4 * n + (i & 3); }

struct Unit { int pm, pn, z; };
struct Gemm { const bf16_t* A; const bf16_t* Bt; int M, N, K, lda; size_t zA = 0, zB = 0; };

struct StaticOrder {
    int nM, nN, nwg, G, c, dual = 0;
    __device__ void init(int M_, int N_, int G_, int c_) { nM = M_ / BM; nN = N_ / BM; nwg = nM * nN; G = G_; c = c_; }
    __device__ bool next(int i, Unit& u) const {
        u.z = dual ? (i & 1) : 0; if (dual) i >>= 1;
        const long L = (long)i * G + c; if (L >= nwg) return false;
        int wgid = (int)L; { const int q = nwg / NXCD, r = nwg % NXCD, xcd = wgid % NXCD, off = wgid / NXCD; wgid = (xcd < r ? xcd * (q + 1) : r * (q + 1) + (xcd - r) * q) + off; }
        const int nig = WGM * nN, gid = wgid / nig, fm = gid * WGM, gsz = (nM - fm) < WGM ? (nM - fm) : WGM;
        u.pm = fm + ((wgid % nig) % gsz); u.pn = (wgid % nig) / gsz; return true;
    }
};

template <class Epi>
__device__ __forceinline__ void gemm_phase(LAS unsigned char* lds, const int tid, const Gemm g, const StaticOrder& S, const Epi& E) {
    LAS unsigned char* const sl = lds + STAGE_BYTES;
    const int wid = __builtin_amdgcn_readfirstlane(tid >> 6), lane = tid & 63, wr = wid >> 2, wc = wid & 3, fr = lane & 15, fq = lane >> 4;
    const int K = g.K, nt = K / BK;
    unsigned voffA[2], voffB[2];
#pragma unroll
    for (int i = 0; i < 2; ++i) { int R, C; stage_rc(tid * 16 + i * 8192, R, C); const int Rb = Epi::PERM ? ((R & ~31) + perm32(R & 31)) : R;
        voffA[i] = (unsigned)(R * g.lda + C) * 2u; voffB[i] = (unsigned)(Rb * K + C) * 2u; }
    const size_t kstep = (size_t)(BK * 2);
    const size_t hstepA = (size_t)HALF * g.lda * 2, hstepB = (size_t)HALF * K * 2;
    const size_t tstepA = 2 * hstepA, tstepB = 2 * hstepB;
    const unsigned ldsw = (unsigned)wid * 1024u;
    const int aoff = lds_byte(wr * 64 + fr, fq * 8), boff = lds_byte(wc * 32 + fr, fq * 8);
#define PG8_SA(b, h) (((b) * 2 + (h)) * HTB)
#define PG8_SB(b, h) ((4 + (b) * 2 + (h)) * HTB)
#define PG8_STAGE(bufoff, gbase, voff) do { _Pragma("unroll") for (int _i = 0; _i < 2; ++_i) \
        __builtin_amdgcn_global_load_lds((const unsigned*)((const char*)(gbase) + (voff)[_i]), (LAS unsigned*)(lds + (bufoff) + ldsw + _i * 8192), 16, 0, 0); } while (0)
#define PG8_LDA(dst, b, h) do { _Pragma("unroll") for (int m = 0; m < 4; ++m) _Pragma("unroll") for (int k = 0; k < 2; ++k) dst[m][k] = *(const LAS bf16x8*)(lds + PG8_SA(b, h) + aoff + m * 2048 + k * 1024); } while (0)
#define PG8_LDB(dst, b, h) do { _Pragma("unroll") for (int n = 0; n < 2; ++n) _Pragma("unroll") for (int k = 0; k < 2; ++k) dst[n][k] = *(const LAS bf16x8*)(lds + PG8_SB(b, h) + boff + n * 2048 + k * 1024); } while (0)
#define PG8_MMA(ai, bj, At, Bt) do { __builtin_amdgcn_s_setprio(1); _Pragma("unroll") for (int m = 0; m < 4; ++m) _Pragma("unroll") for (int n = 0; n < 2; ++n) _Pragma("unroll") for (int k = 0; k < 2; ++k) \
        acc[ai][bj][m][n] = __builtin_amdgcn_mfma_f32_16x16x32_bf16(Bt[n][k], At[m][k], acc[ai][bj][m][n], 0, 0, 0); __builtin_amdgcn_s_setprio(0); } while (0)
#define PG8_WAIT_V(n) asm volatile("s_waitcnt vmcnt(" #n ")" ::: "memory")
#define PG8_WAIT_L(n) asm volatile("s_waitcnt lgkmcnt(" #n ")" ::: "memory")
#define PG8_BAR __builtin_amdgcn_s_barrier()
#define PG8_SCHED __builtin_amdgcn_sched_barrier(0)
    Unit cur, nxt; int ui = 0;
    if (!S.next(0, cur)) return;
    f32x4 acc[2][2][4][2];
    if constexpr (Epi::ACC_INIT) E.init(acc, cur, wr, wc, fr, fq);
    else { float z0_ = 0.f; asm volatile("" : "+v"(z0_));
#pragma unroll
    for (int a = 0; a < 2; ++a)
#pragma unroll
        for (int b = 0; b < 2; ++b)
#pragma unroll
            for (int m = 0; m < 4; ++m)
#pragma unroll
                for (int n = 0; n < 2; ++n) acc[a][b][m][n] = (f32x4){z0_, z0_, z0_, z0_};
    }
    bf16x8 At[4][2], B0[2][2], B1[2][2];
    const char* cA = (const char*)g.A + (size_t)cur.z * g.zA + (size_t)cur.pm * tstepA; const char* cB = (const char*)g.Bt + (size_t)cur.z * g.zB + (size_t)cur.pn * tstepB;
    PG8_STAGE(PG8_SB(0, 0), cB, voffB); PG8_STAGE(PG8_SB(0, 1), cB + hstepB, voffB); PG8_STAGE(PG8_SA(0, 0), cA, voffA); PG8_STAGE(PG8_SA(0, 1), cA + hstepA, voffA);
    if (wr == 1) PG8_BAR;
    PG8_WAIT_V(2); PG8_BAR;
    PG8_STAGE(PG8_SB(1, 0), cB + kstep, voffB); PG8_STAGE(PG8_SA(1, 0), cA + kstep, voffA); PG8_STAGE(PG8_SB(1, 1), cB + hstepB + kstep, voffB);
    PG8_WAIT_V(6); PG8_BAR;
    for (;;) {
        const bool has_next = S.next(ui + 1, nxt);
        const char* nA = has_next ? (const char*)g.A + (size_t)nxt.z * g.zA + (size_t)nxt.pm * tstepA : cA; const char* nB = has_next ? (const char*)g.Bt + (size_t)nxt.z * g.zB + (size_t)nxt.pn * tstepB : cB;
#pragma unroll 1
        for (int t = 0; t < nt; t += 2) {
            const bool last = (t == nt - 2);
            const char* a1 = cA + (size_t)(t + 1) * kstep;
            const char* a2 = last ? nA : cA + (size_t)(t + 2) * kstep; const char* b2 = last ? nB : cB + (size_t)(t + 2) * kstep;
            const char* a3 = a2 + kstep; const char* b3 = b2 + kstep;
            PG8_LDB(B0, 0, 0); PG8_LDB(B1, 0, 1); PG8_SCHED; PG8_LDA(At, 0, 0); PG8_STAGE(PG8_SA(1, 1), a1 + hstepA, voffA);
            PG8_WAIT_V(8); PG8_WAIT_L(0); PG8_BAR;
            if constexpr (Epi::PREF) { if (t == 0) {
                const char* sp_ = (const char*)E.stat_base() + (size_t)cur.pm * 16384 + (size_t)(wid * 2048 + lane * 16);
                __builtin_amdgcn_global_load_lds((const unsigned*)sp_, (LAS unsigned*)(sl + wid * 2048), 16, 0, 0);
                __builtin_amdgcn_global_load_lds((const unsigned*)(sp_ + 1024), (LAS unsigned*)(sl + wid * 2048 + 1024), 16, 0, 0); } }
            PG8_MMA(0, 0, At, B0); PG8_MMA(0, 1, At, B1); PG8_BAR; PG8_SCHED;
            PG8_LDA(At, 0, 1); PG8_STAGE(PG8_SB(0, 0), b2, voffB); PG8_STAGE(PG8_SB(0, 1), b2 + hstepB, voffB); PG8_STAGE(PG8_SA(0, 0), a2, voffA);
            PG8_WAIT_V(8); PG8_WAIT_L(0); PG8_BAR; PG8_MMA(1, 0, At, B0); PG8_MMA(1, 1, At, B1); PG8_BAR; PG8_SCHED;
            PG8_LDB(B0, 1, 0); PG8_LDB(B1, 1, 1); PG8_SCHED; PG8_LDA(At, 1, 0); PG8_STAGE(PG8_SA(0, 1), a2 + hstepA, voffA);
            PG8_WAIT_V(8); PG8_WAIT_L(0); PG8_BAR; PG8_MMA(0, 0, At, B0); PG8_MMA(0, 1, At, B1); PG8_BAR; PG8_SCHED;
            PG8_LDA(At, 1, 1); PG8_STAGE(PG8_SB(1, 0), b3, voffB); PG8_STAGE(PG8_SB(1, 1), b3 + hstepB, voffB); PG8_STAGE(PG8_SA(1, 0), a3, voffA);
            PG8_WAIT_V(8); PG8_WAIT_L(0); PG8_BAR; PG8_MMA(1, 0, At, B0); PG8_MMA(1, 1, At, B1); PG8_BAR; PG8_SCHED;
        }
        if (wr == 0) PG8_BAR;
        E(acc, cur, wr, wc, fr, fq, sl);
        if (!has_next) break;
        if constexpr (Epi::ACC_INIT) E.init(acc, nxt, wr, wc, fr, fq);
        else if (!(Epi::KEEP && nxt.z == 1)) { float z0_ = 0.f; asm volatile("" : "+v"(z0_));
#pragma unroll
        for (int a = 0; a < 2; ++a)
#pragma unroll
            for (int b = 0; b < 2; ++b)
#pragma unroll
                for (int m = 0; m < 4; ++m)
#pragma unroll
                    for (int n = 0; n < 2; ++n) acc[a][b][m][n] = (f32x4){z0_, z0_, z0_, z0_};
        }
        cur = nxt; cA = nA; cB = nB; ++ui;
        if (wr == 1) PG8_BAR;
    }
    PG8_WAIT_V(0);
    PG8_BAR;
#undef PG8_SA
#undef PG8_SB
#undef PG8_STAGE
#undef PG8_LDA
#undef PG8_LDB
#undef PG8_MMA
#undef PG8_WAIT_V
#undef PG8_WAIT_L
#undef PG8_BAR
#undef PG8_SCHED
}
}

typedef f32x4 (&AccRef)[2][2][4][2];

__device__ __forceinline__ float quad_sum(float s) { s += __shfl_xor(s, 16); s += __shfl_xor(s, 32); return s; }
__device__ __forceinline__ float sq4(f32x4 v) { return (v.x * v.x + v.y * v.y) + (v.z * v.z + v.w * v.w); }
__device__ __forceinline__ float sum4(f32x4 v) { return (v.x + v.y) + (v.z + v.w); }
__device__ __forceinline__ u32x4 pack8(f32x4 a, f32x4 b) { u32x4 w; w.x = cvt_pk_bf16(a.x, a.y); w.y = cvt_pk_bf16(a.z, a.w); w.z = cvt_pk_bf16(b.x, b.y); w.w = cvt_pk_bf16(b.z, b.w); return w; }
__device__ __forceinline__ float sigmoidf_(float v) { return __builtin_amdgcn_rcpf(1.0f + __builtin_amdgcn_exp2f(v * (-LOG2E))); }
__device__ __forceinline__ f32x4 sig4(f32x4 v) { return (f32x4){sigmoidf_(v.x), sigmoidf_(v.y), sigmoidf_(v.z), sigmoidf_(v.w)}; }
#define ROWSTAT8(rs, base, inv_n, mul) do { f32x4 pv_[2][4]; \
    _Pragma("unroll") for (int ai = 0; ai < 2; ++ai) _Pragma("unroll") for (int m = 0; m < 4; ++m) pv_[ai][m] = *(const LAS f32x4*)(sl + (ai * 128 + wr * 64 + m * 16 + fr) * 64 + 16 * fq); \
    _Pragma("unroll") for (int ai = 0; ai < 2; ++ai) _Pragma("unroll") for (int m = 0; m < 4; ++m) rs[ai][m] = rsqrtf(quad_sum(sum4(pv_[ai][m])) * (inv_n) + EPS) * (mul); } while (0)

struct EpiIn {
    static constexpr bool PERM = true, ACC_INIT = false, PREF = true, KEEP = false;
    __device__ __forceinline__ const float* stat_base() const { return ssq; }
    const float* ssq; bf16_t* qkva; bf16_t* lat; bf16_t* kvlat; bf16_t* gates; float* lssq; const float* cosA; const float* sinA; float* kbar;
    __device__ __forceinline__ void operator()(AccRef acc, const pg8::Unit& u, int wr, int wc, int fr, int fq, const LAS unsigned char* sl) const {
        const int pn = u.pn;
        float rs[2][4];
        ROWSTAT8(rs, ssq, 1.0f / 1024.0f, 1.0f);
        if (pn < 4) {
            const float sc = (pn < 2) ? C2A : 1.0f;
            f32x4 cs[2][4];
#define ROPE_LOAD(ai, m0) _Pragma("unroll") for (int mm = 0; mm < 2; ++mm) { const size_t ro = (size_t)(u.pm * 256 + (ai) * 128 + wr * 64 + ((m0) + mm) * 16 + fr) * 32 + 8 * fq; \
            cs[mm][0] = *(const GAS f32x4*)(cosA + ro); cs[mm][1] = *(const GAS f32x4*)(cosA + ro + 4); cs[mm][2] = *(const GAS f32x4*)(sinA + ro); cs[mm][3] = *(const GAS f32x4*)(sinA + ro + 4); }
#define ROPE_COMP(ai, m0) _Pragma("unroll") for (int mm = 0; mm < 2; ++mm) { const int m = (m0) + mm; const float r_ = rs[ai][m] * sc; \
            const f32x4 v00 = acc[ai][0][m][0] * r_, v01 = acc[ai][0][m][1] * r_, v10 = acc[ai][1][m][0] * r_, v11 = acc[ai][1][m][1] * r_; \
            acc[ai][0][m][0] = v00 * cs[mm][0] - v10 * cs[mm][2]; acc[ai][0][m][1] = v01 * cs[mm][1] - v11 * cs[mm][3]; acc[ai][1][m][0] = v10 * cs[mm][0] + v00 * cs[mm][2]; acc[ai][1][m][1] = v11 * cs[mm][1] + v01 * cs[mm][3]; }
#define ROPE_STORE(ai, m0) _Pragma("unroll") for (int mm = 0; mm < 2; ++mm) { const int m = (m0) + mm; const int row = u.pm * 256 + (ai) * 128 + wr * 64 + m * 16 + fr; \
            bf16_t* d = qkva + (size_t)row * 1536 + (pn >> 1) * 512 + ((pn & 1) * 4 + wc) * 64 + 8 * fq; \
            *(GAS u32x4*)d = pack8(acc[ai][0][m][0], acc[ai][0][m][1]); *(GAS u32x4*)(d + 32) = pack8(acc[ai][1][m][0], acc[ai][1][m][1]); }
            ROPE_LOAD(0, 0); ROPE_COMP(0, 0); ROPE_LOAD(0, 2); ROPE_STORE(0, 0); ROPE_COMP(0, 2); ROPE_LOAD(1, 0); ROPE_STORE(0, 2); ROPE_COMP(1, 0); ROPE_LOAD(1, 2); ROPE_STORE(1, 0); ROPE_COMP(1, 2); ROPE_STORE(1, 2);
#undef ROPE_LOAD
#undef ROPE_COMP
#undef ROPE_STORE
            if (pn >= 2) {
                f32x4 cs_[2][2];
#pragma unroll
                for (int bj = 0; bj < 2; ++bj)
#pragma unroll
                    for (int n = 0; n < 2; ++n) { f32x4 t = acc[0][bj][0][n];
#pragma unroll
                        for (int m = 1; m < 4; ++m) t = t + acc[0][bj][m][n];
#pragma unroll
                        for (int m = 0; m < 4; ++m) t = t + acc[1][bj][m][n];
#pragma unroll
                        for (int off = 1; off < 16; off <<= 1) { t.x += __shfl_xor(t.x, off); t.y += __shfl_xor(t.y, off); t.z += __shfl_xor(t.z, off); t.w += __shfl_xor(t.w, off); }
                        cs_[bj][n] = t * (1.0f / 256.0f); }
                if (fr == 0) { GAS float* kb_ = (GAS float*)kbar + (size_t)((u.pm >> 3) * 8 + (pn & 1) * 4 + wc) * 512 + (u.pm & 7) * 64 + 8 * fq;
#pragma unroll
                    for (int bj = 0; bj < 2; ++bj)
#pragma unroll
                        for (int n = 0; n < 2; ++n) { GAS float* p_ = kb_ + 32 * bj + 4 * n;
                            __hip_atomic_fetch_add(p_ + 0, cs_[bj][n].x, __ATOMIC_RELAXED, __HIP_MEMORY_SCOPE_AGENT); __hip_atomic_fetch_add(p_ + 1, cs_[bj][n].y, __ATOMIC_RELAXED, __HIP_MEMORY_SCOPE_AGENT);
                            __hip_atomic_fetch_add(p_ + 2, cs_[bj][n].z, __ATOMIC_RELAXED, __HIP_MEMORY_SCOPE_AGENT); __hip_atomic_fetch_add(p_ + 3, cs_[bj][n].w, __ATOMIC_RELAXED, __HIP_MEMORY_SCOPE_AGENT); } }
            }
            return;
        }
#pragma unroll
        for (int ai = 0; ai < 2; ++ai)
#pragma unroll
            for (int m = 0; m < 4; ++m) {
                const int row = u.pm * 256 + ai * 128 + wr * 64 + m * 16 + fr;
                const float r_ = rs[ai][m];
                const f32x4 v00 = acc[ai][0][m][0] * r_, v01 = acc[ai][0][m][1] * r_, v10 = acc[ai][1][m][0] * r_, v11 = acc[ai][1][m][1] * r_;
                if (pn < 6) {
                    bf16_t* d = qkva + (size_t)row * 1536 + pn * 256 + wc * 32 + 8 * fq;
                    *(GAS u32x4*)d = pack8(v00, v01); *(GAS u32x4*)(d + 128) = pack8(v10, v11);
                } else if (pn < 8) {
                    bf16_t* d = lat + (size_t)row * 512 + (pn - 6) * 256 + wc * 32 + 8 * fq;
                    *(GAS u32x4*)d = pack8(v00, v01); *(GAS u32x4*)(d + 128) = pack8(v10, v11);
                    float s = sq4(v00) + sq4(v01); if (pn == 6) s += sq4(v10) + sq4(v11);
                    s = quad_sum(s);
                    if (fq == 0) ((GAS float*)lssq)[(size_t)row * 16 + (pn - 6) * 4 + wc] = s;
                } else if (pn == 8) {
                    bf16_t* d = kvlat + (size_t)row * 256 + wc * 32 + 8 * fq;
                    *(GAS u32x4*)d = pack8(v00, v01); *(GAS u32x4*)(d + 128) = pack8(v10, v11);
                    float s = quad_sum(sq4(v00) + sq4(v01) + sq4(v10) + sq4(v11));
                    if (fq == 0) ((GAS float*)lssq)[(size_t)row * 16 + 8 + wc] = s;
                } else {
                    bf16_t* d = gates + (size_t)row * 2048 + (pn - 9) * 128 + wc * 32 + 8 * fq;
                    const f32x4 sb0 = sig4(v10), sb1 = sig4(v11), sa0 = sig4(v00), sa1 = sig4(v01);
                    const f32x4 r0 = {sa0.x * __builtin_amdgcn_rcpf(sb0.x), sa0.y * __builtin_amdgcn_rcpf(sb0.y), sa0.z * __builtin_amdgcn_rcpf(sb0.z), sa0.w * __builtin_amdgcn_rcpf(sb0.w)};
                    const f32x4 r1 = {sa1.x * __builtin_amdgcn_rcpf(sb1.x), sa1.y * __builtin_amdgcn_rcpf(sb1.y), sa1.z * __builtin_amdgcn_rcpf(sb1.z), sa1.w * __builtin_amdgcn_rcpf(sb1.w)};
                    *(GAS u32x4*)d = pack8(r0, r1); *(GAS u32x4*)(d + 1024) = pack8(sb0, sb1);
                }
            }
    }
};

struct EpiUq {
    static constexpr bool PERM = true, ACC_INIT = false, PREF = true, KEEP = false;
    __device__ __forceinline__ const float* stat_base() const { return lssq; }
    const float* lssq; bf16_t* qb; const float* cosB; const float* sinB;
    __device__ __forceinline__ void operator()(AccRef acc, const pg8::Unit& u, int wr, int wc, int fr, int fq, const LAS unsigned char* sl) const {
        const int pn = u.pn;
        float rs[2][4];
        { f32x4 pv_[2][4];
#pragma unroll
          for (int ai = 0; ai < 2; ++ai)
#pragma unroll
              for (int m = 0; m < 4; ++m) pv_[ai][m] = *(const LAS f32x4*)(sl + (ai * 128 + wr * 64 + m * 16 + fr) * 64 + 16 * (fq & 1));
#pragma unroll
          for (int ai = 0; ai < 2; ++ai)
#pragma unroll
              for (int m = 0; m < 4; ++m) rs[ai][m] = rsqrtf(quad_sum((fq < 2) ? sum4(pv_[ai][m]) : 0.f) * (1.0f / 384.0f) + EPS) * C2B; }
        if (pn == 2) {
            const int head = 2 * wc + (fq >> 1), i0 = 8 * (fq & 1);
            f32x4 cs[2][4];
#define ROPE_LOAD(ai, m0) _Pragma("unroll") for (int mm = 0; mm < 2; ++mm) { const size_t ro = (size_t)(u.pm * 256 + (ai) * 128 + wr * 64 + ((m0) + mm) * 16 + fr) * 16 + i0; \
            cs[mm][0] = *(const GAS f32x4*)(cosB + ro); cs[mm][1] = *(const GAS f32x4*)(cosB + ro + 4); cs[mm][2] = *(const GAS f32x4*)(sinB + ro); cs[mm][3] = *(const GAS f32x4*)(sinB + ro + 4); }
#define ROPE_COMP(ai, m0) _Pragma("unroll") for (int mm = 0; mm < 2; ++mm) { const int m = (m0) + mm; const float r_ = rs[ai][m]; \
            const f32x4 v00 = acc[ai][0][m][0] * r_, v01 = acc[ai][0][m][1] * r_, v10 = acc[ai][1][m][0] * r_, v11 = acc[ai][1][m][1] * r_; \
            acc[ai][0][m][0] = v00 * cs[mm][0] - v10 * cs[mm][2]; acc[ai][0][m][1] = v01 * cs[mm][1] - v11 * cs[mm][3]; acc[ai][1][m][0] = v10 * cs[mm][0] + v00 * cs[mm][2]; acc[ai][1][m][1] = v11 * cs[mm][1] + v01 * cs[mm][3]; }
#define ROPE_STORE(ai, m0) _Pragma("unroll") for (int mm = 0; mm < 2; ++mm) { const int m = (m0) + mm; const int row = u.pm * 256 + (ai) * 128 + wr * 64 + m * 16 + fr; \
            bf16_t* d = qb + (size_t)row * 768 + head * 96 + 64 + i0; \
            *(GAS u32x4*)d = pack8(acc[ai][0][m][0], acc[ai][0][m][1]); *(GAS u32x4*)(d + 16) = pack8(acc[ai][1][m][0], acc[ai][1][m][1]); }
            ROPE_LOAD(0, 0); ROPE_COMP(0, 0); ROPE_LOAD(0, 2); ROPE_STORE(0, 0); ROPE_COMP(0, 2); ROPE_LOAD(1, 0); ROPE_STORE(0, 2); ROPE_COMP(1, 0); ROPE_LOAD(1, 2); ROPE_STORE(1, 0); ROPE_COMP(1, 2); ROPE_STORE(1, 2);
#undef ROPE_LOAD
#undef ROPE_COMP
#undef ROPE_STORE
            return;
        }
#pragma unroll
        for (int ai = 0; ai < 2; ++ai)
#pragma unroll
            for (int m = 0; m < 4; ++m) {
                const int row = u.pm * 256 + ai * 128 + wr * 64 + m * 16 + fr;
                const float r_ = rs[ai][m];
                const int c0 = pn * 256 + wc * 32 + 8 * fq, c1 = c0 + 128;
                *(GAS u32x4*)(qb + (size_t)row * 768 + (c0 >> 6) * 96 + (c0 & 63)) = pack8(acc[ai][0][m][0] * r_, acc[ai][0][m][1] * r_);
                *(GAS u32x4*)(qb + (size_t)row * 768 + (c1 >> 6) * 96 + (c1 & 63)) = pack8(acc[ai][1][m][0] * r_, acc[ai][1][m][1] * r_);
            }
    }
};

template <int MODE> struct EpiRowScale {
    static constexpr bool PERM = true, ACC_INIT = false, PREF = (MODE != 1), KEEP = false;
    __device__ __forceinline__ const float* stat_base() const { return stat; }
    const float* stat; bf16_t* O; int ldc; float cs;
    __device__ __forceinline__ void operator()(AccRef acc, const pg8::Unit& u, int wr, int wc, int fr, int fq, const LAS unsigned char* sl) const {
        float rs[2][4];
        if (MODE == 0) { f32x4 pv_[2][4];
#pragma unroll
            for (int ai = 0; ai < 2; ++ai)
#pragma unroll
                for (int m = 0; m < 4; ++m) pv_[ai][m] = *(const LAS f32x4*)(sl + (ai * 128 + wr * 64 + m * 16 + fr) * 64 + 32);
#pragma unroll
            for (int ai = 0; ai < 2; ++ai)
#pragma unroll
                for (int m = 0; m < 4; ++m) rs[ai][m] = rsqrtf(sum4(pv_[ai][m]) * (1.0f / 256.0f) + EPS);
        } else if (MODE == 1) {
#pragma unroll
            for (int ai = 0; ai < 2; ++ai)
#pragma unroll
                for (int m = 0; m < 4; ++m) rs[ai][m] = ((const GAS float*)stat)[u.pm * 256 + ai * 128 + wr * 64 + m * 16 + fr];
        } else { ROWSTAT8(rs, stat, 1.0f / 1024.0f, cs); }
#pragma unroll
        for (int ai = 0; ai < 2; ++ai)
#pragma unroll
            for (int m = 0; m < 4; ++m) {
                const int row = u.pm * 256 + ai * 128 + wr * 64 + m * 16 + fr;
                const float r_ = rs[ai][m];
                bf16_t* d = O + (size_t)row * ldc + u.pn * 256 + wc * 32 + 8 * fq;
                *(GAS u32x4*)d = pack8(acc[ai][0][m][0] * r_, acc[ai][0][m][1] * r_);
                *(GAS u32x4*)(d + 128) = pack8(acc[ai][1][m][0] * r_, acc[ai][1][m][1] * r_);
            }
    }
};

struct EpiBranchF {
    static constexpr bool PERM = true, ACC_INIT = false, PREF = false, KEEP = true;
    bf16_t* gates;
    __device__ __forceinline__ void operator()(AccRef acc, const pg8::Unit& u, int wr, int wc, int fr, int fq, const LAS unsigned char* sl) const {
        const int zoff = u.z ? 1024 : 0;
        u32x4 gt[4][2];
#define BR_LOAD(ai) _Pragma("unroll") for (int m = 0; m < 4; ++m) _Pragma("unroll") for (int bj = 0; bj < 2; ++bj) \
            gt[m][bj] = *(const GAS u32x4*)(gates + (size_t)(u.pm * 256 + (ai) * 128 + wr * 64 + m * 16 + fr) * 2048 + zoff + u.pn * 256 + bj * 128 + wc * 32 + 8 * fq);
#define BR_COMP(ai) _Pragma("unroll") for (int m = 0; m < 4; ++m) _Pragma("unroll") for (int bj = 0; bj < 2; ++bj) { const u32x4 g = gt[m][bj]; const f32x4 a0 = acc[ai][bj][m][0], a1 = acc[ai][bj][m][1]; \
            acc[ai][bj][m][0] = (f32x4){bflo(g.x) * a0.x, bfhi(g.x) * a0.y, bflo(g.y) * a0.z, bfhi(g.y) * a0.w}; acc[ai][bj][m][1] = (f32x4){bflo(g.z) * a1.x, bfhi(g.z) * a1.y, bflo(g.w) * a1.z, bfhi(g.w) * a1.w}; }
#define BR_STORE(ai) _Pragma("unroll") for (int m = 0; m < 4; ++m) _Pragma("unroll") for (int bj = 0; bj < 2; ++bj) \
            *(GAS u32x4*)(gates + (size_t)(u.pm * 256 + (ai) * 128 + wr * 64 + m * 16 + fr) * 2048 + u.pn * 256 + bj * 128 + wc * 32 + 8 * fq) = pack8(acc[ai][bj][m][0], acc[ai][bj][m][1]);
        BR_LOAD(0); BR_COMP(0); BR_LOAD(1); if (u.z) { BR_STORE(0); } BR_COMP(1); if (u.z) { BR_STORE(1); }
#undef BR_LOAD
#undef BR_COMP
#undef BR_STORE
    }
};

struct EpiRes {
    static constexpr bool PERM = true, ACC_INIT = true, PREF = false, KEEP = false;
    bf16_t* xb; unsigned char* xq; float* ssq;
    __device__ __forceinline__ void init(AccRef acc, const pg8::Unit& u, int wr, int wc, int fr, int fq) const {
        const size_t ubase = (size_t)(u.pm * 256 + wr * 64) * 1024 + u.pn * 256 + wc * 32;
        unsigned loff = (unsigned)(fr * 1024 + 8 * fq);
        asm volatile("" : "+v"(loff));
        const GAS bf16_t* hb = (const GAS bf16_t*)(xb + ubase); const GAS unsigned char* qb_ = (const GAS unsigned char*)(xq + ubase);
#pragma unroll
        for (int ai = 0; ai < 2; ++ai)
#pragma unroll
            for (int m = 0; m < 4; ++m)
#pragma unroll
                for (int bj = 0; bj < 2; ++bj) { const unsigned o = (unsigned)((ai * 128 + m * 16) * 1024 + bj * 128) + loff;
                    const u32x4 h = *(const GAS u32x4*)(hb + o); const u32x2 q = *(const GAS u32x2*)(qb_ + o);
                    xdeq8(h, q, acc[ai][bj][m][0], acc[ai][bj][m][1]); }
    }
    __device__ __forceinline__ void operator()(AccRef acc, const pg8::Unit& u, int wr, int wc, int fr, int fq, const LAS unsigned char* sl) const {
        const size_t ubase = (size_t)(u.pm * 256 + wr * 64) * 1024 + u.pn * 256 + wc * 32;
        unsigned loff = (unsigned)(fr * 1024 + 8 * fq);
        asm volatile("" : "+v"(loff));
        GAS bf16_t* hb = (GAS bf16_t*)(xb + ubase); GAS unsigned char* qb_ = (GAS unsigned char*)(xq + ubase);
#pragma unroll
        for (int ai = 0; ai < 2; ++ai)
#pragma unroll
            for (int m = 0; m < 4; ++m) { float s = 0.f;
#pragma unroll
                for (int bj = 0; bj < 2; ++bj) { const unsigned o = (unsigned)((ai * 128 + m * 16) * 1024 + bj * 128) + loff;
                    const f32x4 v0 = acc[ai][bj][m][0], v1 = acc[ai][bj][m][1];
                    const u32x4 h = pack8(v0, v1); u32x2 q; q.x = xquant4(v0, h.x, h.y); q.y = xquant4(v1, h.z, h.w);
                    *(GAS u32x4*)(hb + o) = h; *(GAS u32x2*)(qb_ + o) = q; s += sq4(v0) + sq4(v1); }
                s = quad_sum(s); if (fq == 0) ((GAS float*)ssq)[(size_t)(u.pm * 256 + ai * 128 + wr * 64 + m * 16 + fr) * 16 + u.pn * 4 + wc] = s; }
    }
};

struct EpiNull {
    static constexpr bool PERM = true, ACC_INIT = false, PREF = false, KEEP = false;
    __device__ __forceinline__ void operator()(AccRef acc, const pg8::Unit& u, int wr, int wc, int fr, int fq, const LAS unsigned char* sl) const {
#pragma unroll
        for (int ai = 0; ai < 2; ++ai)
#pragma unroll
            for (int bj = 0; bj < 2; ++bj)
#pragma unroll
                for (int m = 0; m < 4; ++m)
#pragma unroll
                    for (int n = 0; n < 2; ++n) asm volatile("" :: "v"(acc[ai][bj][m][n]));
    }
};
struct EpiGU {
    static constexpr bool PERM = true, ACC_INIT = false, PREF = true, KEEP = false;
    __device__ __forceinline__ const float* stat_base() const { return ssq; }
    const float* ssq; bf16_t* act;
    __device__ __forceinline__ void operator()(AccRef acc, const pg8::Unit& u, int wr, int wc, int fr, int fq, const LAS unsigned char* sl) const {
        float rs[2][4];
        ROWSTAT8(rs, ssq, 1.0f / 1024.0f, 1.0f);
#pragma unroll
        for (int ai = 0; ai < 2; ++ai)
#pragma unroll
            for (int m = 0; m < 4; ++m) {
                const int row = u.pm * 256 + ai * 128 + wr * 64 + m * 16 + fr;
                const float r_ = rs[ai][m];
                const f32x4 g0 = acc[ai][0][m][0] * r_, g1 = acc[ai][0][m][1] * r_, u0 = acc[ai][1][m][0] * r_, u1 = acc[ai][1][m][1] * r_;
                const f32x4 a0 = g0 * sig4(g0) * u0, a1 = g1 * sig4(g1) * u1;
                *(GAS u32x4*)(act + (size_t)row * DFF + u.pn * 128 + wc * 32 + 8 * fq) = pack8(a0, a1);
            }
    }
};

typedef short v4i16_t __attribute__((ext_vector_type(4)));
__device__ __forceinline__ v4i16_t vtr(const LAS unsigned char* p) { return __builtin_amdgcn_ds_read_tr16_b64_v4i16((LAS v4i16_t*)p); }
__device__ __forceinline__ float swap32_max(float m) { auto rr = __builtin_amdgcn_permlane32_swap(__float_as_uint(m), __float_as_uint(m), false, false); return fmaxf(__uint_as_float(rr[0]), __uint_as_float(rr[1])); }
__device__ __forceinline__ float swap32_add(float m) { auto rr = __builtin_amdgcn_permlane32_swap(__float_as_uint(m), __float_as_uint(m), false, false); return __uint_as_float(rr[0]) + __uint_as_float(rr[1]); }
template <int DQK, int DV, int MODE>
__device__ __forceinline__ void attn_unit(LAS unsigned char* lds, const int tid, const bf16_t* Qg, int ldq, const bf16_t* Kg, int ldk, const bf16_t* K2g,
                                          const bf16_t* Vg, int ldv, bf16_t* Og, int ldo, int qbase, int NT, const float* kbar, int cur, bool stage = true) {
    constexpr int KS = DQK + 8;
    constexpr int KBUF = 64 * KS * 2, VBUF = (DV / 32) * 4096, NB = (MODE == 2) ? 4 : 2;
    constexpr int KMAIN = (MODE == 1) ? 64 : DQK;
    constexpr int KCH = KMAIN / 8, NK = (64 * KCH) / 512, VCH = DV / 8, NV = (64 * VCH) / 512;
    constexpr int NJ = DQK / 16, ND = DV / 32;
    constexpr float THR = 8.0f;
    const int lane = tid & 63, wid = __builtin_amdgcn_readfirstlane(tid >> 6), r32 = lane & 31, hi = lane >> 5;
    bf16x8 qf[NJ];
    { const bf16_t* qrow = Qg + (size_t)(wid * 32 + r32) * ldq + 8 * hi;
#pragma unroll
      for (int j = 0; j < NJ; ++j) qf[j] = *(const GAS bf16x8*)(qrow + 16 * j); }
    float zf = 0.f; asm volatile("" : "+v"(zf)); const unsigned zu = __float_as_uint(zf);
    u32x4 kreg[2][NK], vreg[2][NV], k2reg[2] = {{zu, zu, zu, zu}, {zu, zu, zu, zu}};
#define ATT_LOAD(t, S) do { \
    _Pragma("unroll") for (int i = 0; i < NK; ++i) { const int idx = tid + 512 * i, kv = idx / KCH, c = idx % KCH; kreg[S][i] = *(const GAS u32x4*)(Kg + (size_t)(64 * (t) + kv) * ldk + 8 * c); } \
    if (MODE == 1) { if (tid < 256) k2reg[S] = *(const GAS u32x4*)(K2g + (size_t)(64 * (t) + (tid >> 2)) * 32 + 8 * (tid & 3)); } \
    _Pragma("unroll") for (int i = 0; i < NV; ++i) { const int idx = tid + 512 * i, kv = idx / VCH, c = idx % VCH; vreg[S][i] = *(const GAS u32x4*)(Vg + (size_t)(64 * (t) + kv) * ldv + 8 * c); } } while (0)
#define ATT_STORE(buf, S) do { LAS unsigned char* kb_ = lds + (buf) * KBUF; LAS unsigned char* vb_ = lds + NB * KBUF + (buf) * VBUF; \
    _Pragma("unroll") for (int i = 0; i < NK; ++i) { const int idx = tid + 512 * i, kv = idx / KCH, c = idx % KCH; *(LAS u32x4*)(kb_ + (kv * KS + 8 * c) * 2) = kreg[S][i]; } \
    if (MODE == 1) { if (tid < 256) *(LAS u32x4*)(kb_ + ((tid >> 2) * KS + 64 + 8 * (tid & 3)) * 2) = k2reg[S]; } \
    _Pragma("unroll") for (int i = 0; i < NV; ++i) { const int idx = tid + 512 * i, kv = idx / VCH, c = idx % VCH; *(LAS u32x4*)(vb_ + (c >> 2) * 4096 + kv * 64 + (c & 3) * 16) = vreg[S][i]; } } while (0)
#define ATT_BAR() asm volatile("s_waitcnt lgkmcnt(0)\n\ts_barrier" ::: "memory")
    if (MODE != 2) { ATT_LOAD(0, 0); ATT_LOAD(1, 1); }
    unsigned selmask = 0xffu;
    if (MODE == 0 && cur > 3) {
        float g[7];
#pragma unroll
        for (int j = 0; j < 7; ++j) {
            float a = 0.f;
            if (j < cur) {
#pragma unroll
                for (int jj = 0; jj < 4; ++jj) {
                    const f32x4 k0 = *(const GAS f32x4*)(kbar + j * 64 + 16 * jj + 8 * hi), k1 = *(const GAS f32x4*)(kbar + j * 64 + 16 * jj + 8 * hi + 4);
                    a += bf2f((unsigned short)qf[jj][0]) * k0.x + bf2f((unsigned short)qf[jj][1]) * k0.y + bf2f((unsigned short)qf[jj][2]) * k0.z + bf2f((unsigned short)qf[jj][3]) * k0.w
                       + bf2f((unsigned short)qf[jj][4]) * k1.x + bf2f((unsigned short)qf[jj][5]) * k1.y + bf2f((unsigned short)qf[jj][6]) * k1.z + bf2f((unsigned short)qf[jj][7]) * k1.w;
                }
                a = swap32_add(a);
            }
            g[j] = a;
        }
        unsigned sm = 0u;
#pragma unroll
        for (int j = 0; j < 7; ++j) {
            int rank = 0;
#pragma unroll
            for (int i = 0; i < 7; ++i) if (i != j) rank += (i < cur && (g[i] > g[j] || (g[i] == g[j] && i < j))) ? 1 : 0;
            if (j < cur && rank < 3) sm |= (1u << j);
        }
        selmask = sm | (1u << cur);
    }
    if (MODE != 2) { ATT_STORE(0, 0); ATT_BAR(); }
    else if (stage) {
        ATT_BAR();
        ATT_LOAD(0, 0); ATT_LOAD(1, 1); ATT_STORE(0, 0); ATT_LOAD(2, 0); ATT_STORE(1, 1); ATT_LOAD(3, 1); ATT_STORE(2, 0); ATT_STORE(3, 1);
        ATT_BAR();
    }
    f32x16 o[ND];
#pragma unroll
    for (int d0 = 0; d0 < ND; ++d0)
#pragma unroll
        for (int r = 0; r < 16; ++r) o[d0][r] = zf;
    float mref = zf, lrun = zf;
    const int qabs = qbase + wid * 32 + r32;
    const int qwmax = qbase + wid * 32 + 31;
    const int vlane = (4 * hi + ((lane & 15) >> 2)) * 64 + ((lane >> 4) & 1) * 32 + (lane & 3) * 8;
    if constexpr (MODE == 2) {
    for (int t = 0; t < 4; ++t) { const int buf = t;
        bool lane_ok = true, causal = false, active = true;
        if (MODE == 0) { const int blk = t >> 2; if (blk < cur) lane_ok = ((selmask >> blk) & 1u) != 0u; else causal = (64 * t + 63 > qbase + wid * 32); active = (__any(lane_ok ? 1 : 0) != 0) && (64 * t <= qwmax); }
        if (MODE == 1) { causal = (64 * t + 63 > qbase + wid * 32); active = (64 * t <= qwmax); }
        if (active) {
            const LAS unsigned char* kb = lds + buf * KBUF + (r32 * KS + 8 * hi) * 2;
            const float cin = (MODE == 0 && !lane_ok) ? -INFINITY : -mref;
            f32x16 s0, s1;
#pragma unroll
            for (int r = 0; r < 16; ++r) { s0[r] = cin; s1[r] = cin; }
#pragma unroll
            for (int j = 0; j < NJ; ++j) {
                const bf16x8 k0 = *(const LAS bf16x8*)(kb + j * 32), k1 = *(const LAS bf16x8*)(kb + 32 * KS * 2 + j * 32);
                s0 = __builtin_amdgcn_mfma_f32_32x32x16_bf16(k0, qf[j], s0, 0, 0, 0);
                s1 = __builtin_amdgcn_mfma_f32_32x32x16_bf16(k1, qf[j], s1, 0, 0, 0);
            }
            const LAS unsigned char* vb = lds + NB * KBUF + buf * VBUF + vlane;
            constexpr int NPF = (MODE == 2) ? 0 : 2;
            v4i16_t vpa[2][4], vpb[2][4];
#pragma unroll
            for (int d0 = 0; d0 < NPF; ++d0)
#pragma unroll
                for (int kk = 0; kk < 4; ++kk) { vpa[d0][kk] = vtr(vb + d0 * 4096 + kk * 1024); vpb[d0][kk] = vtr(vb + d0 * 4096 + kk * 1024 + 512); }
            if (MODE != 2) {
                if (causal) {
                    const int kb0 = 64 * t + 4 * hi;
#pragma unroll
                    for (int r = 0; r < 16; ++r) { const int kv = kb0 + (r & 3) + 8 * (r >> 2); if (kv > qabs) s0[r] = -INFINITY; if (kv + 32 > qabs) s1[r] = -INFINITY; }
                }
            }
            float mxa = fmaxf(fmaxf(s0[0], s0[1]), s1[0]), mxb = fmaxf(fmaxf(s0[2], s0[3]), s1[1]);
            mxa = fmaxf(fmaxf(mxa, s1[2]), s1[3]);
#pragma unroll
            for (int r = 4; r < 16; r += 4) { mxa = fmaxf(fmaxf(mxa, s0[r]), s0[r + 1]); mxb = fmaxf(fmaxf(mxb, s0[r + 2]), s0[r + 3]); mxa = fmaxf(fmaxf(mxa, s1[r]), s1[r + 1]); mxb = fmaxf(fmaxf(mxb, s1[r + 2]), s1[r + 3]); }
            float mx = fmaxf(mxa, mxb);
            mx = swap32_max(mx);
            if (__any(mx > THR ? 1 : 0)) {
                const float dl = (mx > THR) ? mx : 0.f;
                mref += dl;
#pragma unroll
                for (int r = 0; r < 16; ++r) { s0[r] -= dl; s1[r] -= dl; }
                const float alpha = __builtin_amdgcn_exp2f(-dl);
                lrun *= alpha;
#pragma unroll
                for (int d0 = 0; d0 < ND; ++d0)
#pragma unroll
                    for (int r = 0; r < 16; ++r) o[d0][r] *= alpha;
            }
            float psa = 0.f, psb = 0.f;
#pragma unroll
            for (int r = 0; r < 16; ++r) { s0[r] = __builtin_amdgcn_exp2f(s0[r]); s1[r] = __builtin_amdgcn_exp2f(s1[r]); psa += s0[r]; psb += s1[r]; }
            lrun += psa + psb;
            bf16x8 pb[4];
            { u32x4 w;
              w.x = cvt_pk_bf16(s0[0], s0[1]); w.y = cvt_pk_bf16(s0[2], s0[3]); w.z = cvt_pk_bf16(s0[4], s0[5]); w.w = cvt_pk_bf16(s0[6], s0[7]); pb[0] = __builtin_bit_cast(bf16x8, w);
              w.x = cvt_pk_bf16(s0[8], s0[9]); w.y = cvt_pk_bf16(s0[10], s0[11]); w.z = cvt_pk_bf16(s0[12], s0[13]); w.w = cvt_pk_bf16(s0[14], s0[15]); pb[1] = __builtin_bit_cast(bf16x8, w);
              w.x = cvt_pk_bf16(s1[0], s1[1]); w.y = cvt_pk_bf16(s1[2], s1[3]); w.z = cvt_pk_bf16(s1[4], s1[5]); w.w = cvt_pk_bf16(s1[6], s1[7]); pb[2] = __builtin_bit_cast(bf16x8, w);
              w.x = cvt_pk_bf16(s1[8], s1[9]); w.y = cvt_pk_bf16(s1[10], s1[11]); w.z = cvt_pk_bf16(s1[12], s1[13]); w.w = cvt_pk_bf16(s1[14], s1[15]); pb[3] = __builtin_bit_cast(bf16x8, w); }
#pragma unroll
            for (int d0 = 0; d0 < ND; ++d0)
#pragma unroll
                for (int kk = 0; kk < 4; ++kk) {
                    v4i16_t a, b;
                    if (d0 < NPF) { a = vpa[d0 & 1][kk]; b = vpb[d0 & 1][kk]; } else { a = vtr(vb + d0 * 4096 + kk * 1024); b = vtr(vb + d0 * 4096 + kk * 1024 + 512); }
                    const bf16x8 vf = {a[0], a[1], a[2], a[3], b[0], b[1], b[2], b[3]};
                    o[d0] = __builtin_amdgcn_mfma_f32_32x32x16_bf16(vf, pb[kk], o[d0], 0, 0, 0);
                }
        }
    }
    } else {
    for (int t2 = 0; t2 < NT; t2 += 2) {
      { const int t = t2; const int buf = 0;
        if (t + 2 < NT) ATT_LOAD(t + 2, 0);
        bool lane_ok = true, causal = false, active = true;
        if (MODE == 0) { const int blk = t >> 2; if (blk < cur) lane_ok = ((selmask >> blk) & 1u) != 0u; else causal = (64 * t + 63 > qbase + wid * 32); active = (__any(lane_ok ? 1 : 0) != 0) && (64 * t <= qwmax); }
        if (MODE == 1) { causal = (64 * t + 63 > qbase + wid * 32); active = (64 * t <= qwmax); }
        if (active) {
            const LAS unsigned char* kb = lds + buf * KBUF + (r32 * KS + 8 * hi) * 2;
            const float cin = (MODE == 0 && !lane_ok) ? -INFINITY : -mref;
            f32x16 s0, s1;
#pragma unroll
            for (int r = 0; r < 16; ++r) { s0[r] = cin; s1[r] = cin; }
#pragma unroll
            for (int j = 0; j < NJ; ++j) {
                const bf16x8 k0 = *(const LAS bf16x8*)(kb + j * 32), k1 = *(const LAS bf16x8*)(kb + 32 * KS * 2 + j * 32);
                s0 = __builtin_amdgcn_mfma_f32_32x32x16_bf16(k0, qf[j], s0, 0, 0, 0);
                s1 = __builtin_amdgcn_mfma_f32_32x32x16_bf16(k1, qf[j], s1, 0, 0, 0);
            }
            const LAS unsigned char* vb = lds + NB * KBUF + buf * VBUF + vlane;
            constexpr int NPF = (MODE == 2) ? 0 : 2;
            v4i16_t vpa[2][4], vpb[2][4];
#pragma unroll
            for (int d0 = 0; d0 < NPF; ++d0)
#pragma unroll
                for (int kk = 0; kk < 4; ++kk) { vpa[d0][kk] = vtr(vb + d0 * 4096 + kk * 1024); vpb[d0][kk] = vtr(vb + d0 * 4096 + kk * 1024 + 512); }
            if (MODE != 2) {
                if (causal) {
                    const int kb0 = 64 * t + 4 * hi;
#pragma unroll
                    for (int r = 0; r < 16; ++r) { const int kv = kb0 + (r & 3) + 8 * (r >> 2); if (kv > qabs) s0[r] = -INFINITY; if (kv + 32 > qabs) s1[r] = -INFINITY; }
                }
            }
            float mxa = fmaxf(fmaxf(s0[0], s0[1]), s1[0]), mxb = fmaxf(fmaxf(s0[2], s0[3]), s1[1]);
            mxa = fmaxf(fmaxf(mxa, s1[2]), s1[3]);
#pragma unroll
            for (int r = 4; r < 16; r += 4) { mxa = fmaxf(fmaxf(mxa, s0[r]), s0[r + 1]); mxb = fmaxf(fmaxf(mxb, s0[r + 2]), s0[r + 3]); mxa = fmaxf(fmaxf(mxa, s1[r]), s1[r + 1]); mxb = fmaxf(fmaxf(mxb, s1[r + 2]), s1[r + 3]); }
            float mx = fmaxf(mxa, mxb);
            mx = swap32_max(mx);
            if (__any(mx > THR ? 1 : 0)) {
                const float dl = (mx > THR) ? mx : 0.f;
                mref += dl;
#pragma unroll
                for (int r = 0; r < 16; ++r) { s0[r] -= dl; s1[r] -= dl; }
                const float alpha = __builtin_amdgcn_exp2f(-dl);
                lrun *= alpha;
#pragma unroll
                for (int d0 = 0; d0 < ND; ++d0)
#pragma unroll
                    for (int r = 0; r < 16; ++r) o[d0][r] *= alpha;
            }
            float psa = 0.f, psb = 0.f;
#pragma unroll
            for (int r = 0; r < 16; ++r) { s0[r] = __builtin_amdgcn_exp2f(s0[r]); s1[r] = __builtin_amdgcn_exp2f(s1[r]); psa += s0[r]; psb += s1[r]; }
            lrun += psa + psb;
            bf16x8 pb[4];
            { u32x4 w;
              w.x = cvt_pk_bf16(s0[0], s0[1]); w.y = cvt_pk_bf16(s0[2], s0[3]); w.z = cvt_pk_bf16(s0[4], s0[5]); w.w = cvt_pk_bf16(s0[6], s0[7]); pb[0] = __builtin_bit_cast(bf16x8, w);
              w.x = cvt_pk_bf16(s0[8], s0[9]); w.y = cvt_pk_bf16(s0[10], s0[11]); w.z = cvt_pk_bf16(s0[12], s0[13]); w.w = cvt_pk_bf16(s0[14], s0[15]); pb[1] = __builtin_bit_cast(bf16x8, w);
              w.x = cvt_pk_bf16(s1[0], s1[1]); w.y = cvt_pk_bf16(s1[2], s1[3]); w.z = cvt_pk_bf16(s1[4], s1[5]); w.w = cvt_pk_bf16(s1[6], s1[7]); pb[2] = __builtin_bit_cast(bf16x8, w);
              w.x = cvt_pk_bf16(s1[8], s1[9]); w.y = cvt_pk_bf16(s1[10], s1[11]); w.z = cvt_pk_bf16(s1[12], s1[13]); w.w = cvt_pk_bf16(s1[14], s1[15]); pb[3] = __builtin_bit_cast(bf16x8, w); }
#pragma unroll
            for (int d0 = 0; d0 < ND; ++d0)
#pragma unroll
                for (int kk = 0; kk < 4; ++kk) {
                    v4i16_t a, b;
                    if (d0 < NPF) { a = vpa[d0 & 1][kk]; b = vpb[d0 & 1][kk]; } else { a = vtr(vb + d0 * 4096 + kk * 1024); b = vtr(vb + d0 * 4096 + kk * 1024 + 512); }
                    const bf16x8 vf = {a[0], a[1], a[2], a[3], b[0], b[1], b[2], b[3]};
                    o[d0] = __builtin_amdgcn_mfma_f32_32x32x16_bf16(vf, pb[kk], o[d0], 0, 0, 0);
                }
        }
        ATT_STORE(1, 1);
        ATT_BAR();
      }
      { const int t = t2 + 1; const int buf = 1;
        if (t + 2 < NT) ATT_LOAD(t + 2, 1);
        bool lane_ok = true, causal = false, active = true;
        if (MODE == 0) { const int blk = t >> 2; if (blk < cur) lane_ok = ((selmask >> blk) & 1u) != 0u; else causal = (64 * t + 63 > qbase + wid * 32); active = (__any(lane_ok ? 1 : 0) != 0) && (64 * t <= qwmax); }
        if (MODE == 1) { causal = (64 * t + 63 > qbase + wid * 32); active = (64 * t <= qwmax); }
        if (active) {
            const LAS unsigned char* kb = lds + buf * KBUF + (r32 * KS + 8 * hi) * 2;
            const float cin = (MODE == 0 && !lane_ok) ? -INFINITY : -mref;
            f32x16 s0, s1;
#pragma unroll
            for (int r = 0; r < 16; ++r) { s0[r] = cin; s1[r] = cin; }
#pragma unroll
            for (int j = 0; j < NJ; ++j) {
                const bf16x8 k0 = *(const LAS bf16x8*)(kb + j * 32), k1 = *(const LAS bf16x8*)(kb + 32 * KS * 2 + j * 32);
                s0 = __builtin_amdgcn_mfma_f32_32x32x16_bf16(k0, qf[j], s0, 0, 0, 0);
                s1 = __builtin_amdgcn_mfma_f32_32x32x16_bf16(k1, qf[j], s1, 0, 0, 0);
            }
            const LAS unsigned char* vb = lds + NB * KBUF + buf * VBUF + vlane;
            constexpr int NPF = (MODE == 2) ? 0 : 2;
            v4i16_t vpa[2][4], vpb[2][4];
#pragma unroll
            for (int d0 = 0; d0 < NPF; ++d0)
#pragma unroll
                for (int kk = 0; kk < 4; ++kk) { vpa[d0][kk] = vtr(vb + d0 * 4096 + kk * 1024); vpb[d0][kk] = vtr(vb + d0 * 4096 + kk * 1024 + 512); }
            if (MODE != 2) {
                if (causal) {
                    const int kb0 = 64 * t + 4 * hi;
#pragma unroll
                    for (int r = 0; r < 16; ++r) { const int kv = kb0 + (r & 3) + 8 * (r >> 2); if (kv > qabs) s0[r] = -INFINITY; if (kv + 32 > qabs) s1[r] = -INFINITY; }
                }
            }
            float mxa = fmaxf(fmaxf(s0[0], s0[1]), s1[0]), mxb = fmaxf(fmaxf(s0[2], s0[3]), s1[1]);
            mxa = fmaxf(fmaxf(mxa, s1[2]), s1[3]);
#pragma unroll
            for (int r = 4; r < 16; r += 4) { mxa = fmaxf(fmaxf(mxa, s0[r]), s0[r + 1]); mxb = fmaxf(fmaxf(mxb, s0[r + 2]), s0[r + 3]); mxa = fmaxf(fmaxf(mxa, s1[r]), s1[r + 1]); mxb = fmaxf(fmaxf(mxb, s1[r + 2]), s1[r + 3]); }
            float mx = fmaxf(mxa, mxb);
            mx = swap32_max(mx);
            if (__any(mx > THR ? 1 : 0)) {
                const float dl = (mx > THR) ? mx : 0.f;
                mref += dl;
#pragma unroll
                for (int r = 0; r < 16; ++r) { s0[r] -= dl; s1[r] -= dl; }
                const float alpha = __builtin_amdgcn_exp2f(-dl);
                lrun *= alpha;
#pragma unroll
                for (int d0 = 0; d0 < ND; ++d0)
#pragma unroll
                    for (int r = 0; r < 16; ++r) o[d0][r] *= alpha;
            }
            float psa = 0.f, psb = 0.f;
#pragma unroll
            for (int r = 0; r < 16; ++r) { s0[r] = __builtin_amdgcn_exp2f(s0[r]); s1[r] = __builtin_amdgcn_exp2f(s1[r]); psa += s0[r]; psb += s1[r]; }
            lrun += psa + psb;
            bf16x8 pb[4];
            { u32x4 w;
              w.x = cvt_pk_bf16(s0[0], s0[1]); w.y = cvt_pk_bf16(s0[2], s0[3]); w.z = cvt_pk_bf16(s0[4], s0[5]); w.w = cvt_pk_bf16(s0[6], s0[7]); pb[0] = __builtin_bit_cast(bf16x8, w);
              w.x = cvt_pk_bf16(s0[8], s0[9]); w.y = cvt_pk_bf16(s0[10], s0[11]); w.z = cvt_pk_bf16(s0[12], s0[13]); w.w = cvt_pk_bf16(s0[14], s0[15]); pb[1] = __builtin_bit_cast(bf16x8, w);
              w.x = cvt_pk_bf16(s1[0], s1[1]); w.y = cvt_pk_bf16(s1[2], s1[3]); w.z = cvt_pk_bf16(s1[4], s1[5]); w.w = cvt_pk_bf16(s1[6], s1[7]); pb[2] = __builtin_bit_cast(bf16x8, w);
              w.x = cvt_pk_bf16(s1[8], s1[9]); w.y = cvt_pk_bf16(s1[10], s1[11]); w.z = cvt_pk_bf16(s1[12], s1[13]); w.w = cvt_pk_bf16(s1[14], s1[15]); pb[3] = __builtin_bit_cast(bf16x8, w); }
#pragma unroll
            for (int d0 = 0; d0 < ND; ++d0)
#pragma unroll
                for (int kk = 0; kk < 4; ++kk) {
                    v4i16_t a, b;
                    if (d0 < NPF) { a = vpa[d0 & 1][kk]; b = vpb[d0 & 1][kk]; } else { a = vtr(vb + d0 * 4096 + kk * 1024); b = vtr(vb + d0 * 4096 + kk * 1024 + 512); }
                    const bf16x8 vf = {a[0], a[1], a[2], a[3], b[0], b[1], b[2], b[3]};
                    o[d0] = __builtin_amdgcn_mfma_f32_32x32x16_bf16(vf, pb[kk], o[d0], 0, 0, 0);
                }
        }
        if (t + 1 < NT) ATT_STORE(0, 0);
        ATT_BAR();
      }
    }
    }
#undef ATT_LOAD
#undef ATT_STORE
#undef ATT_BAR
    lrun = swap32_add(lrun);
    const float inv = 1.0f / lrun;
    bf16_t* orow = Og + (size_t)(wid * 32 + r32) * ldo + 4 * hi;
#pragma unroll
    for (int d0 = 0; d0 < ND; ++d0)
#pragma unroll
        for (int rg = 0; rg < 4; ++rg) {
            u32x2 w; w.x = cvt_pk_bf16(o[d0][4 * rg] * inv, o[d0][4 * rg + 1] * inv); w.y = cvt_pk_bf16(o[d0][4 * rg + 2] * inv, o[d0][4 * rg + 3] * inv);
            *(GAS u32x2*)(orow + 32 * d0 + 8 * rg) = w;
        }
}

__device__ __forceinline__ float wave_sum(float v) {
#pragma unroll
    for (int o = 1; o < 64; o <<= 1) v += __shfl_xor(v, o);
    return v;
}
template <class MapFn>
__device__ __forceinline__ void transpose_item(const float* W, int K, int N, bf16_t* WT, const float* gain, LAS float* scr, int item, int lane, MapFn map) {
    const int nblk = N / 32, kb = item / nblk, nb = item % nblk, k0 = 64 * kb, n0 = 32 * nb;
    f32x4 w[8]; float gv[8];
#pragma unroll
    for (int i = 0; i < 8; ++i) { const int kk = 8 * i + (lane >> 3); w[i] = *(const GAS f32x4*)(W + (size_t)(k0 + kk) * N + n0 + 4 * (lane & 7)); gv[i] = gain ? ((const GAS float*)gain)[k0 + kk] : 1.0f; }
#pragma unroll
    for (int i = 0; i < 8; ++i) { const int kk = 8 * i + (lane >> 3); LAS float* d = scr + kk * 33 + 4 * (lane & 7); const f32x4 v = w[i] * gv[i]; d[0] = v.x; d[1] = v.y; d[2] = v.z; d[3] = v.w; }
    asm volatile("s_waitcnt lgkmcnt(0)" ::: "memory");
    const int c = lane & 7;
#pragma unroll
    for (int j = 0; j < 4; ++j) { const int n = (lane >> 3) + 8 * j; const LAS float* s = scr + (8 * c) * 33 + n;
        u32x4 o; o.x = cvt_pk_bf16(s[0 * 33], s[1 * 33]); o.y = cvt_pk_bf16(s[2 * 33], s[3 * 33]); o.z = cvt_pk_bf16(s[4 * 33], s[5 * 33]); o.w = cvt_pk_bf16(s[6 * 33], s[7 * 33]);
        *(GAS u32x4*)(WT + (size_t)map(n0 + n) * K + k0 + 8 * c) = o; }
    asm volatile("s_waitcnt lgkmcnt(0)" ::: "memory");
}
__device__ __forceinline__ int map_in(int n) {
    if (n < 1024) { const int base = n & 512, mm = n & 511, head = mm >> 6, e = mm & 63; return base + 256 * (head >> 2) + 128 * (e >> 5) + 32 * (head & 3) + (e & 31); }
    if (n < 1920) return n;
    if (n < 2176) return 2048 + (n - 1920);
    if (n < 2208) return 1920 + (n - 2176);
    { const int a = (n - 2208) & 1023, gb = (n - 2208) >> 10; return 2304 + 256 * (a >> 7) + 128 * gb + (a & 127); }
}
__device__ __forceinline__ int map_uq(int n) { const int head = n / 96, e = n % 96; if (e < 64) return 64 * head + e; const int r = e - 64; return 512 + 128 * (r >> 4) + 16 * head + (r & 15); }
__device__ __forceinline__ int map_gu(int n) { if (n < DFF) return 256 * (n >> 7) + (n & 127); const int a = n - DFF; return 256 * (a >> 7) + 128 + (a & 127); }
__device__ __forceinline__ int map_id(int n) { return n; }

#define XB_TMO      128
#define XB_XCNT(j)  (256  + 64 * (j))
#define XB_XSUB(j)  (1280 + 64 * (j))
#define XB_XGEN(j)  (2304 + 64 * (j))
#define XB_TOP      3328
#define XB_TOPGEN   3392
#define XCD_BAR_WORDS 3456
#define XB_SPIN_CAP (1u << 18)
__device__ __forceinline__ unsigned xb_ld(unsigned* p)              { return __hip_atomic_load(p, __ATOMIC_RELAXED, __HIP_MEMORY_SCOPE_AGENT); }
__device__ __forceinline__ unsigned xb_add(unsigned* p, unsigned v) { return __hip_atomic_fetch_add(p, v, __ATOMIC_RELAXED, __HIP_MEMORY_SCOPE_AGENT); }
__device__ __forceinline__ unsigned xb_xcc_id() { return (unsigned)__builtin_amdgcn_s_getreg((3 << 11) | 20) & 0xFu; }
#define XB_SPIN(cond, bar) do { unsigned _sp = 0; while (cond) { __builtin_amdgcn_s_sleep(1); \
    if ((++_sp & 255u) == 0u) { if (xb_ld(&(bar)[XB_TMO])) break; if (_sp > XB_SPIN_CAP) { atomicAdd(&(bar)[XB_TMO], 1u); break; } } } } while (0)
struct XcdBarrier { unsigned* bar; unsigned x; volatile LAS unsigned* st; };
__device__ __forceinline__ XcdBarrier xcd_barrier_post(unsigned* bar, volatile LAS unsigned* st) {
    XcdBarrier b; b.bar = bar; b.x = xb_xcc_id(); b.st = st;
    if (threadIdx.x == 0) (void)xb_add(&bar[XB_XCNT(b.x)], 1u);
    return b;
}
__device__ __forceinline__ void xcd_barrier_complete(unsigned* bar, unsigned x, unsigned& nloc, unsigned& nx) {
    const unsigned G = gridDim.x * gridDim.y * gridDim.z;
    unsigned sum, cnt, mine, sp = 0u;
    for (;;) {
        sum = 0u; cnt = 0u; mine = 0u;
#pragma unroll
        for (unsigned j = 0; j < 16; ++j) { const unsigned c = xb_ld(&bar[XB_XCNT(j)]); sum += c; cnt += (c > 0u) ? 1u : 0u; mine = (j == x) ? c : mine; }
        if (sum == G) break;
        __builtin_amdgcn_s_sleep(1);
        if ((++sp & 255u) == 0u) { if (xb_ld(&bar[XB_TMO])) break; if (sp > XB_SPIN_CAP) { atomicAdd(&bar[XB_TMO], 1u); break; } }
    }
    nloc = mine > 0u ? mine : 1u; nx = cnt > 0u ? cnt : 1u;
}
__device__ __forceinline__ void xcd_barrier(const XcdBarrier& b) {
    asm volatile("s_waitcnt vmcnt(0)" ::: "memory");
    __syncthreads();
    if (threadIdx.x == 0) {
        unsigned* bar = b.bar;
        __builtin_amdgcn_s_waitcnt(0);
        unsigned nloc = b.st[0], nx = b.st[1];
        if (nloc == 0u) { xcd_barrier_complete(bar, b.x, nloc, nx); b.st[0] = nloc; b.st[1] = nx; }
        const unsigned old = xb_add(&bar[XB_XSUB(b.x)], 1u);
        const unsigned gen = old / nloc;
        if (old + 1u == (gen + 1u) * nloc) {
            __builtin_amdgcn_fence(__ATOMIC_RELEASE, "agent");
            asm volatile("s_waitcnt vmcnt(0)" ::: "memory");
            const unsigned og = xb_add(&bar[XB_TOP], 1u);
            const unsigned tg = og / nx;
            if (og + 1u == (tg + 1u) * nx) xb_add(&bar[XB_TOPGEN], 1u);
            else XB_SPIN(xb_ld(&bar[XB_TOPGEN]) == tg, bar);
            __builtin_amdgcn_fence(__ATOMIC_ACQUIRE, "agent");
            xb_add(&bar[XB_XGEN(b.x)], 1u);
            asm volatile("s_waitcnt vmcnt(0)" ::: "memory");
        } else {
            XB_SPIN(xb_ld(&bar[XB_XGEN(b.x)]) == gen, bar);
            __builtin_amdgcn_fence(__ATOMIC_ACQUIRE, "agent");
            asm volatile("s_waitcnt vmcnt(0)" ::: "memory");
        }
    }
    __syncthreads();
}

struct Args {
    const float* x; const float* mem; const int* pos;
    const float* norm_mix; const float* w_in; const float* q_lat_norm; const float* w_uq; const float* kv_lat_norm; const float* w_ukv;
    const float* w_ba; const float* w_bb; const float* w_out; const float* norm_x; const float* norm_mem; const float* w_xq; const float* w_xkv; const float* w_xo;
    const float* norm_ffn; const float* w_gu; const float* w_dn; const float* norm_final;
    float* out; unsigned char* ws; int ph_lo, ph_hi;
};

constexpr int PH_PER_LAYER = 11, N_PHASES = DEPTH * PH_PER_LAYER + 1;
constexpr int LDS_TOTAL = pg8::STAGE_BYTES + 16384;

__global__ void __launch_bounds__(512, 2) fwd_kernel(Args a_in) {
    __shared__ __attribute__((aligned(16))) unsigned char lds_raw[LDS_TOTAL];
    LAS unsigned char* lds = (LAS unsigned char*)lds_raw;
    const int ph_lo = a_in.ph_lo, ph_hi = a_in.ph_hi;
    __shared__ __attribute__((aligned(16))) unsigned bar_st[4];
    __shared__ unsigned long long tacc[2];
    if (threadIdx.x == 0) { tacc[0] = 0ull; tacc[1] = 0ull; }
    if (threadIdx.x < 4) bar_st[threadIdx.x] = 0u;
    __syncthreads();
    XcdBarrier bar; bar.bar = (unsigned*)(a_in.ws + WS_CTL); bar.x = 0; bar.st = (volatile LAS unsigned*)bar_st;
    if (ph_hi - ph_lo > 1) bar = xcd_barrier_post((unsigned*)(a_in.ws + WS_CTL), (volatile LAS unsigned*)bar_st);
    for (int ph = ph_lo; ph < ph_hi; ++ph) {
        if (ph > ph_lo) { if (ph == ph_lo + 1) cg::this_grid().sync(); else xcd_barrier(bar); if (XSYNC) { xcd_barrier(bar); xcd_barrier(bar); } }
        if (TPROBE >= 0 && blockIdx.x == 0 && threadIdx.x == 0) {
            const unsigned long long now = __builtin_amdgcn_s_memrealtime();
            const int pprev = (ph - 1 < 0) ? -1 : ((ph - 1 == N_PHASES - 1) ? 11 : (ph - 1) % PH_PER_LAYER), pcur = (ph == N_PHASES - 1) ? 11 : ph % PH_PER_LAYER;
            if (pprev == TPROBE) tacc[0] += now - tacc[1];
            if (pcur == TPROBE) tacc[1] = now;
        }
        int tid = threadIdx.x; asm volatile("" : "+v"(tid));
        int G = gridDim.x, bx = blockIdx.x; asm volatile("" : "+s"(G), "+s"(bx));
        const int lane = tid & 63, wave = __builtin_amdgcn_readfirstlane(tid >> 6);
        const int vcu = (G % 8 == 0) ? (bx % 8) * (G / 8) + bx / 8 : bx;
        const int gw = vcu * 8 + wave, NGW = G * 8;
        const __attribute__((address_space(4))) Args* ap = (const __attribute__((address_space(4))) Args*)__builtin_amdgcn_kernarg_segment_ptr(); asm volatile("" : "+s"(ap));
        const __attribute__((address_space(4))) Args& a = *ap;
        unsigned char* ws = a.ws; float* aout = a.out; const float* ax = a.x;
        asm volatile("" : "+s"(ws), "+s"(aout), "+s"(ax));
        bf16_t* Win_t = (bf16_t*)(ws + WS_WIN); bf16_t* Wuq_t = (bf16_t*)(ws + WS_WUQ); bf16_t* Wukv_t = (bf16_t*)(ws + WS_WUKV);
        bf16_t* Wba_t = (bf16_t*)(ws + WS_WBA); bf16_t* Wbb_t = (bf16_t*)(ws + WS_WBB); bf16_t* Wout_t = (bf16_t*)(ws + WS_WOUT);
        bf16_t* Wxq_t = (bf16_t*)(ws + WS_WXQ); bf16_t* Wxkv_t = (bf16_t*)(ws + WS_WXKV); bf16_t* Wxo_t = (bf16_t*)(ws + WS_WXO);
        bf16_t* Wgu_t = (bf16_t*)(ws + WS_WGU); bf16_t* Wdn_t = (bf16_t*)(ws + WS_WDN);
        bf16_t* XB = (bf16_t*)(ws + WS_XB); bf16_t* QB = (bf16_t*)aout;
        bf16_t* QKVA = (bf16_t*)(ws + WS_QKVA); bf16_t* QX = (bf16_t*)(ws + WS_QKVA);
        bf16_t* LAT = (bf16_t*)(ws + WS_LAT); bf16_t* OAB = (bf16_t*)((unsigned char*)aout + 64 * MiB);
        bf16_t* KVLAT = (bf16_t*)(ws + WS_KVLAT); bf16_t* GATES = (bf16_t*)(ws + WS_GATES); bf16_t* ACT = (bf16_t*)(ws + WS_ACT);
        bf16_t* KVB = (bf16_t*)(ws + WS_KVB); bf16_t* KVX = (bf16_t*)(ws + WS_KVX); bf16_t* MEMB = (bf16_t*)(ws + WS_MEMB); bf16_t* KPE = (bf16_t*)(ws + WS_KPE);
        float* COSA = (float*)(ws + WS_COSA); float* SINA = (float*)(ws + WS_SINA); float* COSB = (float*)(ws + WS_COSB); float* SINB = (float*)(ws + WS_SINB);
        unsigned char* XQ = ws + WS_XQ; float* SSQ = (float*)(ws + WS_SSQ); float* LSSQ = (float*)(ws + WS_LSSQ); float* RSTDM = (float*)(ws + WS_RSTDM); float* KBAR = (float*)(ws + WS_KBAR);

        if (ph == N_PHASES - 1) {
            if (!PHON(11)) continue;
            for (int row = gw; row < M; row += NGW) {
                const f32x4* sp = (const f32x4*)(SSQ + (size_t)row * 16);
                const f32x4 p0 = sp[0], p1 = sp[1], p2 = sp[2], p3 = sp[3];
                const float s = ((p0.x + p0.y) + (p0.z + p0.w)) + ((p1.x + p1.y) + (p1.z + p1.w)) + ((p2.x + p2.y) + (p2.z + p2.w)) + ((p3.x + p3.y) + (p3.z + p3.w));
                const float rs = rsqrtf(s * (1.0f / 1024.0f) + EPS);
                GAS f32x4* xr = (GAS f32x4*)(aout + (size_t)row * DM) + lane; const GAS f32x4* gr = (const GAS f32x4*)a.norm_final + lane;
                const GAS u32x2* hr = (const GAS u32x2*)(XB + (size_t)row * DM) + lane; const GAS unsigned* qr = (const GAS unsigned*)(XQ + (size_t)row * DM) + lane;
#pragma unroll
                for (int j = 0; j < 4; ++j) { const u32x2 h = hr[64 * j]; const unsigned q = qr[64 * j]; const f32x4 g = gr[64 * j]; f32x4 v;
                    v.x = xdeq(h.x & 0xffffu, bflo(h.x), (int)(q << 24) >> 24); v.y = xdeq(h.x >> 16, bfhi(h.x), (int)(q << 16) >> 24);
                    v.z = xdeq(h.y & 0xffffu, bflo(h.y), (int)(q << 8) >> 24); v.w = xdeq(h.y >> 16, bfhi(h.y), (int)q >> 24);
                    xr[64 * j] = v * rs * g; }
            }
            continue;
        }
        const int l = ph / PH_PER_LAYER, p = ph % PH_PER_LAYER;
        if (STAG > 0 && (p == 5 || p == 8 || p == 10)) {
            const unsigned long long t0 = __builtin_amdgcn_s_memrealtime(); const unsigned long long dl = (unsigned long long)((vcu & 3) * STAG);
            while (__builtin_amdgcn_s_memrealtime() - t0 < dl) __builtin_amdgcn_s_sleep(8);
        }
        const float* xin = (l == 0 && p == 5) ? ax : aout;
        if (!PHON(p)) continue;
        if (p == 0) {
            LAS float* scr = (LAS float*)(lds + wave * 16384);
            constexpr int I_IN = 16 * (IN_W / 32), I_UQ = 6 * 24, I_UKV = 4 * 32, I_BA = 8 * 32, I_OUT = 16 * 32, I_XQ = 16 * 16, I_XKV = 16 * 32, I_XO = 8 * 32, I_GU = 16 * (2 * DFF / 32), I_DN = (DFF / 64) * 32;
            constexpr int NIT = I_IN + I_UQ + I_UKV + 2 * I_BA + I_OUT + I_XQ + I_XKV + I_XO + I_GU + I_DN;
            for (int rep = 0; rep < 1 + DUP(0); ++rep)
            for (int it = gw; it < NIT; it += NGW) {
                int r = it;
                if (r < I_IN) { transpose_item(a.w_in + (size_t)l * DM * IN_W, DM, IN_W, Win_t, a.norm_mix + l * DM, scr, r, lane, map_in); continue; } r -= I_IN;
                if (r < I_UQ) { transpose_item(a.w_uq + (size_t)l * 384 * 768, 384, 768, Wuq_t, a.q_lat_norm + l * 384, scr, r, lane, map_uq); continue; } r -= I_UQ;
                if (r < I_UKV) { transpose_item(a.w_ukv + (size_t)l * 256 * 1024, 256, 1024, Wukv_t, a.kv_lat_norm + l * 256, scr, r, lane, map_id); continue; } r -= I_UKV;
                if (r < I_BA) { transpose_item(a.w_ba + (size_t)l * 512 * 1024, 512, 1024, Wba_t, nullptr, scr, r, lane, map_id); continue; } r -= I_BA;
                if (r < I_BA) { transpose_item(a.w_bb + (size_t)l * 512 * 1024, 512, 1024, Wbb_t, nullptr, scr, r, lane, map_id); continue; } r -= I_BA;
                if (r < I_OUT) { transpose_item(a.w_out + (size_t)l * 1024 * 1024, 1024, 1024, Wout_t, nullptr, scr, r, lane, map_id); continue; } r -= I_OUT;
                if (r < I_XQ) { transpose_item(a.w_xq + (size_t)l * 1024 * 512, 1024, 512, Wxq_t, a.norm_x + l * DM, scr, r, lane, map_id); continue; } r -= I_XQ;
                if (r < I_XKV) { transpose_item(a.w_xkv + (size_t)l * 1024 * 1024, 1024, 1024, Wxkv_t, a.norm_mem + l * DM, scr, r, lane, map_id); continue; } r -= I_XKV;
                if (r < I_XO) { transpose_item(a.w_xo + (size_t)l * 512 * 1024, 512, 1024, Wxo_t, nullptr, scr, r, lane, map_id); continue; } r -= I_XO;
                if (r < I_GU) { transpose_item(a.w_gu + (size_t)l * 1024 * 2 * DFF, 1024, 2 * DFF, Wgu_t, a.norm_ffn + l * DM, scr, r, lane, map_gu); continue; } r -= I_GU;
                transpose_item(a.w_dn + (size_t)l * DFF * 1024, DFF, 1024, Wdn_t, nullptr, scr, r, lane, map_id);
            }
            unsigned zz_ = 0u; asm volatile("" : "+v"(zz_));
            for (int i = vcu * 512 + tid; i < 128 * 8 * 64; i += G * 512) ((GAS unsigned*)KBAR)[i] = zz_;
            for (int i = vcu * 512 + tid; i < 96 * 1024 / 8; i += G * 512) *(GAS u32x4*)(Win_t + (size_t)1952 * 1024 + (size_t)i * 8) = (u32x4){zz_, zz_, zz_, zz_};
            if (l == 0) {
                for (int row = gw; row < M + MM; row += NGW) {
                    const bool ism = row >= M; const int r = ism ? row - M : row;
                    const f32x4* xr = (const f32x4*)((ism ? a.mem : ax) + (size_t)r * DM) + lane;
                    f32x4 v[4]; float s = 0.f;
#pragma unroll
                    for (int j = 0; j < 4; ++j) { v[j] = xr[64 * j]; s += sq4(v[j]); }
                    s = wave_sum(s);
                    GAS_U32X2_PTR o8 = (GAS_U32X2_PTR)((ism ? MEMB : XB) + (size_t)r * DM) + lane;
#pragma unroll
                    for (int j = 0; j < 4; ++j) { u32x2 w; w.x = cvt_pk_bf16(v[j].x, v[j].y); w.y = cvt_pk_bf16(v[j].z, v[j].w); o8[64 * j] = w;
                        if (!ism) ((GAS unsigned*)(XQ + (size_t)r * DM))[64 * j + lane] = xquant4(v[j], w.x, w.y); }
                    if (ism) { if (lane == 0) RSTDM[r] = rsqrtf(s * (1.0f / 1024.0f) + EPS); }
                    else if (lane < 16) SSQ[(size_t)r * 16 + lane] = (lane == 0) ? s : 0.f;
                }
                for (int i = vcu * 512 + tid; i < M * 32; i += G * 512) {
                    const int row = i >> 5, k = i & 31; const float posf = (float)a.pos[row];
                    const float inv = expf(-9.210340371976184f * (2.0f / 64.0f) * (float)k);
                    float sn, cs; sincosf(posf * inv, &sn, &cs); COSA[i] = cs; SINA[i] = sn;
                    if (k < 16) { const float invb = expf(-9.210340371976184f * (2.0f / 32.0f) * (float)k); float sb, cb; sincosf(posf * invb, &sb, &cb); COSB[row * 16 + k] = cb; SINB[row * 16 + k] = sb; }
                }
            }
            __syncthreads();
        } else if (p == 1) {
            pg8::Gemm g{XB, Win_t, M, IN_WP, DM, DM}; pg8::StaticOrder S; S.init(M, IN_WP, G, bx);
            EpiIn E{SSQ, QKVA, LAT, KVLAT, GATES, LSSQ, COSA, SINA, KBAR};
            for (int rep = 0; rep < 1 + DUP(1); ++rep) { int tl = tid; asm volatile("" : "+v"(tl)); pg8::gemm_phase(lds, tl, g, S, E); }
        } else if (p == 2) {
            if (P2ON(0)) { LAS float* red = (LAS float*)lds;
              for (int i = vcu * 512 + tid; i < M * 16; i += G * 512) {
                  const int row = i >> 4, k = i & 15;
                  const float x1 = bf2f(LAT[(size_t)row * 512 + 384 + k]), x2 = bf2f(LAT[(size_t)row * 512 + 400 + k]);
                  const float c = COSB[i], s = SINB[i];
                  KPE[(size_t)row * 32 + k] = f2bf1(x1 * c - x2 * s); KPE[(size_t)row * 32 + 16 + k] = f2bf1(x2 * c + x1 * s);
              }
              __syncthreads(); }
            if (P2ON(1)) { unsigned char* w = ws; int tl = tid; asm volatile("" : "+s"(w), "+v"(tl));
              pg8::Gemm g{(bf16_t*)(w + WS_LAT), (bf16_t*)(w + WS_WUQ), M, 768, 384, 512}; pg8::StaticOrder S; S.init(M, 768, G, bx);
              EpiUq E{(float*)(w + WS_LSSQ), QB, (float*)(w + WS_COSB), (float*)(w + WS_SINB)}; pg8::gemm_phase(lds, tl, g, S, E); }
            if (P2ON(2)) { unsigned char* w = ws; int tl = tid; asm volatile("" : "+s"(w), "+v"(tl));
              pg8::Gemm g{(bf16_t*)(w + WS_KVLAT), (bf16_t*)(w + WS_WUKV), M, 1024, 256, 256}; pg8::StaticOrder S; S.init(M, 1024, G, G - 1 - bx);
              EpiRowScale<0> E{(float*)(w + WS_LSSQ), (bf16_t*)(w + WS_KVB), 1024, 1.f}; pg8::gemm_phase(lds, tl, g, S, E); }
            if (P2ON(3)) { unsigned char* w = ws; int tl = tid; asm volatile("" : "+s"(w), "+v"(tl));
              pg8::Gemm g{(bf16_t*)(w + WS_MEMB), (bf16_t*)(w + WS_WXKV), MM, 1024, 1024, 1024}; pg8::StaticOrder S; S.init(MM, 1024, G, (bx + 128) % G);
              EpiRowScale<1> E{(float*)(w + WS_RSTDM), (bf16_t*)(w + WS_KVX), 1024, 1.f}; pg8::gemm_phase(lds, tl, g, S, E); }
        } else if (p == 3) {
            for (int v = vcu; v < 256; v += G) {
                const int bh = v >> 1, b = bh >> 3, h = bh & 7;
#pragma unroll 1
                for (int i = 0; i < 4; ++i) {
                    const int cur = (v & 1) ? ((i == 0) ? 2 : (i == 1) ? 5 : (i == 2) ? 3 : 4) : ((i == 0) ? 0 : (i == 1) ? 7 : (i == 2) ? 1 : 6);
                    const size_t rowb = (size_t)b * SEQ, rowq = rowb + cur * 256;
                    attn_unit<64, 64, 0>(lds, tid, QKVA + rowq * 1536 + h * 64, 1536, QKVA + rowb * 1536 + 512 + h * 64, 1536, nullptr,
                                         QKVA + rowb * 1536 + 1024 + h * 64, 1536, OAB + rowq * 512 + h * 64, 512, cur * 256, 4 * (cur + 1), KBAR + (size_t)bh * 512, cur);
                }
                for (int rep = 0; rep < 1 + DUP(4); ++rep)
#pragma unroll 1
                for (int i = 0; i < 4; ++i) {
                    const int cur = (v & 1) ? ((i == 0) ? 2 : (i == 1) ? 5 : (i == 2) ? 3 : 4) : ((i == 0) ? 0 : (i == 1) ? 7 : (i == 2) ? 1 : 6);
                    const size_t rowb = (size_t)b * SEQ, rowq = rowb + cur * 256;
                    attn_unit<96, 64, 1>(lds, tid, QB + rowq * 768 + h * 96, 768, KVB + rowb * 1024 + h * 128, 1024, KPE + rowb * 32,
                                         KVB + rowb * 1024 + h * 128 + 64, 1024, OAB + (size_t)M * 512 + rowq * 512 + h * 64, 512, cur * 256, 4 * (cur + 1), nullptr, cur);
                }
            }
        } else if (p == 4) {
            pg8::Gemm g{OAB, Wba_t, M, 1024, 512, 512, (size_t)M * 512 * 2, (size_t)1024 * 512 * 2}; pg8::StaticOrder S; S.init(M, 1024, G, bx); S.dual = 1;
            EpiBranchF E{GATES}; pg8::gemm_phase(lds, tid, g, S, E);
        } else if (p == 5) {
            pg8::Gemm g{GATES, Wout_t, M, 1024, 1024, 2048}; pg8::StaticOrder S; S.init(M, 1024, G, bx);
            if (ND(5)) { int tl = tid; asm volatile("" : "+v"(tl)); EpiNull EN; pg8::gemm_phase(lds, tl, g, S, EN); }
            EpiRes E{XB, XQ, SSQ}; pg8::gemm_phase(lds, tid, g, S, E);
        } else if (p == 6) {
            pg8::Gemm g{XB, Wxq_t, M, 512, 1024, 1024}; pg8::StaticOrder S; S.init(M, 512, G, bx);
            EpiRowScale<2> E{SSQ, QX, 512, C2X}; for (int rep = 0; rep < 1 + DUP(6); ++rep) { int tl = tid; asm volatile("" : "+v"(tl)); pg8::gemm_phase(lds, tl, g, S, E); }
        } else if (p == 7) {
            for (int un = vcu * 2; un < 512; un += 2 * G)
#pragma unroll 1
                for (int i = 0; i < 2; ++i) {
                    const int unit = un + i, bh = unit >> 3, qb = unit & 7, b = bh >> 2, h = bh & 3;
                    const size_t rowq = (size_t)b * SEQ + qb * 256, rowm = (size_t)b * MEMLEN;
                    attn_unit<128, 128, 2>(lds, tid, QX + rowq * 512 + h * 128, 512, KVX + rowm * 1024 + h * 128, 1024, nullptr,
                                           KVX + rowm * 1024 + 512 + h * 128, 1024, QX + rowq * 512 + h * 128, 512, 0, 4, nullptr, 0, i == 0);
                }
        } else if (p == 8) {
            pg8::Gemm g{QX, Wxo_t, M, 1024, 512, 512}; pg8::StaticOrder S; S.init(M, 1024, G, bx);
            if (ND(8)) { int tl = tid; asm volatile("" : "+v"(tl)); EpiNull EN; pg8::gemm_phase(lds, tl, g, S, EN); }
            EpiRes E{XB, XQ, SSQ}; pg8::gemm_phase(lds, tid, g, S, E);
        } else if (p == 9) {
            pg8::Gemm g{XB, Wgu_t, M, 2 * DFF, 1024, 1024}; pg8::StaticOrder S; S.init(M, 2 * DFF, G, bx);
            EpiGU E{SSQ, ACT}; for (int rep = 0; rep < 1 + DUP(9); ++rep) { int tl = tid; asm volatile("" : "+v"(tl)); pg8::gemm_phase(lds, tl, g, S, E); }
            if (DUP(12)) { int tl = tid; asm volatile("" : "+v"(tl)); EpiNull EN; pg8::gemm_phase(lds, tl, g, S, EN); }
        } else {
            pg8::Gemm g{ACT, Wdn_t, M, 1024, DFF, DFF}; pg8::StaticOrder S; S.init(M, 1024, G, bx);
            if (ND(10)) { int tl = tid; asm volatile("" : "+v"(tl)); EpiNull EN; pg8::gemm_phase(lds, tl, g, S, EN); }
            if (ND(13)) { int tl = tid; asm volatile("" : "+v"(tl)); EpiRes ED{(bf16_t*)(ws + 276 * MiB), (unsigned char*)(ws + 340 * MiB), LSSQ}; pg8::gemm_phase(lds, tl, g, S, ED); }
            EpiRes E{XB, XQ, SSQ}; pg8::gemm_phase(lds, tid, g, S, E);
        }
    }
    if (TPROBE >= 0 && blockIdx.x == 0) {
        __syncthreads();
        const unsigned long long t0 = __builtin_amdgcn_s_memrealtime(); const unsigned long long dl = (unsigned long long)TAMP * tacc[0];
        while (__builtin_amdgcn_s_memrealtime() - t0 < dl) __builtin_amdgcn_s_sleep(16);
    }
}

extern "C" void kernel_launch(void* const* d_in, const int* in_sizes, int n_in, void* d_out, int out_size, void* d_ws, size_t ws_size, hipStream_t stream) {
    static int grid = 0;
    if (grid == 0) {
        if (n_in != 21 || in_sizes[0] != M * DM || out_size != M * DM || ws_size < WS_END) {
            fprintf(stderr, "kernel_launch: unexpected shapes (n_in %d, in0 %d, out %d, ws %zu); nothing launched\n", n_in, n_in > 0 ? in_sizes[0] : -1, out_size, ws_size); grid = -1; return; }
        int dev = 0, cus = 0, per_cu = 0;
        hipGetDevice(&dev); hipDeviceGetAttribute(&cus, hipDeviceAttributeMultiprocessorCount, dev);
        if (hipOccupancyMaxActiveBlocksPerMultiprocessor(&per_cu, (const void*)fwd_kernel, 512, 0) != hipSuccess || per_cu < 1) per_cu = 1;
        (void)hipGetLastError();
        grid = cus * 1;
        if (grid <= 0) grid = 256;
    }
    if (grid < 0) return;
    Args a{};
    a.x = (const float*)d_in[0]; a.mem = (const float*)d_in[1]; a.pos = (const int*)d_in[2];
    a.norm_mix = (const float*)d_in[3]; a.w_in = (const float*)d_in[4]; a.q_lat_norm = (const float*)d_in[5]; a.w_uq = (const float*)d_in[6];
    a.kv_lat_norm = (const float*)d_in[7]; a.w_ukv = (const float*)d_in[8]; a.w_ba = (const float*)d_in[9]; a.w_bb = (const float*)d_in[10]; a.w_out = (const float*)d_in[11];
    a.norm_x = (const float*)d_in[12]; a.norm_mem = (const float*)d_in[13]; a.w_xq = (const float*)d_in[14]; a.w_xkv = (const float*)d_in[15]; a.w_xo = (const float*)d_in[16];
    a.norm_ffn = (const float*)d_in[17]; a.w_gu = (const float*)d_in[18]; a.w_dn = (const float*)d_in[19]; a.norm_final = (const float*)d_in[20];
    a.out = (float*)d_out; a.ws = (unsigned char*)d_ws;
#if ONE_LAUNCH
    if (hipMemsetAsync((char*)d_ws + WS_CTL, 0, 65536, stream) != hipSuccess) { fprintf(stderr, "kernel_launch: memset of the barrier words failed\n"); return; }
    a.ph_lo = 0; a.ph_hi = N_PHASES;
    void* args[] = {&a};
    hipError_t e = hipLaunchCooperativeKernel((const void*)fwd_kernel, dim3(grid), dim3(512), args, 0, stream);
    if (e != hipSuccess) fprintf(stderr, "cooperative launch failed: %s (grid %d)\n", hipGetErrorString(e), grid);
#else
    for (int ph = 0; ph < N_PHASES; ++ph) {
        a.ph_lo = ph; a.ph_hi = ph + 1;
        hipLaunchKernelGGL(fwd_kernel, dim3(grid), dim3(512), 0, stream, a);
    }
#endif
}
```

```cpp
#include <hip/hip_runtime.h>
#include <hip/hip_cooperative_groups.h>
#include <cstdio>
#include <cstdint>
namespace cg = cooperative_groups;

#ifndef ONE_LAUNCH
#define ONE_LAUNCH 1
#endif

#ifndef PHMASK
#define PHMASK 0xFFFF
#endif
#ifndef P2MASK
#define P2MASK 0xF
#endif
#define P2ON(k) (((P2MASK) >> (k)) & 1)
#ifndef DUPMASK
#define DUPMASK 0
#endif
#ifndef XSYNC
#define XSYNC 0
#endif
#define DUP(k) (((DUPMASK) >> (k)) & 1)
#ifndef STAG
#define STAG 0
#endif
#ifndef NDUP
#define NDUP 0
#endif
#define ND(k) (((NDUP) >> (k)) & 1)
#ifndef TPROBE
#define TPROBE -1
#endif
#define TAMP 4
#define PHON(k) (((PHMASK) >> (k)) & 1)
#define LAS __attribute__((address_space(3)))
#define GAS __attribute__((address_space(1)))
#define GAS_U32X2_PTR __attribute__((address_space(1))) u32x2*
typedef unsigned short bf16_t;
typedef short bf16x8 __attribute__((ext_vector_type(8)));
typedef float f32x4 __attribute__((ext_vector_type(4)));
typedef float f32x16 __attribute__((ext_vector_type(16)));
typedef unsigned u32x4 __attribute__((ext_vector_type(4)));
typedef unsigned u32x2 __attribute__((ext_vector_type(2)));

constexpr int NBATCH = 16, SEQ = 2048, DM = 1024, DEPTH = 4, MEMLEN = 256;
constexpr int M = NBATCH * SEQ;
constexpr int MM = NBATCH * MEMLEN;
constexpr int IN_W = 4256, IN_WP = 4352;
constexpr int DFF = 2816;
constexpr float EPS = 1e-6f;
constexpr float LOG2E = 1.4426950408889634f;
constexpr float C2A = 0.125f * LOG2E;
constexpr float C2B = 0.10206207261596575f * LOG2E;
constexpr float C2X = 0.08838834764831845f * LOG2E;

constexpr size_t MiB = 1u << 20;
constexpr size_t WS_WIN = 0 * MiB, WS_WUQ = 9 * MiB, WS_WUKV = 10 * MiB, WS_WBA = 11 * MiB, WS_WBB = 12 * MiB, WS_WOUT = 13 * MiB,
                 WS_WXQ = 15 * MiB, WS_WXKV = 16 * MiB, WS_WXO = 18 * MiB, WS_WGU = 19 * MiB, WS_WDN = 30 * MiB;
constexpr size_t WS_XB = 36 * MiB;
constexpr size_t WS_QKVA = 100 * MiB;
constexpr size_t WS_LAT = 196 * MiB;
constexpr size_t WS_KVLAT = 228 * MiB;
constexpr size_t WS_GATES = 244 * MiB;
constexpr size_t WS_ACT = 100 * MiB;
constexpr size_t WS_KVB = 372 * MiB;
constexpr size_t WS_KVX = 436 * MiB;
constexpr size_t WS_MEMB = 444 * MiB;
constexpr size_t WS_KPE = 452 * MiB;
constexpr size_t WS_COSA = 454 * MiB, WS_SINA = 458 * MiB;
constexpr size_t WS_COSB = 462 * MiB, WS_SINB = 464 * MiB;
constexpr size_t WS_SSQ = 466 * MiB;
constexpr size_t WS_LSSQ = 468 * MiB;
constexpr size_t WS_RSTDM = 470 * MiB;
constexpr size_t WS_KBAR = 470 * MiB + 65536;
constexpr size_t WS_XQ = 473 * MiB;
constexpr size_t WS_CTL = 471 * MiB;
constexpr size_t WS_END = 505 * MiB;

typedef float f32x2_t __attribute__((ext_vector_type(2))); typedef __bf16 bf16x2_t __attribute__((ext_vector_type(2)));
__device__ __forceinline__ unsigned cvt_pk_bf16(float lo, float hi) { f32x2_t v = {lo, hi}; bf16x2_t b = __builtin_convertvector(v, bf16x2_t); return __builtin_bit_cast(unsigned, b); }
__device__ __forceinline__ float bf2f(unsigned short b) { return __uint_as_float(((unsigned)b) << 16); }
__device__ __forceinline__ float bflo(unsigned w) { return __uint_as_float(w << 16); }
__device__ __forceinline__ float bfhi(unsigned w) { return __uint_as_float(w & 0xffff0000u); }
__device__ __forceinline__ unsigned short f2bf1(float f) { return (unsigned short)(cvt_pk_bf16(f, 0.f) & 0xffffu); }


__device__ __forceinline__ float xdeq(unsigned hbits, float hf, int q) { unsigned e = (hbits >> 7) & 0xffu; e = e < 16u ? 16u : e; return __builtin_fmaf((float)q, __uint_as_float((e - 15u) << 23), hf); }
__device__ __forceinline__ unsigned xquant(float x, unsigned hbits, float hf) { unsigned e = (hbits >> 7) & 0xffu; e = e < 16u ? 16u : e;
    float qf = __builtin_rintf((x - hf) * __uint_as_float((269u - e) << 23)); qf = fminf(fmaxf(qf, -127.f), 127.f); return ((unsigned)(int)qf) & 0xffu; }
__device__ __forceinline__ void xdeq8(const u32x4 h, const u32x2 q, f32x4& a, f32x4& b) {
    a.x = xdeq(h.x & 0xffffu, bflo(h.x), (int)(q.x << 24) >> 24); a.y = xdeq(h.x >> 16, bfhi(h.x), (int)(q.x << 16) >> 24);
    a.z = xdeq(h.y & 0xffffu, bflo(h.y), (int)(q.x << 8) >> 24);  a.w = xdeq(h.y >> 16, bfhi(h.y), (int)q.x >> 24);
    b.x = xdeq(h.z & 0xffffu, bflo(h.z), (int)(q.y << 24) >> 24); b.y = xdeq(h.z >> 16, bfhi(h.z), (int)(q.y << 16) >> 24);
    b.z = xdeq(h.w & 0xffffu, bflo(h.w), (int)(q.y << 8) >> 24);  b.w = xdeq(h.w >> 16, bfhi(h.w), (int)q.y >> 24);
}
__device__ __forceinline__ unsigned xquant4(const f32x4 v, unsigned w0, unsigned w1) {
    return xquant(v.x, w0 & 0xffffu, bflo(w0)) | (xquant(v.y, w0 >> 16, bfhi(w0)) << 8) | (xquant(v.z, w1 & 0xffffu, bflo(w1)) << 16) | (xquant(v.w, w1 >> 16, bfhi(w1)) << 24);
}

namespace pg8 {
constexpr int BM = 256, BK = 64, HALF = 128, HTB = HALF * BK * 2, STAGE_BYTES = 8 * HTB, NXCD = 8, WGM = 8;
__host__ __device__ __forceinline__ int lds_byte(int r, int c) { const int st = (r >> 4) * 2 + (c >> 5), rr = r & 15, cc = c & 31, ob = rr * 64 + cc * 2; return st * 1024 + (ob ^ (((ob >> 9) & 1) << 5)); }
__host__ __device__ __forceinline__ void stage_rc(int b, int& R, int& C) { const int st = b / 1024, sb = b % 1024, swz = sb ^ (((sb >> 9) & 1) << 5); R = (st >> 1) * 16 + swz / 64; C = (st & 1) * 32 + (swz % 64) / 2; }
__host__ __device__ __forceinline__ int perm32(int rho) { const int n = rho >> 4, i = rho & 15; return 8 * (i >> 2) + 4 * n + (i & 3); }

struct Unit { int pm, pn, z; };
struct Gemm { const bf16_t* A; const bf16_t* Bt; int M, N, K, lda; size_t zA = 0, zB = 0; };

struct StaticOrder {
    int nM, nN, nwg, G, c, dual = 0;
    __device__ void init(int M_, int N_, int G_, int c_) { nM = M_ / BM; nN = N_ / BM; nwg = nM * nN; G = G_; c = c_; }
    __device__ bool next(int i, Unit& u) const {
        u.z = dual ? (i & 1) : 0; if (dual) i >>= 1;
        const long L = (long)i * G + c; if (L >= nwg) return false;
        int wgid = (int)L; { const int q = nwg / NXCD, r = nwg % NXCD, xcd = wgid % NXCD, off = wgid / NXCD; wgid = (xcd < r ? xcd * (q + 1) : r * (q + 1) + (xcd - r) * q) + off; }
        const int nig = WGM * nN, gid = wgid / nig, fm = gid * WGM, gsz = (nM - fm) < WGM ? (nM - fm) : WGM;
        u.pm = fm + ((wgid % nig) % gsz); u.pn = (wgid % nig) / gsz; return true;
    }
};

template <class Epi>
__device__ __forceinline__ void gemm_phase(LAS unsigned char* lds, const int tid, const Gemm g, const StaticOrder& S, const Epi& E) {
    LAS unsigned char* const sl = lds + STAGE_BYTES;
    const int wid = __builtin_amdgcn_readfirstlane(tid >> 6), lane = tid & 63, wr = wid >> 2, wc = wid & 3, fr = lane & 15, fq = lane >> 4;
    const int K = g.K, nt = K / BK;
    unsigned voffA[2], voffB[2];
#pragma unroll
    for (int i = 0; i < 2; ++i) { int R, C; stage_rc(tid * 16 + i * 8192, R, C); const int Rb = Epi::PERM ? ((R & ~31) + perm32(R & 31)) : R;
        voffA[i] = (unsigned)(R * g.lda + C) * 2u; voffB[i] = (unsigned)(Rb * K + C) * 2u; }
    const size_t kstep = (size_t)(BK * 2);
    const size_t hstepA = (size_t)HALF * g.lda * 2, hstepB = (size_t)HALF * K * 2;
    const size_t tstepA = 2 * hstepA, tstepB = 2 * hstepB;
    const unsigned ldsw = (unsigned)wid * 1024u;
    const int aoff = lds_byte(wr * 64 + fr, fq * 8), boff = lds_byte(wc * 32 + fr, fq * 8);
#define PG8_SA(b, h) (((b) * 2 + (h)) * HTB)
#define PG8_SB(b, h) ((4 + (b) * 2 + (h)) * HTB)
#define PG8_STAGE(bufoff, gbase, voff) do { _Pragma("unroll") for (int _i = 0; _i < 2; ++_i) \
        __builtin_amdgcn_global_load_lds((const unsigned*)((const char*)(gbase) + (voff)[_i]), (LAS unsigned*)(lds + (bufoff) + ldsw + _i * 8192), 16, 0, 0); } while (0)
#define PG8_LDA(dst, b, h) do { _Pragma("unroll") for (int m = 0; m < 4; ++m) _Pragma("unroll") for (int k = 0; k < 2; ++k) dst[m][k] = *(const LAS bf16x8*)(lds + PG8_SA(b, h) + aoff + m * 2048 + k * 1024); } while (0)
#define PG8_LDB(dst, b, h) do { _Pragma("unroll") for (int n = 0; n < 2; ++n) _Pragma("unroll") for (int k = 0; k < 2; ++k) dst[n][k] = *(const LAS bf16x8*)(lds + PG8_SB(b, h) + boff + n * 2048 + k * 1024); } while (0)
#define PG8_MMA(ai, bj, At, Bt) do { __builtin_amdgcn_s_setprio(1); _Pragma("unroll") for (int m = 0; m < 4; ++m) _Pragma("unroll") for (int n = 0; n < 2; ++n) _Pragma("unroll") for (int k = 0; k < 2; ++k) \
        acc[ai][bj][m][n] = __builtin_amdgcn_mfma_f32_16x16x32_bf16(Bt[n][k], At[m][k], acc[ai][bj][m][n], 0, 0, 0); __builtin_amdgcn_s_setprio(0); } while (0)
#define PG8_WAIT_V(n) asm volatile("s_waitcnt vmcnt(" #n ")" ::: "memory")
#define PG8_WAIT_L(n) asm volatile("s_waitcnt lgkmcnt(" #n ")" ::: "memory")
#define PG8_BAR __builtin_amdgcn_s_barrier()
#define PG8_SCHED __builtin_amdgcn_sched_barrier(0)
    Unit cur, nxt; int ui = 0;
    if (!S.next(0, cur)) return;
    f32x4 acc[2][2][4][2];
    if constexpr (Epi::ACC_INIT) E.init(acc, cur, wr, wc, fr, fq);
    else { float z0_ = 0.f; asm volatile("" : "+v"(z0_));
#pragma unroll
    for (int a = 0; a < 2; ++a)
#pragma unroll
        for (int b = 0; b < 2; ++b)
#pragma unroll
            for (int m = 0; m < 4; ++m)
#pragma unroll
                for (int n = 0; n < 2; ++n) acc[a][b][m][n] = (f32x4){z0_, z0_, z0_, z0_};
    }
    bf16x8 At[4][2], B0[2][2], B1[2][2];
    const char* cA = (const char*)g.A + (size_t)cur.z * g.zA + (size_t)cur.pm * tstepA; const char* cB = (const char*)g.Bt + (size_t)cur.z * g.zB + (size_t)cur.pn * tstepB;
    PG8_STAGE(PG8_SB(0, 0), cB, voffB); PG8_STAGE(PG8_SB(0, 1), cB + hstepB, voffB); PG8_STAGE(PG8_SA(0, 0), cA, voffA); PG8_STAGE(PG8_SA(0, 1), cA + hstepA, voffA);
    if (wr == 1) PG8_BAR;
    PG8_WAIT_V(2); PG8_BAR;
    PG8_STAGE(PG8_SB(1, 0), cB + kstep, voffB); PG8_STAGE(PG8_SA(1, 0), cA + kstep, voffA); PG8_STAGE(PG8_SB(1, 1), cB + hstepB + kstep, voffB);
    PG8_WAIT_V(6); PG8_BAR;
    for (;;) {
        const bool has_next = S.next(ui + 1, nxt);
        const char* nA = has_next ? (const char*)g.A + (size_t)nxt.z * g.zA + (size_t)nxt.pm * tstepA : cA; const char* nB = has_next ? (const char*)g.Bt + (size_t)nxt.z * g.zB + (size_t)nxt.pn * tstepB : cB;
#pragma unroll 1
        for (int t = 0; t < nt; t += 2) {
            const bool last = (t == nt - 2);
            const char* a1 = cA + (size_t)(t + 1) * kstep;
            const char* a2 = last ? nA : cA + (size_t)(t + 2) * kstep; const char* b2 = last ? nB : cB + (size_t)(t + 2) * kstep;
            const char* a3 = a2 + kstep; const char* b3 = b2 + kstep;
            PG8_LDB(B0, 0, 0); PG8_LDB(B1, 0, 1); PG8_SCHED; PG8_LDA(At, 0, 0); PG8_STAGE(PG8_SA(1, 1), a1 + hstepA, voffA);
            PG8_WAIT_V(8); PG8_WAIT_L(0); PG8_BAR;
            if constexpr (Epi::PREF) { if (t == 0) {
                const char* sp_ = (const char*)E.stat_base() + (size_t)cur.pm * 16384 + (size_t)(wid * 2048 + lane * 16);
                __builtin_amdgcn_global_load_lds((const unsigned*)sp_, (LAS unsigned*)(sl + wid * 2048), 16, 0, 0);
                __builtin_amdgcn_global_load_lds((const unsigned*)(sp_ + 1024), (LAS unsigned*)(sl + wid * 2048 + 1024), 16, 0, 0); } }
            PG8_MMA(0, 0, At, B0); PG8_MMA(0, 1, At, B1); PG8_BAR; PG8_SCHED;
            PG8_LDA(At, 0, 1); PG8_STAGE(PG8_SB(0, 0), b2, voffB); PG8_STAGE(PG8_SB(0, 1), b2 + hstepB, voffB); PG8_STAGE(PG8_SA(0, 0), a2, voffA);
            PG8_WAIT_V(8); PG8_WAIT_L(0); PG8_BAR; PG8_MMA(1, 0, At, B0); PG8_MMA(1, 1, At, B1); PG8_BAR; PG8_SCHED;
            PG8_LDB(B0, 1, 0); PG8_LDB(B1, 1, 1); PG8_SCHED; PG8_LDA(At, 1, 0); PG8_STAGE(PG8_SA(0, 1), a2 + hstepA, voffA);
            PG8_WAIT_V(8); PG8_WAIT_L(0); PG8_BAR; PG8_MMA(0, 0, At, B0); PG8_MMA(0, 1, At, B1); PG8_BAR; PG8_SCHED;
            PG8_LDA(At, 1, 1); PG8_STAGE(PG8_SB(1, 0), b3, voffB); PG8_STAGE(PG8_SB(1, 1), b3 + hstepB, voffB); PG8_STAGE(PG8_SA(1, 0), a3, voffA);
            PG8_WAIT_V(8); PG8_WAIT_L(0); PG8_BAR; PG8_MMA(1, 0, At, B0); PG8_MMA(1, 1, At, B1); PG8_BAR; PG8_SCHED;
        }
        if (wr == 0) PG8_BAR;
        E(acc, cur, wr, wc, fr, fq, sl);
        if (!has_next) break;
        if constexpr (Epi::ACC_INIT) E.init(acc, nxt, wr, wc, fr, fq);
        else if (!(Epi::KEEP && nxt.z == 1)) { float z0_ = 0.f; asm volatile("" : "+v"(z0_));
#pragma unroll
        for (int a = 0; a < 2; ++a)
#pragma unroll
            for (int b = 0; b < 2; ++b)
#pragma unroll
                for (int m = 0; m < 4; ++m)
#pragma unroll
                    for (int n = 0; n < 2; ++n) acc[a][b][m][n] = (f32x4){z0_, z0_, z0_, z0_};
        }
        cur = nxt; cA = nA; cB = nB; ++ui;
        if (wr == 1) PG8_BAR;
    }
    PG8_WAIT_V(0);
    PG8_BAR;
#undef PG8_SA
#undef PG8_SB
#undef PG8_STAGE
#undef PG8_LDA
#undef PG8_LDB
#undef PG8_MMA
#undef PG8_WAIT_V
#undef PG8_WAIT_L
#undef PG8_BAR
#undef PG8_SCHED
}
}

typedef f32x4 (&AccRef)[2][2][4][2];

__device__ __forceinline__ float quad_sum(float s) { s += __shfl_xor(s, 16); s += __shfl_xor(s, 32); return s; }
__device__ __forceinline__ float sq4(f32x4 v) { return (v.x * v.x + v.y * v.y) + (v.z * v.z + v.w * v.w); }
__device__ __forceinline__ float sum4(f32x4 v) { return (v.x + v.y) + (v.z + v.w); }
__device__ __forceinline__ u32x4 pack8(f32x4 a, f32x4 b) { u32x4 w; w.x = cvt_pk_bf16(a.x, a.y); w.y = cvt_pk_bf16(a.z, a.w); w.z = cvt_pk_bf16(b.x, b.y); w.w = cvt_pk_bf16(b.z, b.w); return w; }
__device__ __forceinline__ float sigmoidf_(float v) { return __builtin_amdgcn_rcpf(1.0f + __builtin_amdgcn_exp2f(v * (-LOG2E))); }
__device__ __forceinline__ f32x4 sig4(f32x4 v) { return (f32x4){sigmoidf_(v.x), sigmoidf_(v.y), sigmoidf_(v.z), sigmoidf_(v.w)}; }
#define ROWSTAT8(rs, base, inv_n, mul) do { f32x4 pv_[2][4]; \
    _Pragma("unroll") for (int ai = 0; ai < 2; ++ai) _Pragma("unroll") for (int m = 0; m < 4; ++m) pv_[ai][m] = *(const LAS f32x4*)(sl + (ai * 128 + wr * 64 + m * 16 + fr) * 64 + 16 * fq); \
    _Pragma("unroll") for (int ai = 0; ai < 2; ++ai) _Pragma("unroll") for (int m = 0; m < 4; ++m) rs[ai][m] = rsqrtf(quad_sum(sum4(pv_[ai][m])) * (inv_n) + EPS) * (mul); } while (0)

struct EpiIn {
    static constexpr bool PERM = true, ACC_INIT = false, PREF = true, KEEP = false;
    __device__ __forceinline__ const float* stat_base() const { return ssq; }
    const float* ssq; bf16_t* qkva; bf16_t* lat; bf16_t* kvlat; bf16_t* gates; float* lssq; const float* cosA; const float* sinA; float* kbar;
    __device__ __forceinline__ void operator()(AccRef acc, const pg8::Unit& u, int wr, int wc, int fr, int fq, const LAS unsigned char* sl) const {
        const int pn = u.pn;
        float rs[2][4];
        ROWSTAT8(rs, ssq, 1.0f / 1024.0f, 1.0f);
        if (pn < 4) {
            const float sc = (pn < 2) ? C2A : 1.0f;
            f32x4 cs[2][4];
#define ROPE_LOAD(ai, m0) _Pragma("unroll") for (int mm = 0; mm < 2; ++mm) { const size_t ro = (size_t)(u.pm * 256 + (ai) * 128 + wr * 64 + ((m0) + mm) * 16 + fr) * 32 + 8 * fq; \
            cs[mm][0] = *(const GAS f32x4*)(cosA + ro); cs[mm][1] = *(const GAS f32x4*)(cosA + ro + 4); cs[mm][2] = *(const GAS f32x4*)(sinA + ro); cs[mm][3] = *(const GAS f32x4*)(sinA + ro + 4); }
#define ROPE_COMP(ai, m0) _Pragma("unroll") for (int mm = 0; mm < 2; ++mm) { const int m = (m0) + mm; const float r_ = rs[ai][m] * sc; \
            const f32x4 v00 = acc[ai][0][m][0] * r_, v01 = acc[ai][0][m][1] * r_, v10 = acc[ai][1][m][0] * r_, v11 = acc[ai][1][m][1] * r_; \
            acc[ai][0][m][0] = v00 * cs[mm][0] - v10 * cs[mm][2]; acc[ai][0][m][1] = v01 * cs[mm][1] - v11 * cs[mm][3]; acc[ai][1][m][0] = v10 * cs[mm][0] + v00 * cs[mm][2]; acc[ai][1][m][1] = v11 * cs[mm][1] + v01 * cs[mm][3]; }
#define ROPE_STORE(ai, m0) _Pragma("unroll") for (int mm = 0; mm < 2; ++mm) { const int m = (m0) + mm; const int row = u.pm * 256 + (ai) * 128 + wr * 64 + m * 16 + fr; \
            bf16_t* d = qkva + (size_t)row * 1536 + (pn >> 1) * 512 + ((pn & 1) * 4 + wc) * 64 + 8 * fq; \
            *(GAS u32x4*)d = pack8(acc[ai][0][m][0], acc[ai][0][m][1]); *(GAS u32x4*)(d + 32) = pack8(acc[ai][1][m][0], acc[ai][1][m][1]); }
            ROPE_LOAD(0, 0); ROPE_COMP(0, 0); ROPE_LOAD(0, 2); ROPE_STORE(0, 0); ROPE_COMP(0, 2); ROPE_LOAD(1, 0); ROPE_STORE(0, 2); ROPE_COMP(1, 0); ROPE_LOAD(1, 2); ROPE_STORE(1, 0); ROPE_COMP(1, 2); ROPE_STORE(1, 2);
#undef ROPE_LOAD
#undef ROPE_COMP
#undef ROPE_STORE
            if (pn >= 2) {
                f32x4 cs_[2][2];
#pragma unroll
                for (int bj = 0; bj < 2; ++bj)
#pragma unroll
                    for (int n = 0; n < 2; ++n) { f32x4 t = acc[0][bj][0][n];
#pragma unroll
                        for (int m = 1; m < 4; ++m) t = t + acc[0][bj][m][n];
#pragma unroll
                        for (int m = 0; m < 4; ++m) t = t + acc[1][bj][m][n];
#pragma unroll
                        for (int off = 1; off < 16; off <<= 1) { t.x += __shfl_xor(t.x, off); t.y += __shfl_xor(t.y, off); t.z += __shfl_xor(t.z, off); t.w += __shfl_xor(t.w, off); }
                        cs_[bj][n] = t * (1.0f / 256.0f); }
                if (fr == 0) { GAS float* kb_ = (GAS float*)kbar + (size_t)((u.pm >> 3) * 8 + (pn & 1) * 4 + wc) * 512 + (u.pm & 7) * 64 + 8 * fq;
#pragma unroll
                    for (int bj = 0; bj < 2; ++bj)
#pragma unroll
                        for (int n = 0; n < 2; ++n) { GAS float* p_ = kb_ + 32 * bj + 4 * n;
                            __hip_atomic_fetch_add(p_ + 0, cs_[bj][n].x, __ATOMIC_RELAXED, __HIP_MEMORY_SCOPE_AGENT); __hip_atomic_fetch_add(p_ + 1, cs_[bj][n].y, __ATOMIC_RELAXED, __HIP_MEMORY_SCOPE_AGENT);
                            __hip_atomic_fetch_add(p_ + 2, cs_[bj][n].z, __ATOMIC_RELAXED, __HIP_MEMORY_SCOPE_AGENT); __hip_atomic_fetch_add(p_ + 3, cs_[bj][n].w, __ATOMIC_RELAXED, __HIP_MEMORY_SCOPE_AGENT); } }
            }
            return;
        }
#pragma unroll
        for (int ai = 0; ai < 2; ++ai)
#pragma unroll
            for (int m = 0; m < 4; ++m) {
                const int row = u.pm * 256 + ai * 128 + wr * 64 + m * 16 + fr;
                const float r_ = rs[ai][m];
                const f32x4 v00 = acc[ai][0][m][0] * r_, v01 = acc[ai][0][m][1] * r_, v10 = acc[ai][1][m][0] * r_, v11 = acc[ai][1][m][1] * r_;
                if (pn < 6) {
                    bf16_t* d = qkva + (size_t)row * 1536 + pn * 256 + wc * 32 + 8 * fq;
                    *(GAS u32x4*)d = pack8(v00, v01); *(GAS u32x4*)(d + 128) = pack8(v10, v11);
                } else if (pn < 8) {
                    bf16_t* d = lat + (size_t)row * 512 + (pn - 6) * 256 + wc * 32 + 8 * fq;
                    *(GAS u32x4*)d = pack8(v00, v01); *(GAS u32x4*)(d + 128) = pack8(v10, v11);
                    float s = sq4(v00) + sq4(v01); if (pn == 6) s += sq4(v10) + sq4(v11);
                    s = quad_sum(s);
                    if (fq == 0) ((GAS float*)lssq)[(size_t)row * 16 + (pn - 6) * 4 + wc] = s;
                } else if (pn == 8) {
                    bf16_t* d = kvlat + (size_t)row * 256 + wc * 32 + 8 * fq;
                    *(GAS u32x4*)d = pack8(v00, v01); *(GAS u32x4*)(d + 128) = pack8(v10, v11);
                    float s = quad_sum(sq4(v00) + sq4(v01) + sq4(v10) + sq4(v11));
                    if (fq == 0) ((GAS float*)lssq)[(size_t)row * 16 + 8 + wc] = s;
                } else {
                    bf16_t* d = gates + (size_t)row * 2048 + (pn - 9) * 128 + wc * 32 + 8 * fq;
                    f32x4 sb0, sb1, r0, r1;
#define GATE1(R, SB, GA, GB) { const float da_ = 1.0f + __builtin_amdgcn_exp2f((GA) * (-LOG2E)), db_ = 1.0f + __builtin_amdgcn_exp2f((GB) * (-LOG2E)); SB = __builtin_amdgcn_rcpf(db_); R = db_ * __builtin_amdgcn_rcpf(da_); }
                    GATE1(r0.x, sb0.x, v00.x, v10.x) GATE1(r0.y, sb0.y, v00.y, v10.y) GATE1(r0.z, sb0.z, v00.z, v10.z) GATE1(r0.w, sb0.w, v00.w, v10.w)
                    GATE1(r1.x, sb1.x, v01.x, v11.x) GATE1(r1.y, sb1.y, v01.y, v11.y) GATE1(r1.z, sb1.z, v01.z, v11.z) GATE1(r1.w, sb1.w, v01.w, v11.w)
#undef GATE1
                    *(GAS u32x4*)d = pack8(r0, r1); *(GAS u32x4*)(d + 1024) = pack8(sb0, sb1);
                }
            }
    }
};

struct EpiUq {
    static constexpr bool PERM = true, ACC_INIT = false, PREF = true, KEEP = false;
    __device__ __forceinline__ const float* stat_base() const { return lssq; }
    const float* lssq; bf16_t* qb; const float* cosB; const float* sinB;
    __device__ __forceinline__ void operator()(AccRef acc, const pg8::Unit& u, int wr, int wc, int fr, int fq, const LAS unsigned char* sl) const {
        const int pn = u.pn;
        float rs[2][4];
        { f32x4 pv_[2][4];
#pragma unroll
          for (int ai = 0; ai < 2; ++ai)
#pragma unroll
              for (int m = 0; m < 4; ++m) pv_[ai][m] = *(const LAS f32x4*)(sl + (ai * 128 + wr * 64 + m * 16 + fr) * 64 + 16 * (fq & 1));
#pragma unroll
          for (int ai = 0; ai < 2; ++ai)
#pragma unroll
              for (int m = 0; m < 4; ++m) rs[ai][m] = rsqrtf(quad_sum((fq < 2) ? sum4(pv_[ai][m]) : 0.f) * (1.0f / 384.0f) + EPS) * C2B; }
        if (pn == 2) {
            const int head = 2 * wc + (fq >> 1), i0 = 8 * (fq & 1);
            f32x4 cs[2][4];
#define ROPE_LOAD(ai, m0) _Pragma("unroll") for (int mm = 0; mm < 2; ++mm) { const size_t ro = (size_t)(u.pm * 256 + (ai) * 128 + wr * 64 + ((m0) + mm) * 16 + fr) * 16 + i0; \
            cs[mm][0] = *(const GAS f32x4*)(cosB + ro); cs[mm][1] = *(const GAS f32x4*)(cosB + ro + 4); cs[mm][2] = *(const GAS f32x4*)(sinB + ro); cs[mm][3] = *(const GAS f32x4*)(sinB + ro + 4); }
#define ROPE_COMP(ai, m0) _Pragma("unroll") for (int mm = 0; mm < 2; ++mm) { const int m = (m0) + mm; const float r_ = rs[ai][m]; \
            const f32x4 v00 = acc[ai][0][m][0] * r_, v01 = acc[ai][0][m][1] * r_, v10 = acc[ai][1][m][0] * r_, v11 = acc[ai][1][m][1] * r_; \
            acc[ai][0][m][0] = v00 * cs[mm][0] - v10 * cs[mm][2]; acc[ai][0][m][1] = v01 * cs[mm][1] - v11 * cs[mm][3]; acc[ai][1][m][0] = v10 * cs[mm][0] + v00 * cs[mm][2]; acc[ai][1][m][1] = v11 * cs[mm][1] + v01 * cs[mm][3]; }
#define ROPE_STORE(ai, m0) _Pragma("unroll") for (int mm = 0; mm < 2; ++mm) { const int m = (m0) + mm; const int row = u.pm * 256 + (ai) * 128 + wr * 64 + m * 16 + fr; \
            bf16_t* d = qb + (size_t)row * 768 + head * 96 + 64 + i0; \
            *(GAS u32x4*)d = pack8(acc[ai][0][m][0], acc[ai][0][m][1]); *(GAS u32x4*)(d + 16) = pack8(acc[ai][1][m][0], acc[ai][1][m][1]); }
            ROPE_LOAD(0, 0); ROPE_COMP(0, 0); ROPE_LOAD(0, 2); ROPE_STORE(0, 0); ROPE_COMP(0, 2); ROPE_LOAD(1, 0); ROPE_STORE(0, 2); ROPE_COMP(1, 0); ROPE_LOAD(1, 2); ROPE_STORE(1, 0); ROPE_COMP(1, 2); ROPE_STORE(1, 2);
#undef ROPE_LOAD
#undef ROPE_COMP
#undef ROPE_STORE
            return;
        }
#pragma unroll
        for (int ai = 0; ai < 2; ++ai)
#pragma unroll
            for (int m = 0; m < 4; ++m) {
                const int row = u.pm * 256 + ai * 128 + wr * 64 + m * 16 + fr;
                const float r_ = rs[ai][m];
                const int c0 = pn * 256 + wc * 32 + 8 * fq, c1 = c0 + 128;
                *(GAS u32x4*)(qb + (size_t)row * 768 + (c0 >> 6) * 96 + (c0 & 63)) = pack8(acc[ai][0][m][0] * r_, acc[ai][0][m][1] * r_);
                *(GAS u32x4*)(qb + (size_t)row * 768 + (c1 >> 6) * 96 + (c1 & 63)) = pack8(acc[ai][1][m][0] * r_, acc[ai][1][m][1] * r_);
            }
    }
};

template <int MODE> struct EpiRowScale {
    static constexpr bool PERM = true, ACC_INIT = false, PREF = (MODE != 1), KEEP = false;
    __device__ __forceinline__ const float* stat_base() const { return stat; }
    const float* stat; bf16_t* O; int ldc; float cs;
    __device__ __forceinline__ void operator()(AccRef acc, const pg8::Unit& u, int wr, int wc, int fr, int fq, const LAS unsigned char* sl) const {
        float rs[2][4];
        if (MODE == 0) { f32x4 pv_[2][4];
#pragma unroll
            for (int ai = 0; ai < 2; ++ai)
#pragma unroll
                for (int m = 0; m < 4; ++m) pv_[ai][m] = *(const LAS f32x4*)(sl + (ai * 128 + wr * 64 + m * 16 + fr) * 64 + 32);
#pragma unroll
            for (int ai = 0; ai < 2; ++ai)
#pragma unroll
                for (int m = 0; m < 4; ++m) rs[ai][m] = rsqrtf(sum4(pv_[ai][m]) * (1.0f / 256.0f) + EPS);
        } else if (MODE == 1) {
#pragma unroll
            for (int ai = 0; ai < 2; ++ai)
#pragma unroll
                for (int m = 0; m < 4; ++m) rs[ai][m] = ((const GAS float*)stat)[u.pm * 256 + ai * 128 + wr * 64 + m * 16 + fr];
        } else { ROWSTAT8(rs, stat, 1.0f / 1024.0f, cs); }
#pragma unroll
        for (int ai = 0; ai < 2; ++ai)
#pragma unroll
            for (int m = 0; m < 4; ++m) {
                const int row = u.pm * 256 + ai * 128 + wr * 64 + m * 16 + fr;
                const float r_ = rs[ai][m];
                bf16_t* d = O + (size_t)row * ldc + u.pn * 256 + wc * 32 + 8 * fq;
                *(GAS u32x4*)d = pack8(acc[ai][0][m][0] * r_, acc[ai][0][m][1] * r_);
                *(GAS u32x4*)(d + 128) = pack8(acc[ai][1][m][0] * r_, acc[ai][1][m][1] * r_);
            }
    }
};

struct EpiBranchF {
    static constexpr bool PERM = true, ACC_INIT = false, PREF = false, KEEP = true;
    bf16_t* gates;
    __device__ __forceinline__ void operator()(AccRef acc, const pg8::Unit& u, int wr, int wc, int fr, int fq, const LAS unsigned char* sl) const {
        const int zoff = u.z ? 1024 : 0;
        u32x4 gt[4][2];
#define BR_LOAD(ai) _Pragma("unroll") for (int m = 0; m < 4; ++m) _Pragma("unroll") for (int bj = 0; bj < 2; ++bj) \
            gt[m][bj] = *(const GAS u32x4*)(gates + (size_t)(u.pm * 256 + (ai) * 128 + wr * 64 + m * 16 + fr) * 2048 + zoff + u.pn * 256 + bj * 128 + wc * 32 + 8 * fq);
#define BR_COMP(ai) _Pragma("unroll") for (int m = 0; m < 4; ++m) _Pragma("unroll") for (int bj = 0; bj < 2; ++bj) { const u32x4 g = gt[m][bj]; const f32x4 a0 = acc[ai][bj][m][0], a1 = acc[ai][bj][m][1]; \
            acc[ai][bj][m][0] = (f32x4){bflo(g.x) * a0.x, bfhi(g.x) * a0.y, bflo(g.y) * a0.z, bfhi(g.y) * a0.w}; acc[ai][bj][m][1] = (f32x4){bflo(g.z) * a1.x, bfhi(g.z) * a1.y, bflo(g.w) * a1.z, bfhi(g.w) * a1.w}; }
#define BR_STORE(ai) _Pragma("unroll") for (int m = 0; m < 4; ++m) _Pragma("unroll") for (int bj = 0; bj < 2; ++bj) \
            *(GAS u32x4*)(gates + (size_t)(u.pm * 256 + (ai) * 128 + wr * 64 + m * 16 + fr) * 2048 + u.pn * 256 + bj * 128 + wc * 32 + 8 * fq) = pack8(acc[ai][bj][m][0], acc[ai][bj][m][1]);
        BR_LOAD(0); BR_COMP(0); BR_LOAD(1); if (u.z) { BR_STORE(0); } BR_COMP(1); if (u.z) { BR_STORE(1); }
#undef BR_LOAD
#undef BR_COMP
#undef BR_STORE
    }
};

struct EpiRes {
    static constexpr bool PERM = true, ACC_INIT = true, PREF = false, KEEP = false;
    bf16_t* xb; unsigned char* xq; float* ssq;
    __device__ __forceinline__ void init(AccRef acc, const pg8::Unit& u, int wr, int wc, int fr, int fq) const {
        const size_t ubase = (size_t)(u.pm * 256 + wr * 64) * 1024 + u.pn * 256 + wc * 32;
        unsigned loff = (unsigned)(fr * 1024 + 8 * fq);
        asm volatile("" : "+v"(loff));
        const GAS bf16_t* hb = (const GAS bf16_t*)(xb + ubase); const GAS unsigned char* qb_ = (const GAS unsigned char*)(xq + ubase);
#pragma unroll
        for (int ai = 0; ai < 2; ++ai)
#pragma unroll
            for (int m = 0; m < 4; ++m)
#pragma unroll
                for (int bj = 0; bj < 2; ++bj) { const unsigned o = (unsigned)((ai * 128 + m * 16) * 1024 + bj * 128) + loff;
                    const u32x4 h = *(const GAS u32x4*)(hb + o); const u32x2 q = *(const GAS u32x2*)(qb_ + o);
                    xdeq8(h, q, acc[ai][bj][m][0], acc[ai][bj][m][1]); }
    }
    __device__ __forceinline__ void operator()(AccRef acc, const pg8::Unit& u, int wr, int wc, int fr, int fq, const LAS unsigned char* sl) const {
        const size_t ubase = (size_t)(u.pm * 256 + wr * 64) * 1024 + u.pn * 256 + wc * 32;
        unsigned loff = (unsigned)(fr * 1024 + 8 * fq);
        asm volatile("" : "+v"(loff));
        GAS bf16_t* hb = (GAS bf16_t*)(xb + ubase); GAS unsigned char* qb_ = (GAS unsigned char*)(xq + ubase);
#pragma unroll
        for (int ai = 0; ai < 2; ++ai)
#pragma unroll
            for (int m = 0; m < 4; ++m) { float s = 0.f;
#pragma unroll
                for (int bj = 0; bj < 2; ++bj) { const unsigned o = (unsigned)((ai * 128 + m * 16) * 1024 + bj * 128) + loff;
                    const f32x4 v0 = acc[ai][bj][m][0], v1 = acc[ai][bj][m][1];
                    const u32x4 h = pack8(v0, v1); u32x2 q; q.x = xquant4(v0, h.x, h.y); q.y = xquant4(v1, h.z, h.w);
                    *(GAS u32x4*)(hb + o) = h; *(GAS u32x2*)(qb_ + o) = q; s += sq4(v0) + sq4(v1); }
                s = quad_sum(s); if (fq == 0) ((GAS float*)ssq)[(size_t)(u.pm * 256 + ai * 128 + wr * 64 + m * 16 + fr) * 16 + u.pn * 4 + wc] = s; }
    }
};

struct EpiNull {
    static constexpr bool PERM = true, ACC_INIT = false, PREF = false, KEEP = false;
    __device__ __forceinline__ void operator()(AccRef acc, const pg8::Unit& u, int wr, int wc, int fr, int fq, const LAS unsigned char* sl) const {
#pragma unroll
        for (int ai = 0; ai < 2; ++ai)
#pragma unroll
            for (int bj = 0; bj < 2; ++bj)
#pragma unroll
                for (int m = 0; m < 4; ++m)
#pragma unroll
                    for (int n = 0; n < 2; ++n) asm volatile("" :: "v"(acc[ai][bj][m][n]));
    }
};
struct EpiGU {
    static constexpr bool PERM = true, ACC_INIT = false, PREF = true, KEEP = false;
    __device__ __forceinline__ const float* stat_base() const { return ssq; }
    const float* ssq; bf16_t* act;
    __device__ __forceinline__ void operator()(AccRef acc, const pg8::Unit& u, int wr, int wc, int fr, int fq, const LAS unsigned char* sl) const {
        float rs[2][4];
        ROWSTAT8(rs, ssq, 1.0f / 1024.0f, 1.0f);
#pragma unroll
        for (int ai = 0; ai < 2; ++ai)
#pragma unroll
            for (int m = 0; m < 4; ++m) {
                const int row = u.pm * 256 + ai * 128 + wr * 64 + m * 16 + fr;
                const float r_ = rs[ai][m];
                const f32x4 g0 = acc[ai][0][m][0] * r_, g1 = acc[ai][0][m][1] * r_, u0 = acc[ai][1][m][0] * r_, u1 = acc[ai][1][m][1] * r_;
                const f32x4 a0 = g0 * sig4(g0) * u0, a1 = g1 * sig4(g1) * u1;
                *(GAS u32x4*)(act + (size_t)row * DFF + u.pn * 128 + wc * 32 + 8 * fq) = pack8(a0, a1);
            }
    }
};

typedef short v4i16_t __attribute__((ext_vector_type(4)));
__device__ __forceinline__ v4i16_t vtr(const LAS unsigned char* p) { return __builtin_amdgcn_ds_read_tr16_b64_v4i16((LAS v4i16_t*)p); }
__device__ __forceinline__ float swap32_max(float m) { auto rr = __builtin_amdgcn_permlane32_swap(__float_as_uint(m), __float_as_uint(m), false, false); return fmaxf(__uint_as_float(rr[0]), __uint_as_float(rr[1])); }
__device__ __forceinline__ float swap32_add(float m) { auto rr = __builtin_amdgcn_permlane32_swap(__float_as_uint(m), __float_as_uint(m), false, false); return __uint_as_float(rr[0]) + __uint_as_float(rr[1]); }
template <int DQK, int DV, int MODE>
__device__ __forceinline__ void attn_unit(LAS unsigned char* lds, const int tid, const bf16_t* Qg, int ldq, const bf16_t* Kg, int ldk, const bf16_t* K2g,
                                          const bf16_t* Vg, int ldv, bf16_t* Og, int ldo, int qbase, int NT, const float* kbar, int cur, bool stage = true) {
    constexpr int KS = DQK + 8;
    constexpr int KBUF = 64 * KS * 2, VBUF = (DV / 32) * 4096, NB = (MODE == 2) ? 4 : 2;
    constexpr int KMAIN = (MODE == 1) ? 64 : DQK;
    constexpr int KCH = KMAIN / 8, NK = (64 * KCH) / 512, VCH = DV / 8, NV = (64 * VCH) / 512;
    constexpr int NJ = DQK / 16, ND = DV / 32;
    constexpr float THR = 8.0f;
    const int lane = tid & 63, wid = __builtin_amdgcn_readfirstlane(tid >> 6), r32 = lane & 31, hi = lane >> 5;
    bf16x8 qf[NJ];
    { const bf16_t* qrow = Qg + (size_t)(wid * 32 + r32) * ldq + 8 * hi;
#pragma unroll
      for (int j = 0; j < NJ; ++j) qf[j] = *(const GAS bf16x8*)(qrow + 16 * j); }
    float zf = 0.f; asm volatile("" : "+v"(zf)); const unsigned zu = __float_as_uint(zf);
    u32x4 kreg[2][NK], vreg[2][NV], k2reg[2] = {{zu, zu, zu, zu}, {zu, zu, zu, zu}};
#define ATT_LOAD(t, S) do { \
    _Pragma("unroll") for (int i = 0; i < NK; ++i) { const int idx = tid + 512 * i, kv = idx / KCH, c = idx % KCH; kreg[S][i] = *(const GAS u32x4*)(Kg + (size_t)(64 * (t) + kv) * ldk + 8 * c); } \
    if (MODE == 1) { if (tid < 256) k2reg[S] = *(const GAS u32x4*)(K2g + (size_t)(64 * (t) + (tid >> 2)) * 32 + 8 * (tid & 3)); } \
    _Pragma("unroll") for (int i = 0; i < NV; ++i) { const int idx = tid + 512 * i, kv = idx / VCH, c = idx % VCH; vreg[S][i] = *(const GAS u32x4*)(Vg + (size_t)(64 * (t) + kv) * ldv + 8 * c); } } while (0)
#define ATT_STORE(buf, S) do { LAS unsigned char* kb_ = lds + (buf) * KBUF; LAS unsigned char* vb_ = lds + NB * KBUF + (buf) * VBUF; \
    _Pragma("unroll") for (int i = 0; i < NK; ++i) { const int idx = tid + 512 * i, kv = idx / KCH, c = idx % KCH; *(LAS u32x4*)(kb_ + (kv * KS + 8 * c) * 2) = kreg[S][i]; } \
    if (MODE == 1) { if (tid < 256) *(LAS u32x4*)(kb_ + ((tid >> 2) * KS + 64 + 8 * (tid & 3)) * 2) = k2reg[S]; } \
    _Pragma("unroll") for (int i = 0; i < NV; ++i) { const int idx = tid + 512 * i, kv = idx / VCH, c = idx % VCH; *(LAS u32x4*)(vb_ + (c >> 2) * 4096 + kv * 64 + (c & 3) * 16) = vreg[S][i]; } } while (0)
#define ATT_BAR() asm volatile("s_waitcnt lgkmcnt(0)\n\ts_barrier" ::: "memory")
    if (MODE != 2) { ATT_LOAD(0, 0); ATT_LOAD(1, 1); }
    unsigned selmask = 0xffu;
    if (MODE == 0 && cur > 3) {
        float g[7];
#pragma unroll
        for (int j = 0; j < 7; ++j) {
            float a = 0.f;
            if (j < cur) {
#pragma unroll
                for (int jj = 0; jj < 4; ++jj) {
                    const f32x4 k0 = *(const GAS f32x4*)(kbar + j * 64 + 16 * jj + 8 * hi), k1 = *(const GAS f32x4*)(kbar + j * 64 + 16 * jj + 8 * hi + 4);
                    a += bf2f((unsigned short)qf[jj][0]) * k0.x + bf2f((unsigned short)qf[jj][1]) * k0.y + bf2f((unsigned short)qf[jj][2]) * k0.z + bf2f((unsigned short)qf[jj][3]) * k0.w
                       + bf2f((unsigned short)qf[jj][4]) * k1.x + bf2f((unsigned short)qf[jj][5]) * k1.y + bf2f((unsigned short)qf[jj][6]) * k1.z + bf2f((unsigned short)qf[jj][7]) * k1.w;
                }
                a = swap32_add(a);
            }
            g[j] = a;
        }
        unsigned sm = 0u;
#pragma unroll
        for (int j = 0; j < 7; ++j) {
            int rank = 0;
#pragma unroll
            for (int i = 0; i < 7; ++i) if (i != j) rank += (i < cur && (g[i] > g[j] || (g[i] == g[j] && i < j))) ? 1 : 0;
            if (j < cur && rank < 3) sm |= (1u << j);
        }
        selmask = sm | (1u << cur);
    }
    if (MODE != 2) { ATT_STORE(0, 0); ATT_BAR(); }
    else if (stage) {
        ATT_BAR();
        ATT_LOAD(0, 0); ATT_LOAD(1, 1); ATT_STORE(0, 0); ATT_LOAD(2, 0); ATT_STORE(1, 1); ATT_LOAD(3, 1); ATT_STORE(2, 0); ATT_STORE(3, 1);
        ATT_BAR();
    }
    f32x16 o[ND];
#pragma unroll
    for (int d0 = 0; d0 < ND; ++d0)
#pragma unroll
        for (int r = 0; r < 16; ++r) o[d0][r] = zf;
    float mref = zf, lrun = zf;
    const int qabs = qbase + wid * 32 + r32;
    const int qwmax = qbase + wid * 32 + 31;
    const int vlane = (4 * hi + ((lane & 15) >> 2)) * 64 + ((lane >> 4) & 1) * 32 + (lane & 3) * 8;
    if constexpr (MODE == 2) {
    for (int t = 0; t < 4; ++t) { const int buf = t;
        bool lane_ok = true, causal = false, active = true;
        if (MODE == 0) { const int blk = t >> 2; if (blk < cur) lane_ok = ((selmask >> blk) & 1u) != 0u; else causal = (64 * t + 63 > qbase + wid * 32); active = (__any(lane_ok ? 1 : 0) != 0) && (64 * t <= qwmax); }
        if (MODE == 1) { causal = (64 * t + 63 > qbase + wid * 32); active = (64 * t <= qwmax); }
        if (active) {
            const LAS unsigned char* kb = lds + buf * KBUF + (r32 * KS + 8 * hi) * 2;
            const float cin = (MODE == 0 && !lane_ok) ? -INFINITY : -mref;
            f32x16 s0, s1;
#pragma unroll
            for (int r = 0; r < 16; ++r) { s0[r] = cin; s1[r] = cin; }
#pragma unroll
            for (int j = 0; j < NJ; ++j) {
                const bf16x8 k0 = *(const LAS bf16x8*)(kb + j * 32), k1 = *(const LAS bf16x8*)(kb + 32 * KS * 2 + j * 32);
                s0 = __builtin_amdgcn_mfma_f32_32x32x16_bf16(k0, qf[j], s0, 0, 0, 0);
                s1 = __builtin_amdgcn_mfma_f32_32x32x16_bf16(k1, qf[j], s1, 0, 0, 0);
            }
            const LAS unsigned char* vb = lds + NB * KBUF + buf * VBUF + vlane;
            constexpr int NPF = (MODE == 2) ? 0 : 2;
            v4i16_t vpa[2][4], vpb[2][4];
#pragma unroll
            for (int d0 = 0; d0 < NPF; ++d0)
#pragma unroll
                for (int kk = 0; kk < 4; ++kk) { vpa[d0][kk] = vtr(vb + d0 * 4096 + kk * 1024); vpb[d0][kk] = vtr(vb + d0 * 4096 + kk * 1024 + 512); }
            if (MODE != 2) {
                if (causal) {
                    const int kb0 = 64 * t + 4 * hi;
#pragma unroll
                    for (int r = 0; r < 16; ++r) { const int kv = kb0 + (r & 3) + 8 * (r >> 2); if (kv > qabs) s0[r] = -INFINITY; if (kv + 32 > qabs) s1[r] = -INFINITY; }
                }
            }
            float mxa = fmaxf(fmaxf(s0[0], s0[1]), s1[0]), mxb = fmaxf(fmaxf(s0[2], s0[3]), s1[1]);
            mxa = fmaxf(fmaxf(mxa, s1[2]), s1[3]);
#pragma unroll
            for (int r = 4; r < 16; r += 4) { mxa = fmaxf(fmaxf(mxa, s0[r]), s0[r + 1]); mxb = fmaxf(fmaxf(mxb, s0[r + 2]), s0[r + 3]); mxa = fmaxf(fmaxf(mxa, s1[r]), s1[r + 1]); mxb = fmaxf(fmaxf(mxb, s1[r + 2]), s1[r + 3]); }
            float mx = fmaxf(mxa, mxb);
            mx = swap32_max(mx);
            if (__any(mx > THR ? 1 : 0)) {
                const float dl = (mx > THR) ? mx : 0.f;
                mref += dl;
#pragma unroll
                for (int r = 0; r < 16; ++r) { s0[r] -= dl; s1[r] -= dl; }
                const float alpha = __builtin_amdgcn_exp2f(-dl);
                lrun *= alpha;
#pragma unroll
                for (int d0 = 0; d0 < ND; ++d0)
#pragma unroll
                    for (int r = 0; r < 16; ++r) o[d0][r] *= alpha;
            }
            float psa = 0.f, psb = 0.f;
#pragma unroll
            for (int r = 0; r < 16; ++r) { s0[r] = __builtin_amdgcn_exp2f(s0[r]); s1[r] = __builtin_amdgcn_exp2f(s1[r]); psa += s0[r]; psb += s1[r]; }
            lrun += psa + psb;
            bf16x8 pb[4];
            { u32x4 w;
              w.x = cvt_pk_bf16(s0[0], s0[1]); w.y = cvt_pk_bf16(s0[2], s0[3]); w.z = cvt_pk_bf16(s0[4], s0[5]); w.w = cvt_pk_bf16(s0[6], s0[7]); pb[0] = __builtin_bit_cast(bf16x8, w);
              w.x = cvt_pk_bf16(s0[8], s0[9]); w.y = cvt_pk_bf16(s0[10], s0[11]); w.z = cvt_pk_bf16(s0[12], s0[13]); w.w = cvt_pk_bf16(s0[14], s0[15]); pb[1] = __builtin_bit_cast(bf16x8, w);
              w.x = cvt_pk_bf16(s1[0], s1[1]); w.y = cvt_pk_bf16(s1[2], s1[3]); w.z = cvt_pk_bf16(s1[4], s1[5]); w.w = cvt_pk_bf16(s1[6], s1[7]); pb[2] = __builtin_bit_cast(bf16x8, w);
              w.x = cvt_pk_bf16(s1[8], s1[9]); w.y = cvt_pk_bf16(s1[10], s1[11]); w.z = cvt_pk_bf16(s1[12], s1[13]); w.w = cvt_pk_bf16(s1[14], s1[15]); pb[3] = __builtin_bit_cast(bf16x8, w); }
#pragma unroll
            for (int d0 = 0; d0 < ND; ++d0)
#pragma unroll
                for (int kk = 0; kk < 4; ++kk) {
                    v4i16_t a, b;
                    if (d0 < NPF) { a = vpa[d0 & 1][kk]; b = vpb[d0 & 1][kk]; } else { a = vtr(vb + d0 * 4096 + kk * 1024); b = vtr(vb + d0 * 4096 + kk * 1024 + 512); }
                    const bf16x8 vf = {a[0], a[1], a[2], a[3], b[0], b[1], b[2], b[3]};
                    o[d0] = __builtin_amdgcn_mfma_f32_32x32x16_bf16(vf, pb[kk], o[d0], 0, 0, 0);
                }
        }
    }
    } else {
    for (int t2 = 0; t2 < NT; t2 += 2) {
      { const int t = t2; const int buf = 0;
        if (t + 2 < NT) ATT_LOAD(t + 2, 0);
        bool lane_ok = true, causal = false, active = true;
        if (MODE == 0) { const int blk = t >> 2; if (blk < cur) lane_ok = ((selmask >> blk) & 1u) != 0u; else causal = (64 * t + 63 > qbase + wid * 32); active = (__any(lane_ok ? 1 : 0) != 0) && (64 * t <= qwmax); }
        if (MODE == 1) { causal = (64 * t + 63 > qbase + wid * 32); active = (64 * t <= qwmax); }
        if (active) {
            const LAS unsigned char* kb = lds + buf * KBUF + (r32 * KS + 8 * hi) * 2;
            const float cin = (MODE == 0 && !lane_ok) ? -INFINITY : -mref;
            f32x16 s0, s1;
#pragma unroll
            for (int r = 0; r < 16; ++r) { s0[r] = cin; s1[r] = cin; }
#pragma unroll
            for (int j = 0; j < NJ; ++j) {
                const bf16x8 k0 = *(const LAS bf16x8*)(kb + j * 32), k1 = *(const LAS bf16x8*)(kb + 32 * KS * 2 + j * 32);
                s0 = __builtin_amdgcn_mfma_f32_32x32x16_bf16(k0, qf[j], s0, 0, 0, 0);
                s1 = __builtin_amdgcn_mfma_f32_32x32x16_bf16(k1, qf[j], s1, 0, 0, 0);
            }
            const LAS unsigned char* vb = lds + NB * KBUF + buf * VBUF + vlane;
            constexpr int NPF = (MODE == 2) ? 0 : 2;
            v4i16_t vpa[2][4], vpb[2][4];
#pragma unroll
            for (int d0 = 0; d0 < NPF; ++d0)
#pragma unroll
                for (int kk = 0; kk < 4; ++kk) { vpa[d0][kk] = vtr(vb + d0 * 4096 + kk * 1024); vpb[d0][kk] = vtr(vb + d0 * 4096 + kk * 1024 + 512); }
            if (MODE != 2) {
                if (causal) {
                    const int kb0 = 64 * t + 4 * hi;
#pragma unroll
                    for (int r = 0; r < 16; ++r) { const int kv = kb0 + (r & 3) + 8 * (r >> 2); if (kv > qabs) s0[r] = -INFINITY; if (kv + 32 > qabs) s1[r] = -INFINITY; }
                }
            }
            float mxa = fmaxf(fmaxf(s0[0], s0[1]), s1[0]), mxb = fmaxf(fmaxf(s0[2], s0[3]), s1[1]);
            mxa = fmaxf(fmaxf(mxa, s1[2]), s1[3]);
#pragma unroll
            for (int r = 4; r < 16; r += 4) { mxa = fmaxf(fmaxf(mxa, s0[r]), s0[r + 1]); mxb = fmaxf(fmaxf(mxb, s0[r + 2]), s0[r + 3]); mxa = fmaxf(fmaxf(mxa, s1[r]), s1[r + 1]); mxb = fmaxf(fmaxf(mxb, s1[r + 2]), s1[r + 3]); }
            float mx = fmaxf(mxa, mxb);
            mx = swap32_max(mx);
            if (__any(mx > THR ? 1 : 0)) {
                const float dl = (mx > THR) ? mx : 0.f;
                mref += dl;
#pragma unroll
                for (int r = 0; r < 16; ++r) { s0[r] -= dl; s1[r] -= dl; }
                const float alpha = __builtin_amdgcn_exp2f(-dl);
                lrun *= alpha;
#pragma unroll
                for (int d0 = 0; d0 < ND; ++d0)
#pragma unroll
                    for (int r = 0; r < 16; ++r) o[d0][r] *= alpha;
            }
            float psa = 0.f, psb = 0.f;
#pragma unroll
            for (int r = 0; r < 16; ++r) { s0[r] = __builtin_amdgcn_exp2f(s0[r]); s1[r] = __builtin_amdgcn_exp2f(s1[r]); psa += s0[r]; psb += s1[r]; }
            lrun += psa + psb;
            bf16x8 pb[4];
            { u32x4 w;
              w.x = cvt_pk_bf16(s0[0], s0[1]); w.y = cvt_pk_bf16(s0[2], s0[3]); w.z = cvt_pk_bf16(s0[4], s0[5]); w.w = cvt_pk_bf16(s0[6], s0[7]); pb[0] = __builtin_bit_cast(bf16x8, w);
              w.x = cvt_pk_bf16(s0[8], s0[9]); w.y = cvt_pk_bf16(s0[10], s0[11]); w.z = cvt_pk_bf16(s0[12], s0[13]); w.w = cvt_pk_bf16(s0[14], s0[15]); pb[1] = __builtin_bit_cast(bf16x8, w);
              w.x = cvt_pk_bf16(s1[0], s1[1]); w.y = cvt_pk_bf16(s1[2], s1[3]); w.z = cvt_pk_bf16(s1[4], s1[5]); w.w = cvt_pk_bf16(s1[6], s1[7]); pb[2] = __builtin_bit_cast(bf16x8, w);
              w.x = cvt_pk_bf16(s1[8], s1[9]); w.y = cvt_pk_bf16(s1[10], s1[11]); w.z = cvt_pk_bf16(s1[12], s1[13]); w.w = cvt_pk_bf16(s1[14], s1[15]); pb[3] = __builtin_bit_cast(bf16x8, w); }
#pragma unroll
            for (int d0 = 0; d0 < ND; ++d0)
#pragma unroll
                for (int kk = 0; kk < 4; ++kk) {
                    v4i16_t a, b;
                    if (d0 < NPF) { a = vpa[d0 & 1][kk]; b = vpb[d0 & 1][kk]; } else { a = vtr(vb + d0 * 4096 + kk * 1024); b = vtr(vb + d0 * 4096 + kk * 1024 + 512); }
                    const bf16x8 vf = {a[0], a[1], a[2], a[3], b[0], b[1], b[2], b[3]};
                    o[d0] = __builtin_amdgcn_mfma_f32_32x32x16_bf16(vf, pb[kk], o[d0], 0, 0, 0);
                }
        }
        ATT_STORE(1, 1);
        ATT_BAR();
      }
      { const int t = t2 + 1; const int buf = 1;
        if (t + 2 < NT) ATT_LOAD(t + 2, 1);
        bool lane_ok = true, causal = false, active = true;
        if (MODE == 0) { const int blk = t >> 2; if (blk < cur) lane_ok = ((selmask >> blk) & 1u) != 0u; else causal = (64 * t + 63 > qbase + wid * 32); active = (__any(lane_ok ? 1 : 0) != 0) && (64 * t <= qwmax); }
        if (MODE == 1) { causal = (64 * t + 63 > qbase + wid * 32); active = (64 * t <= qwmax); }
        if (active) {
            const LAS unsigned char* kb = lds + buf * KBUF + (r32 * KS + 8 * hi) * 2;
            const float cin = (MODE == 0 && !lane_ok) ? -INFINITY : -mref;
            f32x16 s0, s1;
#pragma unroll
            for (int r = 0; r < 16; ++r) { s0[r] = cin; s1[r] = cin; }
#pragma unroll
            for (int j = 0; j < NJ; ++j) {
                const bf16x8 k0 = *(const LAS bf16x8*)(kb + j * 32), k1 = *(const LAS bf16x8*)(kb + 32 * KS * 2 + j * 32);
                s0 = __builtin_amdgcn_mfma_f32_32x32x16_bf16(k0, qf[j], s0, 0, 0, 0);
                s1 = __builtin_amdgcn_mfma_f32_32x32x16_bf16(k1, qf[j], s1, 0, 0, 0);
            }
            const LAS unsigned char* vb = lds + NB * KBUF + buf * VBUF + vlane;
            constexpr int NPF = (MODE == 2) ? 0 : 2;
            v4i16_t vpa[2][4], vpb[2][4];
#pragma unroll
            for (int d0 = 0; d0 < NPF; ++d0)
#pragma unroll
                for (int kk = 0; kk < 4; ++kk) { vpa[d0][kk] = vtr(vb + d0 * 4096 + kk * 1024); vpb[d0][kk] = vtr(vb + d0 * 4096 + kk * 1024 + 512); }
            if (MODE != 2) {
                if (causal) {
                    const int kb0 = 64 * t + 4 * hi;
#pragma unroll
                    for (int r = 0; r < 16; ++r) { const int kv = kb0 + (r & 3) + 8 * (r >> 2); if (kv > qabs) s0[r] = -INFINITY; if (kv + 32 > qabs) s1[r] = -INFINITY; }
                }
            }
            float mxa = fmaxf(fmaxf(s0[0], s0[1]), s1[0]), mxb = fmaxf(fmaxf(s0[2], s0[3]), s1[1]);
            mxa = fmaxf(fmaxf(mxa, s1[2]), s1[3]);
#pragma unroll
            for (int r = 4; r < 16; r += 4) { mxa = fmaxf(fmaxf(mxa, s0[r]), s0[r + 1]); mxb = fmaxf(fmaxf(mxb, s0[r + 2]), s0[r + 3]); mxa = fmaxf(fmaxf(mxa, s1[r]), s1[r + 1]); mxb = fmaxf(fmaxf(mxb, s1[r + 2]), s1[r + 3]); }
            float mx = fmaxf(mxa, mxb);
            mx = swap32_max(mx);
            if (__any(mx > THR ? 1 : 0)) {
                const float dl = (mx > THR) ? mx : 0.f;
                mref += dl;
#pragma unroll
                for (int r = 0; r < 16; ++r) { s0[r] -= dl; s1[r] -= dl; }
                const float alpha = __builtin_amdgcn_exp2f(-dl);
                lrun *= alpha;
#pragma unroll
                for (int d0 = 0; d0 < ND; ++d0)
#pragma unroll
                    for (int r = 0; r < 16; ++r) o[d0][r] *= alpha;
            }
            float psa = 0.f, psb = 0.f;
#pragma unroll
            for (int r = 0; r < 16; ++r) { s0[r] = __builtin_amdgcn_exp2f(s0[r]); s1[r] = __builtin_amdgcn_exp2f(s1[r]); psa += s0[r]; psb += s1[r]; }
            lrun += psa + psb;
            bf16x8 pb[4];
            { u32x4 w;
              w.x = cvt_pk_bf16(s0[0], s0[1]); w.y = cvt_pk_bf16(s0[2], s0[3]); w.z = cvt_pk_bf16(s0[4], s0[5]); w.w = cvt_pk_bf16(s0[6], s0[7]); pb[0] = __builtin_bit_cast(bf16x8, w);
              w.x = cvt_pk_bf16(s0[8], s0[9]); w.y = cvt_pk_bf16(s0[10], s0[11]); w.z = cvt_pk_bf16(s0[12], s0[13]); w.w = cvt_pk_bf16(s0[14], s0[15]); pb[1] = __builtin_bit_cast(bf16x8, w);
              w.x = cvt_pk_bf16(s1[0], s1[1]); w.y = cvt_pk_bf16(s1[2], s1[3]); w.z = cvt_pk_bf16(s1[4], s1[5]); w.w = cvt_pk_bf16(s1[6], s1[7]); pb[2] = __builtin_bit_cast(bf16x8, w);
              w.x = cvt_pk_bf16(s1[8], s1[9]); w.y = cvt_pk_bf16(s1[10], s1[11]); w.z = cvt_pk_bf16(s1[12], s1[13]); w.w = cvt_pk_bf16(s1[14], s1[15]); pb[3] = __builtin_bit_cast(bf16x8, w); }
#pragma unroll
            for (int d0 = 0; d0 < ND; ++d0)
#pragma unroll
                for (int kk = 0; kk < 4; ++kk) {
                    v4i16_t a, b;
                    if (d0 < NPF) { a = vpa[d0 & 1][kk]; b = vpb[d0 & 1][kk]; } else { a = vtr(vb + d0 * 4096 + kk * 1024); b = vtr(vb + d0 * 4096 + kk * 1024 + 512); }
                    const bf16x8 vf = {a[0], a[1], a[2], a[3], b[0], b[1], b[2], b[3]};
                    o[d0] = __builtin_amdgcn_mfma_f32_32x32x16_bf16(vf, pb[kk], o[d0], 0, 0, 0);
                }
        }
        if (t + 1 < NT) ATT_STORE(0, 0);
        ATT_BAR();
      }
    }
    }
#undef ATT_LOAD
#undef ATT_STORE
#undef ATT_BAR
    lrun = swap32_add(lrun);
    const float inv = 1.0f / lrun;
    bf16_t* orow = Og + (size_t)(wid * 32 + r32) * ldo + 4 * hi;
#pragma unroll
    for (int d0 = 0; d0 < ND; ++d0)
#pragma unroll
        for (int rg = 0; rg < 4; ++rg) {
            u32x2 w; w.x = cvt_pk_bf16(o[d0][4 * rg] * inv, o[d0][4 * rg + 1] * inv); w.y = cvt_pk_bf16(o[d0][4 * rg + 2] * inv, o[d0][4 * rg + 3] * inv);
            *(GAS u32x2*)(orow + 32 * d0 + 8 * rg) = w;
        }
}

__device__ __forceinline__ float wave_sum(float v) {
#pragma unroll
    for (int o = 1; o < 64; o <<= 1) v += __shfl_xor(v, o);
    return v;
}
template <class MapFn>
__device__ __forceinline__ void transpose_item(const float* W, int K, int N, bf16_t* WT, const float* gain, LAS float* scr, int item, int lane, MapFn map) {
    const int nblk = N / 32, kb = item / nblk, nb = item % nblk, k0 = 64 * kb, n0 = 32 * nb;
    f32x4 w[8]; float gv[8];
#pragma unroll
    for (int i = 0; i < 8; ++i) { const int kk = 8 * i + (lane >> 3); w[i] = *(const GAS f32x4*)(W + (size_t)(k0 + kk) * N + n0 + 4 * (lane & 7)); gv[i] = gain ? ((const GAS float*)gain)[k0 + kk] : 1.0f; }
#pragma unroll
    for (int i = 0; i < 8; ++i) { const int kk = 8 * i + (lane >> 3); LAS float* d = scr + kk * 33 + 4 * (lane & 7); const f32x4 v = w[i] * gv[i]; d[0] = v.x; d[1] = v.y; d[2] = v.z; d[3] = v.w; }
    asm volatile("s_waitcnt lgkmcnt(0)" ::: "memory");
    const int c = lane & 7;
#pragma unroll
    for (int j = 0; j < 4; ++j) { const int n = (lane >> 3) + 8 * j; const LAS float* s = scr + (8 * c) * 33 + n;
        u32x4 o; o.x = cvt_pk_bf16(s[0 * 33], s[1 * 33]); o.y = cvt_pk_bf16(s[2 * 33], s[3 * 33]); o.z = cvt_pk_bf16(s[4 * 33], s[5 * 33]); o.w = cvt_pk_bf16(s[6 * 33], s[7 * 33]);
        *(GAS u32x4*)(WT + (size_t)map(n0 + n) * K + k0 + 8 * c) = o; }
    asm volatile("s_waitcnt lgkmcnt(0)" ::: "memory");
}
__device__ __forceinline__ int map_in(int n) {
    if (n < 1024) { const int base = n & 512, mm = n & 511, head = mm >> 6, e = mm & 63; return base + 256 * (head >> 2) + 128 * (e >> 5) + 32 * (head & 3) + (e & 31); }
    if (n < 1920) return n;
    if (n < 2176) return 2048 + (n - 1920);
    if (n < 2208) return 1920 + (n - 2176);
    { const int a = (n - 2208) & 1023, gb = (n - 2208) >> 10; return 2304 + 256 * (a >> 7) + 128 * gb + (a & 127); }
}
__device__ __forceinline__ int map_uq(int n) { const int head = n / 96, e = n % 96; if (e < 64) return 64 * head + e; const int r = e - 64; return 512 + 128 * (r >> 4) + 16 * head + (r & 15); }
__device__ __forceinline__ int map_gu(int n) { if (n < DFF) return 256 * (n >> 7) + (n & 127); const int a = n - DFF; return 256 * (a >> 7) + 128 + (a & 127); }
__device__ __forceinline__ int map_id(int n) { return n; }

#define XB_TMO      128
#define XB_XCNT(j)  (256  + 64 * (j))
#define XB_XSUB(j)  (1280 + 64 * (j))
#define XB_XGEN(j)  (2304 + 64 * (j))
#define XB_TOP      3328
#define XB_TOPGEN   3392
#define XCD_BAR_WORDS 3456
#define XB_SPIN_CAP (1u << 18)
__device__ __forceinline__ unsigned xb_ld(unsigned* p)              { return __hip_atomic_load(p, __ATOMIC_RELAXED, __HIP_MEMORY_SCOPE_AGENT); }
__device__ __forceinline__ unsigned xb_add(unsigned* p, unsigned v) { return __hip_atomic_fetch_add(p, v, __ATOMIC_RELAXED, __HIP_MEMORY_SCOPE_AGENT); }
__device__ __forceinline__ unsigned xb_xcc_id() { return (unsigned)__builtin_amdgcn_s_getreg((3 << 11) | 20) & 0xFu; }
#define XB_SPIN(cond, bar) do { unsigned _sp = 0; while (cond) { __builtin_amdgcn_s_sleep(1); \
    if ((++_sp & 255u) == 0u) { if (xb_ld(&(bar)[XB_TMO])) break; if (_sp > XB_SPIN_CAP) { atomicAdd(&(bar)[XB_TMO], 1u); break; } } } } while (0)
struct XcdBarrier { unsigned* bar; unsigned x; volatile LAS unsigned* st; };
__device__ __forceinline__ XcdBarrier xcd_barrier_post(unsigned* bar, volatile LAS unsigned* st) {
    XcdBarrier b; b.bar = bar; b.x = xb_xcc_id(); b.st = st;
    if (threadIdx.x == 0) (void)xb_add(&bar[XB_XCNT(b.x)], 1u);
    return b;
}
__device__ __forceinline__ void xcd_barrier_complete(unsigned* bar, unsigned x, unsigned& nloc, unsigned& nx) {
    const unsigned G = gridDim.x * gridDim.y * gridDim.z;
    unsigned sum, cnt, mine, sp = 0u;
    for (;;) {
        sum = 0u; cnt = 0u; mine = 0u;
#pragma unroll
        for (unsigned j = 0; j < 16; ++j) { const unsigned c = xb_ld(&bar[XB_XCNT(j)]); sum += c; cnt += (c > 0u) ? 1u : 0u; mine = (j == x) ? c : mine; }
        if (sum == G) break;
        __builtin_amdgcn_s_sleep(1);
        if ((++sp & 255u) == 0u) { if (xb_ld(&bar[XB_TMO])) break; if (sp > XB_SPIN_CAP) { atomicAdd(&bar[XB_TMO], 1u); break; } }
    }
    nloc = mine > 0u ? mine : 1u; nx = cnt > 0u ? cnt : 1u;
}
__device__ __forceinline__ void xcd_barrier(const XcdBarrier& b) {
    asm volatile("s_waitcnt vmcnt(0)" ::: "memory");
    __syncthreads();
    if (threadIdx.x == 0) {
        unsigned* bar = b.bar;
        __builtin_amdgcn_s_waitcnt(0);
        unsigned nloc = b.st[0], nx = b.st[1];
        if (nloc == 0u) { xcd_barrier_complete(bar, b.x, nloc, nx); b.st[0] = nloc; b.st[1] = nx; }
        const unsigned old = xb_add(&bar[XB_XSUB(b.x)], 1u);
        const unsigned gen = old / nloc;
        if (old + 1u == (gen + 1u) * nloc) {
            __builtin_amdgcn_fence(__ATOMIC_RELEASE, "agent");
            asm volatile("s_waitcnt vmcnt(0)" ::: "memory");
            const unsigned og = xb_add(&bar[XB_TOP], 1u);
            const unsigned tg = og / nx;
            if (og + 1u == (tg + 1u) * nx) xb_add(&bar[XB_TOPGEN], 1u);
            else XB_SPIN(xb_ld(&bar[XB_TOPGEN]) == tg, bar);
            __builtin_amdgcn_fence(__ATOMIC_ACQUIRE, "agent");
            xb_add(&bar[XB_XGEN(b.x)], 1u);
            asm volatile("s_waitcnt vmcnt(0)" ::: "memory");
        } else {
            XB_SPIN(xb_ld(&bar[XB_XGEN(b.x)]) == gen, bar);
            __builtin_amdgcn_fence(__ATOMIC_ACQUIRE, "agent");
            asm volatile("s_waitcnt vmcnt(0)" ::: "memory");
        }
    }
    __syncthreads();
}

struct Args {
    const float* x; const float* mem; const int* pos;
    const float* norm_mix; const float* w_in; const float* q_lat_norm; const float* w_uq; const float* kv_lat_norm; const float* w_ukv;
    const float* w_ba; const float* w_bb; const float* w_out; const float* norm_x; const float* norm_mem; const float* w_xq; const float* w_xkv; const float* w_xo;
    const float* norm_ffn; const float* w_gu; const float* w_dn; const float* norm_final;
    float* out; unsigned char* ws; int ph_lo, ph_hi;
};

constexpr int PH_PER_LAYER = 11, N_PHASES = DEPTH * PH_PER_LAYER + 1;
constexpr int LDS_TOTAL = pg8::STAGE_BYTES + 16384;

__global__ void __launch_bounds__(512, 2) fwd_kernel(Args a_in) {
    __shared__ __attribute__((aligned(16))) unsigned char lds_raw[LDS_TOTAL];
    LAS unsigned char* lds = (LAS unsigned char*)lds_raw;
    const int ph_lo = a_in.ph_lo, ph_hi = a_in.ph_hi;
    __shared__ __attribute__((aligned(16))) unsigned bar_st[4];
    __shared__ unsigned long long tacc[2];
    if (threadIdx.x == 0) { tacc[0] = 0ull; tacc[1] = 0ull; }
    if (threadIdx.x < 4) bar_st[threadIdx.x] = 0u;
    __syncthreads();
    XcdBarrier bar; bar.bar = (unsigned*)(a_in.ws + WS_CTL); bar.x = 0; bar.st = (volatile LAS unsigned*)bar_st;
    if (ph_hi - ph_lo > 1) bar = xcd_barrier_post((unsigned*)(a_in.ws + WS_CTL), (volatile LAS unsigned*)bar_st);
    for (int ph = ph_lo; ph < ph_hi; ++ph) {
        if (ph > ph_lo) { if (ph == ph_lo + 1) cg::this_grid().sync(); else xcd_barrier(bar); if (XSYNC) { xcd_barrier(bar); xcd_barrier(bar); } }
        if (TPROBE >= 0 && blockIdx.x == 0 && threadIdx.x == 0) {
            const unsigned long long now = __builtin_amdgcn_s_memrealtime();
            const int pprev = (ph - 1 < 0) ? -1 : ((ph - 1 == N_PHASES - 1) ? 11 : (ph - 1) % PH_PER_LAYER), pcur = (ph == N_PHASES - 1) ? 11 : ph % PH_PER_LAYER;
            if (pprev == TPROBE) tacc[0] += now - tacc[1];
            if (pcur == TPROBE) tacc[1] = now;
        }
        int tid = threadIdx.x; asm volatile("" : "+v"(tid));
        int G = gridDim.x, bx = blockIdx.x; asm volatile("" : "+s"(G), "+s"(bx));
        const int lane = tid & 63, wave = __builtin_amdgcn_readfirstlane(tid >> 6);
        const int vcu = (G % 8 == 0) ? (bx % 8) * (G / 8) + bx / 8 : bx;
        const int gw = vcu * 8 + wave, NGW = G * 8;
        const __attribute__((address_space(4))) Args* ap = (const __attribute__((address_space(4))) Args*)__builtin_amdgcn_kernarg_segment_ptr(); asm volatile("" : "+s"(ap));
        const __attribute__((address_space(4))) Args& a = *ap;
        unsigned char* ws = a.ws; float* aout = a.out; const float* ax = a.x;
        asm volatile("" : "+s"(ws), "+s"(aout), "+s"(ax));
        bf16_t* Win_t = (bf16_t*)(ws + WS_WIN); bf16_t* Wuq_t = (bf16_t*)(ws + WS_WUQ); bf16_t* Wukv_t = (bf16_t*)(ws + WS_WUKV);
        bf16_t* Wba_t = (bf16_t*)(ws + WS_WBA); bf16_t* Wbb_t = (bf16_t*)(ws + WS_WBB); bf16_t* Wout_t = (bf16_t*)(ws + WS_WOUT);
        bf16_t* Wxq_t = (bf16_t*)(ws + WS_WXQ); bf16_t* Wxkv_t = (bf16_t*)(ws + WS_WXKV); bf16_t* Wxo_t = (bf16_t*)(ws + WS_WXO);
        bf16_t* Wgu_t = (bf16_t*)(ws + WS_WGU); bf16_t* Wdn_t = (bf16_t*)(ws + WS_WDN);
        bf16_t* XB = (bf16_t*)(ws + WS_XB); bf16_t* QB = (bf16_t*)aout;
        bf16_t* QKVA = (bf16_t*)(ws + WS_QKVA); bf16_t* QX = (bf16_t*)(ws + WS_QKVA);
        bf16_t* LAT = (bf16_t*)(ws + WS_LAT); bf16_t* OAB = (bf16_t*)((unsigned char*)aout + 64 * MiB);
        bf16_t* KVLAT = (bf16_t*)(ws + WS_KVLAT); bf16_t* GATES = (bf16_t*)(ws + WS_GATES); bf16_t* ACT = (bf16_t*)(ws + WS_ACT);
        bf16_t* KVB = (bf16_t*)(ws + WS_KVB); bf16_t* KVX = (bf16_t*)(ws + WS_KVX); bf16_t* MEMB = (bf16_t*)(ws + WS_MEMB); bf16_t* KPE = (bf16_t*)(ws + WS_KPE);
        float* COSA = (float*)(ws + WS_COSA); float* SINA = (float*)(ws + WS_SINA); float* COSB = (float*)(ws + WS_COSB); float* SINB = (float*)(ws + WS_SINB);
        unsigned char* XQ = ws + WS_XQ; float* SSQ = (float*)(ws + WS_SSQ); float* LSSQ = (float*)(ws + WS_LSSQ); float* RSTDM = (float*)(ws + WS_RSTDM); float* KBAR = (float*)(ws + WS_KBAR);

        if (ph == N_PHASES - 1) {
            if (!PHON(11)) continue;
            for (int row = gw; row < M; row += NGW) {
                const f32x4* sp = (const f32x4*)(SSQ + (size_t)row * 16);
                const f32x4 p0 = sp[0], p1 = sp[1], p2 = sp[2], p3 = sp[3];
                const float s = ((p0.x + p0.y) + (p0.z + p0.w)) + ((p1.x + p1.y) + (p1.z + p1.w)) + ((p2.x + p2.y) + (p2.z + p2.w)) + ((p3.x + p3.y) + (p3.z + p3.w));
                const float rs = rsqrtf(s * (1.0f / 1024.0f) + EPS);
                GAS f32x4* xr = (GAS f32x4*)(aout + (size_t)row * DM) + lane; const GAS f32x4* gr = (const GAS f32x4*)a.norm_final + lane;
                const GAS u32x2* hr = (const GAS u32x2*)(XB + (size_t)row * DM) + lane; const GAS unsigned* qr = (const GAS unsigned*)(XQ + (size_t)row * DM) + lane;
#pragma unroll
                for (int j = 0; j < 4; ++j) { const u32x2 h = hr[64 * j]; const unsigned q = qr[64 * j]; const f32x4 g = gr[64 * j]; f32x4 v;
                    v.x = xdeq(h.x & 0xffffu, bflo(h.x), (int)(q << 24) >> 24); v.y = xdeq(h.x >> 16, bfhi(h.x), (int)(q << 16) >> 24);
                    v.z = xdeq(h.y & 0xffffu, bflo(h.y), (int)(q << 8) >> 24); v.w = xdeq(h.y >> 16, bfhi(h.y), (int)q >> 24);
                    xr[64 * j] = v * rs * g; }
            }
            continue;
        }
        const int l = ph / PH_PER_LAYER, p = ph % PH_PER_LAYER;
        if (STAG > 0 && (p == 5 || p == 8 || p == 10)) {
            const unsigned long long t0 = __builtin_amdgcn_s_memrealtime(); const unsigned long long dl = (unsigned long long)((vcu & 3) * STAG);
            while (__builtin_amdgcn_s_memrealtime() - t0 < dl) __builtin_amdgcn_s_sleep(8);
        }
        const float* xin = (l == 0 && p == 5) ? ax : aout;
        if (!PHON(p)) continue;
        if (p == 0) {
            LAS float* scr = (LAS float*)(lds + wave * 16384);
            constexpr int I_IN = 16 * (IN_W / 32), I_UQ = 6 * 24, I_UKV = 4 * 32, I_BA = 8 * 32, I_OUT = 16 * 32, I_XQ = 16 * 16, I_XKV = 16 * 32, I_XO = 8 * 32, I_GU = 16 * (2 * DFF / 32), I_DN = (DFF / 64) * 32;
            constexpr int NIT = I_IN + I_UQ + I_UKV + 2 * I_BA + I_OUT + I_XQ + I_XKV + I_XO + I_GU + I_DN;
            for (int rep = 0; rep < 1 + DUP(0); ++rep)
            for (int it = gw; it < NIT; it += NGW) {
                int r = it;
                if (r < I_IN) { transpose_item(a.w_in + (size_t)l * DM * IN_W, DM, IN_W, Win_t, a.norm_mix + l * DM, scr, r, lane, map_in); continue; } r -= I_IN;
                if (r < I_UQ) { transpose_item(a.w_uq + (size_t)l * 384 * 768, 384, 768, Wuq_t, a.q_lat_norm + l * 384, scr, r, lane, map_uq); continue; } r -= I_UQ;
                if (r < I_UKV) { transpose_item(a.w_ukv + (size_t)l * 256 * 1024, 256, 1024, Wukv_t, a.kv_lat_norm + l * 256, scr, r, lane, map_id); continue; } r -= I_UKV;
                if (r < I_BA) { transpose_item(a.w_ba + (size_t)l * 512 * 1024, 512, 1024, Wba_t, nullptr, scr, r, lane, map_id); continue; } r -= I_BA;
                if (r < I_BA) { transpose_item(a.w_bb + (size_t)l * 512 * 1024, 512, 1024, Wbb_t, nullptr, scr, r, lane, map_id); continue; } r -= I_BA;
                if (r < I_OUT) { transpose_item(a.w_out + (size_t)l * 1024 * 1024, 1024, 1024, Wout_t, nullptr, scr, r, lane, map_id); continue; } r -= I_OUT;
                if (r < I_XQ) { transpose_item(a.w_xq + (size_t)l * 1024 * 512, 1024, 512, Wxq_t, a.norm_x + l * DM, scr, r, lane, map_id); continue; } r -= I_XQ;
                if (r < I_XKV) { transpose_item(a.w_xkv + (size_t)l * 1024 * 1024, 1024, 1024, Wxkv_t, a.norm_mem + l * DM, scr, r, lane, map_id); continue; } r -= I_XKV;
                if (r < I_XO) { transpose_item(a.w_xo + (size_t)l * 512 * 1024, 512, 1024, Wxo_t, nullptr, scr, r, lane, map_id); continue; } r -= I_XO;
                if (r < I_GU) { transpose_item(a.w_gu + (size_t)l * 1024 * 2 * DFF, 1024, 2 * DFF, Wgu_t, a.norm_ffn + l * DM, scr, r, lane, map_gu); continue; } r -= I_GU;
                transpose_item(a.w_dn + (size_t)l * DFF * 1024, DFF, 1024, Wdn_t, nullptr, scr, r, lane, map_id);
            }
            unsigned zz_ = 0u; asm volatile("" : "+v"(zz_));
            for (int i = vcu * 512 + tid; i < 128 * 8 * 64; i += G * 512) ((GAS unsigned*)KBAR)[i] = zz_;
            for (int i = vcu * 512 + tid; i < 96 * 1024 / 8; i += G * 512) *(GAS u32x4*)(Win_t + (size_t)1952 * 1024 + (size_t)i * 8) = (u32x4){zz_, zz_, zz_, zz_};
            if (l == 0) {
                for (int row = gw; row < M + MM; row += NGW) {
                    const bool ism = row >= M; const int r = ism ? row - M : row;
                    const f32x4* xr = (const f32x4*)((ism ? a.mem : ax) + (size_t)r * DM) + lane;
                    f32x4 v[4]; float s = 0.f;
#pragma unroll
                    for (int j = 0; j < 4; ++j) { v[j] = xr[64 * j]; s += sq4(v[j]); }
                    s = wave_sum(s);
                    GAS_U32X2_PTR o8 = (GAS_U32X2_PTR)((ism ? MEMB : XB) + (size_t)r * DM) + lane;
#pragma unroll
                    for (int j = 0; j < 4; ++j) { u32x2 w; w.x = cvt_pk_bf16(v[j].x, v[j].y); w.y = cvt_pk_bf16(v[j].z, v[j].w); o8[64 * j] = w;
                        if (!ism) ((GAS unsigned*)(XQ + (size_t)r * DM))[64 * j + lane] = xquant4(v[j], w.x, w.y); }
                    if (ism) { if (lane == 0) RSTDM[r] = rsqrtf(s * (1.0f / 1024.0f) + EPS); }
                    else if (lane < 16) SSQ[(size_t)r * 16 + lane] = (lane == 0) ? s : 0.f;
                }
                for (int i = vcu * 512 + tid; i < M * 32; i += G * 512) {
                    const int row = i >> 5, k = i & 31; const float posf = (float)a.pos[row];
                    const float inv = expf(-9.210340371976184f * (2.0f / 64.0f) * (float)k);
                    float sn, cs; sincosf(posf * inv, &sn, &cs); COSA[i] = cs; SINA[i] = sn;
                    if (k < 16) { const float invb = expf(-9.210340371976184f * (2.0f / 32.0f) * (float)k); float sb, cb; sincosf(posf * invb, &sb, &cb); COSB[row * 16 + k] = cb; SINB[row * 16 + k] = sb; }
                }
            }
            __syncthreads();
        } else if (p == 1) {
            pg8::Gemm g{XB, Win_t, M, IN_WP, DM, DM}; pg8::StaticOrder S; S.init(M, IN_WP, G, bx);
            EpiIn E{SSQ, QKVA, LAT, KVLAT, GATES, LSSQ, COSA, SINA, KBAR};
            for (int rep = 0; rep < 1 + DUP(1); ++rep) { int tl = tid; asm volatile("" : "+v"(tl)); pg8::gemm_phase(lds, tl, g, S, E); }
            if (bx >= G / 2) {
              unsigned char* w = ws; int tl = tid; asm volatile("" : "+s"(w), "+v"(tl));
              pg8::Gemm g2{(bf16_t*)(w + WS_MEMB), (bf16_t*)(w + WS_WXKV), MM, 1024, 1024, 1024}; pg8::StaticOrder S2; S2.init(MM, 1024, G / 2, bx - G / 2);
              EpiRowScale<1> E2{(float*)(w + WS_RSTDM), (bf16_t*)(w + WS_KVX), 1024, 1.f}; pg8::gemm_phase(lds, tl, g2, S2, E2); }
        } else if (p == 2) {
            if (P2ON(0)) { LAS float* red = (LAS float*)lds;
              if (bx >= G / 2) for (int i = (bx - G / 2) * 512 + tid; i < M * 16; i += (G / 2) * 512) {
                  const int row = i >> 4, k = i & 15;
                  const float x1 = bf2f(LAT[(size_t)row * 512 + 384 + k]), x2 = bf2f(LAT[(size_t)row * 512 + 400 + k]);
                  const float c = COSB[i], s = SINB[i];
                  KPE[(size_t)row * 32 + k] = f2bf1(x1 * c - x2 * s); KPE[(size_t)row * 32 + 16 + k] = f2bf1(x2 * c + x1 * s);
              }
              __syncthreads(); }
            if (P2ON(1)) { unsigned char* w = ws; int tl = tid; asm volatile("" : "+s"(w), "+v"(tl));
              pg8::Gemm g{(bf16_t*)(w + WS_LAT), (bf16_t*)(w + WS_WUQ), M, 768, 384, 512}; pg8::StaticOrder S; S.init(M, 768, G, bx);
              EpiUq E{(float*)(w + WS_LSSQ), QB, (float*)(w + WS_COSB), (float*)(w + WS_SINB)}; pg8::gemm_phase(lds, tl, g, S, E); }
            if (P2ON(2)) { unsigned char* w = ws; int tl = tid; asm volatile("" : "+s"(w), "+v"(tl));
              pg8::Gemm g{(bf16_t*)(w + WS_KVLAT), (bf16_t*)(w + WS_WUKV), M, 1024, 256, 256}; pg8::StaticOrder S; S.init(M, 1024, G, G - 1 - bx);
              EpiRowScale<0> E{(float*)(w + WS_LSSQ), (bf16_t*)(w + WS_KVB), 1024, 1.f}; pg8::gemm_phase(lds, tl, g, S, E); }
        } else if (p == 3) {
            for (int v = vcu; v < 256; v += G) {
                const int bh = v >> 1, b = bh >> 3, h = bh & 7;
#pragma unroll 1
                for (int i = 0; i < 4; ++i) {
                    const int cur = (v & 1) ? ((i == 0) ? 2 : (i == 1) ? 5 : (i == 2) ? 3 : 4) : ((i == 0) ? 0 : (i == 1) ? 7 : (i == 2) ? 1 : 6);
                    const size_t rowb = (size_t)b * SEQ, rowq = rowb + cur * 256;
                    attn_unit<64, 64, 0>(lds, tid, QKVA + rowq * 1536 + h * 64, 1536, QKVA + rowb * 1536 + 512 + h * 64, 1536, nullptr,
                                         QKVA + rowb * 1536 + 1024 + h * 64, 1536, OAB + rowq * 512 + h * 64, 512, cur * 256, 4 * (cur + 1), KBAR + (size_t)bh * 512, cur);
                }
                for (int rep = 0; rep < 1 + DUP(4); ++rep)
#pragma unroll 1
                for (int i = 0; i < 4; ++i) {
                    const int cur = (v & 1) ? ((i == 0) ? 2 : (i == 1) ? 5 : (i == 2) ? 3 : 4) : ((i == 0) ? 0 : (i == 1) ? 7 : (i == 2) ? 1 : 6);
                    const size_t rowb = (size_t)b * SEQ, rowq = rowb + cur * 256;
                    attn_unit<96, 64, 1>(lds, tid, QB + rowq * 768 + h * 96, 768, KVB + rowb * 1024 + h * 128, 1024, KPE + rowb * 32,
                                         KVB + rowb * 1024 + h * 128 + 64, 1024, OAB + (size_t)M * 512 + rowq * 512 + h * 64, 512, cur * 256, 4 * (cur + 1), nullptr, cur);
                }
            }
        } else if (p == 4) {
            pg8::Gemm g{OAB, Wba_t, M, 1024, 512, 512, (size_t)M * 512 * 2, (size_t)1024 * 512 * 2}; pg8::StaticOrder S; S.init(M, 1024, G, bx); S.dual = 1;
            EpiBranchF E{GATES}; pg8::gemm_phase(lds, tid, g, S, E);
        } else if (p == 5) {
            pg8::Gemm g{GATES, Wout_t, M, 1024, 1024, 2048}; pg8::StaticOrder S; S.init(M, 1024, G, bx);
            if (ND(5)) { int tl = tid; asm volatile("" : "+v"(tl)); EpiNull EN; pg8::gemm_phase(lds, tl, g, S, EN); }
            EpiRes E{XB, XQ, SSQ}; pg8::gemm_phase(lds, tid, g, S, E);
        } else if (p == 6) {
            pg8::Gemm g{XB, Wxq_t, M, 512, 1024, 1024}; pg8::StaticOrder S; S.init(M, 512, G, bx);
            EpiRowScale<2> E{SSQ, QX, 512, C2X}; for (int rep = 0; rep < 1 + DUP(6); ++rep) { int tl = tid; asm volatile("" : "+v"(tl)); pg8::gemm_phase(lds, tl, g, S, E); }
        } else if (p == 7) {
            for (int un = vcu * 2; un < 512; un += 2 * G)
#pragma unroll 1
                for (int i = 0; i < 2; ++i) {
                    const int unit = un + i, bh = unit >> 3, qb = unit & 7, b = bh >> 2, h = bh & 3;
                    const size_t rowq = (size_t)b * SEQ + qb * 256, rowm = (size_t)b * MEMLEN;
                    attn_unit<128, 128, 2>(lds, tid, QX + rowq * 512 + h * 128, 512, KVX + rowm * 1024 + h * 128, 1024, nullptr,
                                           KVX + rowm * 1024 + 512 + h * 128, 1024, QX + rowq * 512 + h * 128, 512, 0, 4, nullptr, 0, i == 0);
                }
        } else if (p == 8) {
            pg8::Gemm g{QX, Wxo_t, M, 1024, 512, 512}; pg8::StaticOrder S; S.init(M, 1024, G, bx);
            if (ND(8)) { int tl = tid; asm volatile("" : "+v"(tl)); EpiNull EN; pg8::gemm_phase(lds, tl, g, S, EN); }
            EpiRes E{XB, XQ, SSQ}; pg8::gemm_phase(lds, tid, g, S, E);
        } else if (p == 9) {
            pg8::Gemm g{XB, Wgu_t, M, 2 * DFF, 1024, 1024}; pg8::StaticOrder S; S.init(M, 2 * DFF, G, bx);
            EpiGU E{SSQ, ACT}; for (int rep = 0; rep < 1 + DUP(9); ++rep) { int tl = tid; asm volatile("" : "+v"(tl)); pg8::gemm_phase(lds, tl, g, S, E); }
            if (DUP(12)) { int tl = tid; asm volatile("" : "+v"(tl)); EpiNull EN; pg8::gemm_phase(lds, tl, g, S, EN); }
        } else {
            pg8::Gemm g{ACT, Wdn_t, M, 1024, DFF, DFF}; pg8::StaticOrder S; S.init(M, 1024, G, bx);
            if (ND(10)) { int tl = tid; asm volatile("" : "+v"(tl)); EpiNull EN; pg8::gemm_phase(lds, tl, g, S, EN); }
            if (ND(13)) { int tl = tid; asm volatile("" : "+v"(tl)); EpiRes ED{(bf16_t*)(ws + 276 * MiB), (unsigned char*)(ws + 340 * MiB), LSSQ}; pg8::gemm_phase(lds, tl, g, S, ED); }
            EpiRes E{XB, XQ, SSQ}; pg8::gemm_phase(lds, tid, g, S, E);
        }
    }
    if (TPROBE >= 0 && blockIdx.x == 0) {
        __syncthreads();
        const unsigned long long t0 = __builtin_amdgcn_s_memrealtime(); const unsigned long long dl = (unsigned long long)TAMP * tacc[0];
        while (__builtin_amdgcn_s_memrealtime() - t0 < dl) __builtin_amdgcn_s_sleep(16);
    }
}

extern "C" void kernel_launch(void* const* d_in, const int* in_sizes, int n_in, void* d_out, int out_size, void* d_ws, size_t ws_size, hipStream_t stream) {
    static int grid = 0;
    if (grid == 0) {
        if (n_in != 21 || in_sizes[0] != M * DM || out_size != M * DM || ws_size < WS_END) {
            fprintf(stderr, "kernel_launch: unexpected shapes (n_in %d, in0 %d, out %d, ws %zu); nothing launched\n", n_in, n_in > 0 ? in_sizes[0] : -1, out_size, ws_size); grid = -1; return; }
        int dev = 0, cus = 0, per_cu = 0;
        hipGetDevice(&dev); hipDeviceGetAttribute(&cus, hipDeviceAttributeMultiprocessorCount, dev);
        if (hipOccupancyMaxActiveBlocksPerMultiprocessor(&per_cu, (const void*)fwd_kernel, 512, 0) != hipSuccess || per_cu < 1) per_cu = 1;
        (void)hipGetLastError();
        grid = cus * 1;
        if (grid <= 0) grid = 256;
    }
    if (grid < 0) return;
    Args a{};
    a.x = (const float*)d_in[0]; a.mem = (const float*)d_in[1]; a.pos = (const int*)d_in[2];
    a.norm_mix = (const float*)d_in[3]; a.w_in = (const float*)d_in[4]; a.q_lat_norm = (const float*)d_in[5]; a.w_uq = (const float*)d_in[6];
    a.kv_lat_norm = (const float*)d_in[7]; a.w_ukv = (const float*)d_in[8]; a.w_ba = (const float*)d_in[9]; a.w_bb = (const float*)d_in[10]; a.w_out = (const float*)d_in[11];
    a.norm_x = (const float*)d_in[12]; a.norm_mem = (const float*)d_in[13]; a.w_xq = (const float*)d_in[14]; a.w_xkv = (const float*)d_in[15]; a.w_xo = (const float*)d_in[16];
    a.norm_ffn = (const float*)d_in[17]; a.w_gu = (const float*)d_in[18]; a.w_dn = (const float*)d_in[19]; a.norm_final = (const float*)d_in[20];
    a.out = (float*)d_out; a.ws = (unsigned char*)d_ws;
#if ONE_LAUNCH
    if (hipMemsetAsync((char*)d_ws + WS_CTL, 0, 65536, stream) != hipSuccess) { fprintf(stderr, "kernel_launch: memset of the barrier words failed\n"); return; }
    a.ph_lo = 0; a.ph_hi = N_PHASES;
    void* args[] = {&a};
    hipError_t e = hipLaunchCooperativeKernel((const void*)fwd_kernel, dim3(grid), dim3(512), args, 0, stream);
    if (e != hipSuccess) fprintf(stderr, "cooperative launch failed: %s (grid %d)\n", hipGetErrorString(e), grid);
#else
    for (int ph = 0; ph < N_PHASES; ++ph) {
        a.ph_lo = ph; a.ph_hi = ph + 1;
        hipLaunchKernelGGL(fwd_kernel, dim3(grid), dim3(512), 0, stream, a);
    }
#endif
}
```
